# Optimizing an MI355X kernel written in HIP

```python
import math
import jax, jax.numpy as jnp
from jax import lax
import numpy as np

D_MODEL = 2048
BATCH = 2
SEQ = 16384
DEPTH = 4

D_MIX = D_MODEL
GROUP_W = D_MIX // 4
D_FF = 5632
NORM_EPS = 1e-6
MASK_VALUE = -1e30
HG_HEADS = 4
HG_EXPAND = GROUP_W // HG_HEADS
HG_HEAD_V = GROUP_W // HG_HEADS
HG_CHUNK = 64
ATT_HEADS = 8
ATT_HEAD_DIM = GROUP_W // ATT_HEADS
ATT_PATTERNS = ((128, 1), (512, 4), (2048, 16))
ATT_BLOCK = 128
SSM_HEAD_DIM = 64
SSM_HEADS = GROUP_W // SSM_HEAD_DIM
SSM_GROUPS = 2
SSM_STATE = 128
SSM_CONV = 4
SSM_CHUNK = 64
SSM_CONV_DIM = GROUP_W + 2 * SSM_GROUPS * SSM_STATE
LRU_BLOCKS = 8
LRU_BLOCK_W = GROUP_W // LRU_BLOCKS
LRU_CONV = 4
LRU_C = 8.0
IN_WIDTHS = (GROUP_W, GROUP_W, GROUP_W, GROUP_W,
             GROUP_W, GROUP_W, GROUP_W,
             GROUP_W, SSM_CONV_DIM, SSM_HEADS,
             GROUP_W, GROUP_W)
N_IN = sum(IN_WIDTHS)

kernel_name = "hybrid_parallel_hgrn2_dilattn_ssd_rglru"


def rmsnorm(x, w):
    xf = x.astype(jnp.float32)
    y = xf * lax.rsqrt(jnp.mean(xf * xf, axis=-1, keepdims=True) + NORM_EPS)
    return (y * w.astype(jnp.float32)).astype(x.dtype)


def swiglu(x, w_gate, w_up, w_down):
    return (jax.nn.silu(x @ w_gate) * (x @ w_up)) @ w_down


def causal_dwconv(x, w, b):
    width, ch = w.shape
    y = lax.conv_general_dilated(x, w[:, None, :].astype(x.dtype), window_strides=(1,),
                                 padding=[(width - 1, 0)],
                                 dimension_numbers=("NWC", "WIO", "NWC"),
                                 feature_group_count=ch)
    return y + b.astype(x.dtype)


def hgrn2_chunk_scan(q, k, v, log_f):
    bsz, seq, heads, dk = q.shape
    dv = v.shape[-1]
    c = HG_CHUNK
    nc = seq // c

    def to_chunks(t):
        return t.reshape(bsz, nc, c, heads, t.shape[-1]).transpose(1, 0, 3, 2, 4)

    mask = jnp.tril(jnp.ones((c, c), dtype=bool))[:, :, None]

    def step(state, inp):
        qc, kc, vc, gc = inp
        b = jnp.cumsum(gc, axis=2)
        o_inter = jnp.einsum("bhtk,bhkv->bhtv", qc * jnp.exp(b), state)
        diff = b[:, :, :, None, :] - b[:, :, None, :, :]
        decay = jnp.where(mask, jnp.exp(jnp.where(mask, diff, 0.0)), 0.0)
        scores = jnp.einsum("bhtk,bhsk,bhtsk->bhts", qc, kc, decay)
        o = o_inter + jnp.einsum("bhts,bhsv->bhtv", scores, vc)
        b_last = b[:, :, -1:, :]
        state = (jnp.exp(b_last[:, :, 0, :])[..., None] * state
                 + jnp.einsum("bhsk,bhsv->bhkv", kc * jnp.exp(b_last - b), vc))
        return state, o

    init = jnp.zeros((bsz, heads, dk, dv), jnp.float32)
    _, o = lax.scan(step, init, (to_chunks(q), to_chunks(k), to_chunks(v), to_chunks(log_f)))
    return o.transpose(1, 0, 3, 2, 4).reshape(bsz, seq, heads, dv)


def hgrn2_mixer(q_raw, f_raw, i_raw, g_raw, lower_bound, norm_w):
    bsz, seq, _ = q_raw.shape
    out_dtype = q_raw.dtype

    def heads(t):
        return t.astype(jnp.float32).reshape(bsz, seq, HG_HEADS, -1)

    q = jax.nn.silu(heads(q_raw))
    z = heads(f_raw)
    lb = lower_bound.astype(jnp.float32).reshape(HG_HEADS, HG_EXPAND)
    f = lb + (1.0 - lb) * jax.nn.sigmoid(z)
    log_f = jnp.log(f)
    k = (1.0 - lb) * jax.nn.sigmoid(-z)
    v = heads(i_raw)
    o = hgrn2_chunk_scan(q, k, v, log_f)
    o = rmsnorm(o, norm_w.reshape(HG_HEADS, HG_HEAD_V)) * jax.nn.silu(heads(g_raw))
    return o.reshape(bsz, seq, GROUP_W).astype(out_dtype)


def dilated_pattern(q, k, v, dil, span):
    bsz, seq, heads, hd = q.shape
    qb_len = ATT_BLOCK
    unit = dil * qb_len
    seq_p = -(-seq // unit) * unit
    m_len = seq_p // dil
    nb = m_len // qb_len
    pad = ((0, 0), (0, seq_p - seq), (0, 0), (0, 0))

    def to_blocks(t):
        return (jnp.pad(t, pad).reshape(bsz, m_len, dil, heads, hd)
                .transpose(0, 2, 1, 3, 4).reshape(bsz, dil, nb, qb_len, heads, hd))

    def with_prev(t):
        prev = jnp.pad(t[:, :, :-1], ((0, 0), (0, 0), (1, 0), (0, 0), (0, 0), (0, 0)))
        return jnp.concatenate([prev, t], axis=3)

    qb = to_blocks(q)
    kk = with_prev(to_blocks(k))
    vv = with_prev(to_blocks(v))
    s = jnp.einsum("brnqhe,brnkhe->brnhqk", qb, kk) * (hd ** -0.5)
    iq = jnp.arange(qb_len)[:, None]
    ik = jnp.arange(2 * qb_len)[None, :]
    rel = qb_len + iq - ik
    blk = jnp.arange(nb)[:, None, None]
    valid = ((rel >= 0) & (rel <= span) & (blk * qb_len + ik[None] - qb_len >= 0))[:, None]
    s = jnp.where(valid, s, MASK_VALUE)
    m = jnp.max(s, axis=-1)
    p = jnp.where(valid, jnp.exp(s - m[..., None]), 0.0)
    den = jnp.sum(p, axis=-1)
    num = jnp.einsum("brnhqk,brnkhe->brnqhe", p, vv)
    num = (num.reshape(bsz, dil, m_len, heads, hd).transpose(0, 2, 1, 3, 4)
           .reshape(bsz, seq_p, heads, hd)[:, :seq])

    def stat_back(t):
        return (t.transpose(0, 1, 2, 4, 3).reshape(bsz, dil, m_len, heads)
                .transpose(0, 2, 1, 3).reshape(bsz, seq_p, heads)[:, :seq])

    return num, stat_back(m), stat_back(den)


def dilated_attention(q_raw, k_raw, v_raw, norm_w):
    bsz, seq, _ = q_raw.shape

    def heads(t):
        return t.astype(jnp.float32).reshape(bsz, seq, ATT_HEADS, ATT_HEAD_DIM)

    q, k, v = heads(q_raw), heads(k_raw), heads(v_raw)
    outs = [dilated_pattern(q, k, v, dil, win // dil) for (win, dil) in ATT_PATTERNS]
    nums = jnp.stack([o[0] for o in outs])
    ms = jnp.stack([o[1] for o in outs])
    dens = jnp.stack([o[2] for o in outs])
    wts = jnp.exp(ms - jnp.max(ms, axis=0))
    o = jnp.sum(wts[..., None] * nums, axis=0) / jnp.sum(wts * dens, axis=0)[..., None]
    return rmsnorm(o.reshape(bsz, seq, GROUP_W), norm_w).astype(q_raw.dtype)


def ssd_chunked(xdt, adt, bm, cm):
    bsz, seq, heads, hp = xdt.shape
    lc = SSM_CHUNK
    nc = seq // lc
    g = SSM_GROUPS
    r = heads // g
    xc = xdt.reshape(bsz, nc, lc, g, r, hp)
    a = adt.reshape(bsz, nc, lc, g, r).transpose(0, 3, 4, 1, 2)
    bc = bm.reshape(bsz, nc, lc, g, SSM_STATE)
    cc = cm.reshape(bsz, nc, lc, g, SSM_STATE)
    a_cs = jnp.cumsum(a, axis=-1)
    mask = jnp.tril(jnp.ones((lc, lc), dtype=bool))
    seg = a_cs[..., :, None] - a_cs[..., None, :]
    lmat = jnp.where(mask, jnp.exp(jnp.where(mask, seg, 0.0)), 0.0)
    cb = jnp.einsum("bclgn,bcsgn->bgcls", cc, bc)
    y_diag = jnp.einsum("bgcls,bgrcls,bcsgrp->bclgrp", cb, lmat, xc)
    decay_states = jnp.exp(a_cs[..., -1:] - a_cs)
    states = jnp.einsum("bcsgn,bgrcs,bcsgrp->bcgrpn", bc, decay_states, xc)
    chunk_decay = jnp.exp(a_cs[..., -1])

    def step(carry, inp):
        st, dec = inp
        return dec[..., None, None] * carry + st, carry

    init = jnp.zeros((bsz, g, r, hp, SSM_STATE), jnp.float32)
    _, prev = lax.scan(step, init, (states.transpose(1, 0, 2, 3, 4, 5),
                                    chunk_decay.transpose(3, 0, 1, 2)))
    prev = prev.transpose(1, 0, 2, 3, 4, 5)
    y_off = jnp.einsum("bclgn,bcgrpn,bgrcl->bclgrp", cc, prev, jnp.exp(a_cs))
    return (y_diag + y_off).reshape(bsz, seq, heads, hp)


def mamba2_mixer(z, xbc, dt_raw, conv_w, conv_b, dt_bias, a_log, d_skip, norm_w):
    bsz, seq, _ = z.shape
    xbc = jax.nn.silu(causal_dwconv(xbc, conv_w, conv_b)).astype(jnp.float32)
    xs, bm, cm = jnp.split(xbc, [GROUP_W, GROUP_W + SSM_GROUPS * SSM_STATE], axis=-1)
    x = xs.reshape(bsz, seq, SSM_HEADS, SSM_HEAD_DIM)
    bm = bm.reshape(bsz, seq, SSM_GROUPS, SSM_STATE)
    cm = cm.reshape(bsz, seq, SSM_GROUPS, SSM_STATE)
    dt = jax.nn.softplus(dt_raw.astype(jnp.float32) + dt_bias.astype(jnp.float32))
    a = -jnp.exp(a_log.astype(jnp.float32))
    y = ssd_chunked(x * dt[..., None], dt * a, bm, cm)
    y = y + d_skip.astype(jnp.float32)[:, None] * x
    y = y.reshape(bsz, seq, GROUP_W) * jax.nn.silu(z.astype(jnp.float32))
    y = rmsnorm(y.reshape(bsz, seq, SSM_GROUPS, GROUP_W // SSM_GROUPS),
                norm_w.reshape(SSM_GROUPS, GROUP_W // SSM_GROUPS))
    return y.reshape(bsz, seq, GROUP_W).astype(z.dtype)


def _lin_combine(e1, e2):
    a1, b1 = e1
    a2, b2 = e2
    return a1 * a2, a2 * b1 + b2


def rglru_mixer(xb, gb, conv_w, conv_b, w_a, b_a, w_x, b_x, a_param, norm_w):
    bsz, seq, _ = xb.shape
    xc = causal_dwconv(xb, conv_w, conv_b).astype(jnp.float32)
    xh = xc.reshape(bsz, seq, LRU_BLOCKS, LRU_BLOCK_W)
    r = jax.nn.sigmoid(jnp.einsum("bshi,hij->bshj", xh, w_a.astype(jnp.float32)) + b_a.astype(jnp.float32))
    i = jax.nn.sigmoid(jnp.einsum("bshi,hij->bshj", xh, w_x.astype(jnp.float32)) + b_x.astype(jnp.float32))
    log_a = -LRU_C * r * jax.nn.softplus(-a_param.astype(jnp.float32).reshape(LRU_BLOCKS, LRU_BLOCK_W))
    a = jnp.exp(log_a)
    bterm = jnp.sqrt(jnp.maximum(-jnp.expm1(2.0 * log_a), 0.0)) * (i * xh)
    _, h = lax.associative_scan(_lin_combine, (a, bterm), axis=1)
    h = h.reshape(bsz, seq, GROUP_W) * jax.nn.gelu(gb.astype(jnp.float32))
    return rmsnorm(h, norm_w).astype(xb.dtype)


def setup_inputs(seed: int = 0) -> dict:
    key = jax.random.key(seed)
    ks = iter(jax.random.split(key, 40))
    f32 = jnp.float32

    def nrm(shape, scale):
        return jax.random.normal(next(ks), shape, f32) * scale

    def gain(shape):
        return 1.0 + nrm(shape, 0.02)

    L = DEPTH
    x = nrm((BATCH, SEQ, D_MODEL), 1.0)
    ffn1_norm = gain((L, D_MODEL))
    ffn1_w_gate = nrm((L, D_MODEL, D_FF), D_MODEL ** -0.5)
    ffn1_w_up = nrm((L, D_MODEL, D_FF), D_MODEL ** -0.5)
    ffn1_w_down = nrm((L, D_FF, D_MODEL), D_FF ** -0.5)
    mix_norm = gain((L, D_MODEL))
    w_in = nrm((L, D_MODEL, N_IN), D_MODEL ** -0.5)
    w_out = nrm((L, D_MIX, D_MODEL), D_MIX ** -0.5)
    hgrn_lb_logits = nrm((L, GROUP_W), 0.5)
    hgrn_norm = gain((L, GROUP_W))
    attn_norm = gain((L, GROUP_W))
    ssm_conv_w = nrm((L, SSM_CONV, SSM_CONV_DIM), SSM_CONV ** -0.5)
    ssm_conv_b = nrm((L, SSM_CONV_DIM), 0.01)
    dt0 = jnp.exp(jax.random.uniform(next(ks), (L, SSM_HEADS), f32,
                                     minval=math.log(1e-3), maxval=math.log(1e-1)))
    ssm_dt_bias = dt0 + jnp.log(-jnp.expm1(-dt0))
    ssm_a_log = jnp.log(jax.random.uniform(next(ks), (L, SSM_HEADS), f32, minval=1.0, maxval=16.0))
    ssm_d = gain((L, SSM_HEADS))
    ssm_norm = gain((L, GROUP_W))
    lru_conv_w = nrm((L, LRU_CONV, GROUP_W), LRU_CONV ** -0.5)
    lru_conv_b = nrm((L, GROUP_W), 0.01)
    lru_w_a = nrm((L, LRU_BLOCKS, LRU_BLOCK_W, LRU_BLOCK_W), LRU_BLOCK_W ** -0.5)
    lru_b_a = nrm((L, LRU_BLOCKS, LRU_BLOCK_W), 0.01)
    lru_w_x = nrm((L, LRU_BLOCKS, LRU_BLOCK_W, LRU_BLOCK_W), LRU_BLOCK_W ** -0.5)
    lru_b_x = nrm((L, LRU_BLOCKS, LRU_BLOCK_W), 0.01)
    a_c = jax.random.uniform(next(ks), (L, GROUP_W), f32, minval=0.9, maxval=0.999)
    s = a_c ** (1.0 / LRU_C)
    lru_a_param = jnp.log(s) - jnp.log1p(-s)
    lru_norm = gain((L, GROUP_W))
    ffn2_norm = gain((L, D_MODEL))
    ffn2_w_gate = nrm((L, D_MODEL, D_FF), D_MODEL ** -0.5)
    ffn2_w_up = nrm((L, D_MODEL, D_FF), D_MODEL ** -0.5)
    ffn2_w_down = nrm((L, D_FF, D_MODEL), D_FF ** -0.5)
    final_norm = gain((D_MODEL,))
    return {"x": x, "ffn1_norm": ffn1_norm, "ffn1_w_gate": ffn1_w_gate, "ffn1_w_up": ffn1_w_up,
            "ffn1_w_down": ffn1_w_down, "mix_norm": mix_norm, "w_in": w_in, "w_out": w_out,
            "hgrn_lb_logits": hgrn_lb_logits, "hgrn_norm": hgrn_norm, "attn_norm": attn_norm,
            "ssm_conv_w": ssm_conv_w, "ssm_conv_b": ssm_conv_b, "ssm_dt_bias": ssm_dt_bias,
            "ssm_a_log": ssm_a_log, "ssm_d": ssm_d, "ssm_norm": ssm_norm,
            "lru_conv_w": lru_conv_w, "lru_conv_b": lru_conv_b, "lru_w_a": lru_w_a, "lru_b_a": lru_b_a,
            "lru_w_x": lru_w_x, "lru_b_x": lru_b_x, "lru_a_param": lru_a_param, "lru_norm": lru_norm,
            "ffn2_norm": ffn2_norm, "ffn2_w_gate": ffn2_w_gate, "ffn2_w_up": ffn2_w_up,
            "ffn2_w_down": ffn2_w_down, "final_norm": final_norm}


def reference(x, ffn1_norm, ffn1_w_gate, ffn1_w_up, ffn1_w_down, mix_norm, w_in, w_out,
              hgrn_lb_logits, hgrn_norm, attn_norm, ssm_conv_w, ssm_conv_b, ssm_dt_bias,
              ssm_a_log, ssm_d, ssm_norm, lru_conv_w, lru_conv_b, lru_w_a, lru_b_a,
              lru_w_x, lru_b_x, lru_a_param, lru_norm, ffn2_norm, ffn2_w_gate, ffn2_w_up,
              ffn2_w_down, final_norm):
    split_points = np.cumsum(np.array(IN_WIDTHS))[:-1].tolist()
    lb_logits = hgrn_lb_logits.astype(jnp.float32)
    lb_e = jnp.exp(lb_logits - jnp.max(lb_logits, axis=0, keepdims=True))
    lb_p = lb_e / jnp.sum(lb_e, axis=0, keepdims=True)
    lower_bounds = jnp.cumsum(lb_p, axis=0) - lb_p[0]
    for l in range(DEPTH):
        x = x + 0.5 * swiglu(rmsnorm(x, ffn1_norm[l]), ffn1_w_gate[l], ffn1_w_up[l], ffn1_w_down[l])
        h = rmsnorm(x, mix_norm[l])
        proj = h @ w_in[l]
        (a_q, a_f, a_i, a_g, b_q, b_k, b_v, c_z, c_xbc, c_dt, d_x, d_g) = jnp.split(proj, split_points, axis=-1)
        y_a = hgrn2_mixer(a_q, a_f, a_i, a_g, lower_bounds[l], hgrn_norm[l])
        y_b = dilated_attention(b_q, b_k, b_v, attn_norm[l])
        y_c = mamba2_mixer(c_z, c_xbc, c_dt, ssm_conv_w[l], ssm_conv_b[l], ssm_dt_bias[l],
                           ssm_a_log[l], ssm_d[l], ssm_norm[l])
        y_d = rglru_mixer(d_x, d_g, lru_conv_w[l], lru_conv_b[l], lru_w_a[l], lru_b_a[l],
                          lru_w_x[l], lru_b_x[l], lru_a_param[l], lru_norm[l])
        y = jnp.concatenate([y_a, y_b, y_c, y_d], axis=-1).astype(x.dtype)
        x = x + y @ w_out[l]
        x = x + 0.5 * swiglu(rmsnorm(x, ffn2_norm[l]), ffn2_w_gate[l], ffn2_w_up[l], ffn2_w_down[l])
    return rmsnorm(x, final_norm)
```

```cpp
#include <hip/hip_runtime.h>
#include <cstdio>
#include <cstdint>
namespace pg8 {
#define PG8_LAS __attribute__((address_space(3)))
typedef unsigned short bf16_t;
typedef short bf16x8 __attribute__((ext_vector_type(8)));
typedef float f32x4 __attribute__((ext_vector_type(4)));
typedef unsigned u32x4 __attribute__((ext_vector_type(4)));
constexpr int BM = 256, BK = 64, HALF = 128, HTB = HALF * BK * 2  , STAGE_BYTES = 8 * HTB, NXCD = 8, WGM = 8;

__host__ __device__ __forceinline__ int lds_byte(int r, int c) { const int st = (r >> 4) * 2 + (c >> 5), rr = r & 15, cc = c & 31, ob = rr * 64 + cc * 2; return st * 1024 + (ob ^ (((ob >> 9) & 1) << 5)); }
__host__ __device__ __forceinline__ void stage_rc(int b, int& R, int& C) { const int st = b / 1024, sb = b % 1024, swz = sb ^ (((sb >> 9) & 1) << 5); R = (st >> 1) * 16 + swz / 64; C = (st & 1) * 32 + (swz % 64) / 2; }
__host__ __device__ __forceinline__ int perm32(int rho) { const int n = rho >> 4, i = rho & 15; return 8 * (i >> 2) + 4 * n + (i & 3); }

struct Unit { int pm, pn; };
struct Gemm { const bf16_t* A; const bf16_t* Bt; int M, N, K; };

template <int GH, bool REV = false> struct StaticOrderT {
    int nM, nN, nwg, G, c;
    __host__ __device__ void init(int M, int N, int G_, int c_) { nM = M / BM; nN = N / BM; nwg = nM * nN; G = G_; c = c_; }
    __host__ __device__ bool next(int i, Unit& u) const {
        if ((long)i * G + c >= nwg) return false;
        const long L = (long)((REV && nwg % G == 0) ? nwg / G - 1 - i : i) * G + c;
        int wgid = (int)L; { const int q = nwg / NXCD, r = nwg % NXCD, xcd = wgid % NXCD, off = wgid / NXCD; wgid = (xcd < r ? xcd * (q + 1) : r * (q + 1) + (xcd - r) * q) + off; }
        const int nig = GH * nN, gid = wgid / nig, fm = gid * GH, gsz = (nM % GH == 0) ? GH : ((nM - fm) < GH ? (nM - fm) : GH);
        u.pm = fm + ((wgid % nig) % gsz); u.pn = (wgid % nig) / gsz; return true;
    }
    __device__ __forceinline__ void a_ready(const Unit&) const {}
    __device__ __forceinline__ void done(const Unit&) const {}
};
typedef StaticOrderT<WGM> StaticOrder;

__device__ __forceinline__ unsigned cvt_pk_bf16(float lo, float hi) { unsigned r; asm volatile("v_cvt_pk_bf16_f32 %0, %1, %2" : "=v"(r) : "v"(lo), "v"(hi)); return r; }
__device__ __forceinline__ float fast_sigmoid(float v) { return __builtin_amdgcn_rcpf(1.0f + __expf(-v)); }
struct EpiSwiglu {
    static constexpr bool PERM = true, AFTER_DRAIN = false;
    bf16_t* H; int ldh; const unsigned* rowss; float inv_d, eps;
    struct Pre { const PG8_LAS unsigned* rs; };
    __device__ __forceinline__ void prefetch(Pre& p, const Unit& u, int wr, int fr, PG8_LAS unsigned char* lds, int ui, int wid, int lane) const {
        PG8_LAS unsigned* area = (PG8_LAS unsigned*)(lds + STAGE_BYTES + (ui & 1) * 1024);
        if (wid < 4) __builtin_amdgcn_global_load_lds((const unsigned*)(rowss + u.pm * BM + wid * 64 + lane), area + wid * 64, 4, 0, 0);
        p.rs = area; }
    __device__ __forceinline__ void operator()(const f32x4 (&acc)[2][2][4][2], const Unit& u, int wr, int wc, int fr, int fq, const Pre& pre) const {
        const int row0 = u.pm * BM + wr * 64 + fr, col0 = u.pn * HALF + wc * 32 + 8 * fq;
        unsigned rsv[2][4];
#pragma unroll
        for (int ai = 0; ai < 2; ++ai)
#pragma unroll
            for (int m = 0; m < 4; ++m) rsv[ai][m] = pre.rs[wr * 64 + fr + ai * HALF + m * 16];
        __builtin_amdgcn_sched_barrier(0);
#pragma unroll
        for (int ai = 0; ai < 2; ++ai)
#pragma unroll
            for (int m = 0; m < 4; ++m) { const int row = row0 + ai * HALF + m * 16; const float ms = (float)rsv[ai][m] * inv_d + eps, rl = __builtin_amdgcn_rsqf(ms) * -1.4426950408889634f;
                float o[8];
#pragma unroll
                for (int n = 0; n < 2; ++n)
#pragma unroll
                    for (int j = 0; j < 4; ++j) { const float g = acc[ai][0][m][n][j], uu = acc[ai][1][m][n][j], t = __builtin_amdgcn_exp2f(g * rl); o[4 * n + j] = (g * uu) * __builtin_amdgcn_rcpf(__builtin_fmaf(t, ms, ms)); }
                u32x4 w; w.x = cvt_pk_bf16(o[0], o[1]); w.y = cvt_pk_bf16(o[2], o[3]); w.z = cvt_pk_bf16(o[4], o[5]); w.w = cvt_pk_bf16(o[6], o[7]);
                *(u32x4*)(H + (size_t)row * ldh + col0) = w; }
    }
};
struct EpiRowScale {
    static constexpr bool PERM = true, AFTER_DRAIN = false;
    bf16_t* O; int ldc; const unsigned* rowss; float inv_d, eps;
    struct Pre { const PG8_LAS unsigned* rs; };
    __device__ __forceinline__ void prefetch(Pre& p, const Unit& u, int wr, int fr, PG8_LAS unsigned char* lds, int ui, int wid, int lane) const {
        PG8_LAS unsigned* area = (PG8_LAS unsigned*)(lds + STAGE_BYTES + (ui & 1) * 1024);
        if (wid < 4) __builtin_amdgcn_global_load_lds((const unsigned*)(rowss + u.pm * BM + wid * 64 + lane), area + wid * 64, 4, 0, 0);
        p.rs = area; }
    __device__ __forceinline__ void operator()(const f32x4 (&acc)[2][2][4][2], const Unit& u, int wr, int wc, int fr, int fq, const Pre& pre) const {
        const int row0 = u.pm * BM + wr * 64 + fr, col0 = u.pn * BM + wc * 32 + 8 * fq;
        unsigned rsv[2][4];
#pragma unroll
        for (int ai = 0; ai < 2; ++ai)
#pragma unroll
            for (int m = 0; m < 4; ++m) rsv[ai][m] = pre.rs[wr * 64 + fr + ai * HALF + m * 16];
        __builtin_amdgcn_sched_barrier(0);
#pragma unroll
        for (int ai = 0; ai < 2; ++ai)
#pragma unroll
            for (int m = 0; m < 4; ++m) { const int row = row0 + ai * HALF + m * 16; const float r = __builtin_amdgcn_rsqf((float)rsv[ai][m] * inv_d + eps);
                bf16_t* rowp = O + (size_t)row * ldc + col0;
#pragma unroll
                for (int bj = 0; bj < 2; ++bj) { const f32x4 v0 = acc[ai][bj][m][0] * r, v1 = acc[ai][bj][m][1] * r;
                    u32x4 w; w.x = cvt_pk_bf16(v0[0], v0[1]); w.y = cvt_pk_bf16(v0[2], v0[3]); w.z = cvt_pk_bf16(v1[0], v1[1]); w.w = cvt_pk_bf16(v1[2], v1[3]);
                    *(u32x4*)(rowp + bj * HALF) = w; } }
    }
};
__device__ __forceinline__ float lo_scale(unsigned hb) { int se = (int)((hb >> 7) & 0xffu) - 15; se = se < 0 ? 0 : se; return __builtin_bit_cast(float, (unsigned)se << 23); }
__device__ __forceinline__ float lo_inv(unsigned hb) { int ie = 269 - (int)((hb >> 7) & 0xffu); ie = ie > 254 ? 254 : ie; return __builtin_bit_cast(float, (unsigned)ie << 23); }
__device__ __forceinline__ float lo_dec(unsigned hb, unsigned byte) { return ((float)byte - 128.0f) * lo_scale(hb); }
__device__ __forceinline__ unsigned lo_enc(float x, unsigned hb) { const float hf = __builtin_bit_cast(float, hb << 16); float t = (x - hf) * lo_inv(hb) + 128.0f; t = fminf(fmaxf(t, 1.0f), 255.0f); return (unsigned)__builtin_rintf(t); }
#ifndef MK_LO
#define MK_LO 0
#endif
__device__ __forceinline__ size_t lo_addr(int pm, int pn, int am, int wave, int lane) { return ((((size_t)(pm * 8 + pn) * 8 + am) * 8 + wave) * 64 + lane) * 16; }
struct EpiResid {
    static constexpr bool PERM = true, AFTER_DRAIN = false;
    bf16_t* xh; unsigned char* xl; unsigned* rowss_out; int ldc; float scale;
    struct Pre {}; __device__ __forceinline__ void prefetch(Pre&, const Unit&, int, int, PG8_LAS unsigned char*, int, int, int) const {}
    __device__ __forceinline__ void operator()(const f32x4 (&acc)[2][2][4][2], const Unit& u, int wr, int wc, int fr, int fq, const Pre&) const {
        const int row0 = u.pm * BM + wr * 64 + fr, col0 = u.pn * BM + wc * 32 + 8 * fq, wave = wr * 4 + wc, lane = fq * 16 + fr;
        constexpr int NB = MK_LO ? 2 : 4;
#pragma unroll
        for (int ab = 0; ab < 8 / NB; ++ab) {
            u32x4 hi[NB][2], lo[NB];
#pragma unroll
            for (int mm = 0; mm < NB; ++mm) { const int am = NB * ab + mm, ai = am >> 2, m = am & 3; if (MK_LO) lo[mm] = *(const u32x4*)(xl + lo_addr(u.pm, u.pn, am, wave, lane)); else lo[mm] = (u32x4){0x80808080u, 0x80808080u, 0x80808080u, 0x80808080u};
#pragma unroll
                for (int bj = 0; bj < 2; ++bj) hi[mm][bj] = *(const u32x4*)(xh + (size_t)(row0 + ai * HALF + m * 16) * ldc + col0 + bj * HALF); }
#pragma unroll
            for (int mm = 0; mm < NB; ++mm) { const int am = NB * ab + mm, ai = am >> 2, m = am & 3; const int row = row0 + ai * HALF + m * 16; float ss = 0.f; u32x4 wl = {0u, 0u, 0u, 0u};
#pragma unroll
                for (int bj = 0; bj < 2; ++bj) { const size_t o2 = (size_t)row * ldc + col0 + bj * HALF; u32x4 wh;
#pragma unroll
                    for (int q = 0; q < 4; ++q) { const unsigned h = hi[mm][bj][q], lw = lo[mm][2 * bj + (q >> 1)] >> (16 * (q & 1));
                        float x0 = __builtin_bit_cast(float, h << 16), x1 = __builtin_bit_cast(float, h & 0xffff0000u); if (MK_LO) { x0 += lo_dec(h & 0xffffu, lw & 0xffu); x1 += lo_dec(h >> 16, (lw >> 8) & 0xffu); }
                        x0 += acc[ai][bj][m][q >> 1][2 * (q & 1)] * scale; x1 += acc[ai][bj][m][q >> 1][2 * (q & 1) + 1] * scale;
                        ss += x0 * x0 + x1 * x1;
                        const unsigned nh = cvt_pk_bf16(x0, x1); wh[q] = nh;
                        if (MK_LO) wl[2 * bj + (q >> 1)] |= (lo_enc(x0, nh & 0xffffu) | (lo_enc(x1, nh >> 16) << 8)) << (16 * (q & 1)); }
                    *(u32x4*)(xh + o2) = wh; }
                if (MK_LO) *(u32x4*)(xl + lo_addr(u.pm, u.pn, am, wave, lane)) = wl;
                ss += __shfl_xor(ss, 16); ss += __shfl_xor(ss, 32);
                if (fq == 0) atomicAdd(rowss_out + row, (unsigned)(ss * 1024.0f + 0.5f)); } }
    }
};
struct EpiNull {
    static constexpr bool PERM = true, AFTER_DRAIN = false;
    float* sink;
    struct Pre {}; __device__ __forceinline__ void prefetch(Pre&, const Unit&, int, int, PG8_LAS unsigned char*, int, int, int) const {}
    __device__ __forceinline__ void operator()(const f32x4 (&acc)[2][2][4][2], const Unit& u, int wr, int wc, int fr, int fq, const Pre&) const {
        float s = 0.f;
#pragma unroll
        for (int ai = 0; ai < 2; ++ai)
#pragma unroll
            for (int bj = 0; bj < 2; ++bj)
#pragma unroll
                for (int m = 0; m < 4; ++m)
#pragma unroll
                    for (int n = 0; n < 2; ++n) s += (acc[ai][bj][m][n][0] + acc[ai][bj][m][n][1]) + (acc[ai][bj][m][n][2] + acc[ai][bj][m][n][3]);
        if (s == 1234567.125f) sink[0] = s;
    }
};
template <class Epi, class Sched, bool ALIGN_EPI = false, bool SP2 = false>
__device__ __forceinline__ void gemm_phase(PG8_LAS unsigned char* lds, const Gemm g, const Sched& S, const Epi& E) {
    int tid_ = threadIdx.x; asm volatile("" : "+v"(tid_));
    const int tid = tid_, wid = __builtin_amdgcn_readfirstlane(tid >> 6), lane = tid & 63, wr = wid >> 2, wc = wid & 3, fr = lane & 15, fq = lane >> 4;
    const int K = g.K, nt = K / BK;
    unsigned voffA[2], voffB[2];
#pragma unroll
    for (int i = 0; i < 2; ++i) { int R, C; stage_rc(tid * 16 + i * 8192, R, C); const int Rb = Epi::PERM ? ((R & ~31) + perm32(R & 31)) : R;
        voffA[i] = (unsigned)(R * K + C) * 2u; voffB[i] = (unsigned)(Rb * K + C) * 2u; }
    const size_t kstep = (size_t)(BK * 2);
    const size_t hstep = (size_t)HALF * K * 2;
    const size_t tstep = 2 * hstep;
    const unsigned ldsw = (unsigned)wid * 1024u;
    const int aoff = lds_byte(wr * 64 + fr, fq * 8), boff = lds_byte(wc * 32 + fr, fq * 8);
#define PG8_SA(b, h) (((b) * 2 + (h)) * HTB)
#define PG8_SB(b, h) ((4 + (b) * 2 + (h)) * HTB)
#define PG8_STAGE(bufoff, gbase, voff) do { _Pragma("unroll") for (int _i = 0; _i < 2; ++_i) \
        __builtin_amdgcn_global_load_lds((const unsigned*)((const char*)(gbase) + (voff)[_i]), (PG8_LAS unsigned*)(lds + (bufoff) + ldsw + _i * 8192), 16, 0, 0); } while (0)
#define PG8_LDA(dst, b, h) do { _Pragma("unroll") for (int m = 0; m < 4; ++m) _Pragma("unroll") for (int k = 0; k < 2; ++k) dst[m][k] = *(const PG8_LAS bf16x8*)(lds + PG8_SA(b, h) + aoff + m * 2048 + k * 1024); } while (0)
#define PG8_LDB(dst, b, h) do { _Pragma("unroll") for (int n = 0; n < 2; ++n) _Pragma("unroll") for (int k = 0; k < 2; ++k) dst[n][k] = *(const PG8_LAS bf16x8*)(lds + PG8_SB(b, h) + boff + n * 2048 + k * 1024); } while (0)
#define PG8_MMA(ai, bj, At, Bt) do { __builtin_amdgcn_s_setprio(1); _Pragma("unroll") for (int m = 0; m < 4; ++m) _Pragma("unroll") for (int n = 0; n < 2; ++n) _Pragma("unroll") for (int k = 0; k < 2; ++k) \
        acc[ai][bj][m][n] = __builtin_amdgcn_mfma_f32_16x16x32_bf16(Bt[n][k], At[m][k], acc[ai][bj][m][n], 0, 0, 0); __builtin_amdgcn_s_setprio(0); } while (0)
#define PG8_WAIT_V(n) asm volatile("s_waitcnt vmcnt(" #n ")" ::: "memory")
#define PG8_WAIT_L(n) asm volatile("s_waitcnt lgkmcnt(" #n ")" ::: "memory")
#define PG8_BAR __builtin_amdgcn_s_barrier()
#define PG8_SCHED __builtin_amdgcn_sched_barrier(0)
    Unit cur, nxt; int ui = 0;
    if (!S.next(0, cur)) return;
    f32x4 acc[2][2][4][2];
#define PG8_ZERO_ACC() do { _Pragma("unroll") for (int a = 0; a < 2; ++a) _Pragma("unroll") for (int b = 0; b < 2; ++b) _Pragma("unroll") for (int m = 0; m < 4; ++m) _Pragma("unroll") for (int n = 0; n < 2; ++n) { \
        typedef unsigned long long u64x2_ __attribute__((ext_vector_type(2))); unsigned long long z0_, z1_; asm volatile("v_mov_b64 %0, 0\n\tv_mov_b64 %1, 0" : "=v"(z0_), "=v"(z1_)); \
        acc[a][b][m][n] = __builtin_bit_cast(f32x4, (u64x2_){z0_, z1_}); } } while (0)
    PG8_ZERO_ACC();
    bf16x8 At[4][2], B0[2][2], B1[2][2];
    const char* cA = (const char*)g.A + (size_t)cur.pm * tstep; const char* cB = (const char*)g.Bt + (size_t)cur.pn * tstep;
    S.a_ready(cur);
    if constexpr (SP2) {
        PG8_STAGE(PG8_SB(0, 0), cB, voffB); PG8_STAGE(PG8_SB(0, 1), cB + hstep, voffB); PG8_STAGE(PG8_SA(0, 0), cA, voffA); PG8_STAGE(PG8_SA(0, 1), cA + hstep, voffA);
        if (wr == 1) PG8_BAR;
        PG8_WAIT_V(2); PG8_BAR;
        PG8_STAGE(PG8_SB(1, 0), cB + kstep, voffB); PG8_STAGE(PG8_SA(1, 0), cA + kstep, voffA); PG8_STAGE(PG8_SB(1, 1), cB + hstep + kstep, voffB);
        PG8_WAIT_V(6); PG8_BAR;
    } else {
        PG8_STAGE(PG8_SB(0, 0), cB, voffB); PG8_STAGE(PG8_SA(0, 0), cA, voffA); PG8_STAGE(PG8_SB(0, 1), cB + hstep, voffB); PG8_STAGE(PG8_SA(0, 1), cA + hstep, voffA);
        if (wr == 1) PG8_BAR;
        PG8_WAIT_V(4); PG8_BAR;
        PG8_STAGE(PG8_SB(1, 0), cB + kstep, voffB); PG8_STAGE(PG8_SA(1, 0), cA + kstep, voffA); PG8_STAGE(PG8_SB(1, 1), cB + hstep + kstep, voffB);
        PG8_WAIT_V(6); PG8_BAR;
    }
    for (;;) {
        const bool has_next = S.next(ui + 1, nxt);
        typename Epi::Pre pre; E.prefetch(pre, cur, wr, fr, lds, ui, wid, lane);
        const char* nA = has_next ? (const char*)g.A + (size_t)nxt.pm * tstep : cA; const char* nB = has_next ? (const char*)g.Bt + (size_t)nxt.pn * tstep : cB;
        for (int t = 0; t < nt; t += 2) {
            const bool last = (t == nt - 2);
            const char* a1 = cA + (size_t)(t + 1) * kstep;
            const char* a2 = last ? nA : cA + (size_t)(t + 2) * kstep; const char* b2 = last ? nB : cB + (size_t)(t + 2) * kstep;
            const char* a3 = a2 + kstep; const char* b3 = b2 + kstep;
            if (last && has_next) S.a_ready(nxt);
            if constexpr (SP2) {
            PG8_LDB(B0, 0, 0); PG8_LDB(B1, 0, 1); PG8_SCHED; PG8_LDA(At, 0, 0); PG8_STAGE(PG8_SA(1, 1), a1 + hstep, voffA);
            PG8_WAIT_V(8); PG8_WAIT_L(0); PG8_BAR; PG8_MMA(0, 0, At, B0); PG8_MMA(0, 1, At, B1); PG8_BAR; PG8_SCHED;
            PG8_LDA(At, 0, 1); PG8_STAGE(PG8_SB(0, 0), b2, voffB); PG8_STAGE(PG8_SB(0, 1), b2 + hstep, voffB); PG8_STAGE(PG8_SA(0, 0), a2, voffA);
            PG8_WAIT_V(8); PG8_WAIT_L(0); PG8_BAR; PG8_MMA(1, 0, At, B0); PG8_MMA(1, 1, At, B1); PG8_BAR; PG8_SCHED;
            PG8_LDB(B0, 1, 0); PG8_LDB(B1, 1, 1); PG8_SCHED; PG8_LDA(At, 1, 0); PG8_STAGE(PG8_SA(0, 1), a2 + hstep, voffA);
            PG8_WAIT_V(8); PG8_WAIT_L(0); PG8_BAR; PG8_MMA(0, 0, At, B0); PG8_MMA(0, 1, At, B1); PG8_BAR; PG8_SCHED;
            PG8_LDA(At, 1, 1); PG8_STAGE(PG8_SB(1, 0), b3, voffB); PG8_STAGE(PG8_SB(1, 1), b3 + hstep, voffB); PG8_STAGE(PG8_SA(1, 0), a3, voffA);
            PG8_WAIT_V(8); PG8_WAIT_L(0); PG8_BAR; PG8_MMA(1, 0, At, B0); PG8_MMA(1, 1, At, B1); PG8_BAR; PG8_SCHED;
            } else {
            PG8_LDB(B0, 0, 0); PG8_SCHED; PG8_LDA(At, 0, 0); PG8_STAGE(PG8_SA(1, 1), a1 + hstep, voffA);
            PG8_WAIT_L(8); PG8_BAR; PG8_WAIT_L(0); PG8_MMA(0, 0, At, B0); PG8_BAR; PG8_SCHED;
            PG8_LDB(B1, 0, 1); PG8_STAGE(PG8_SB(0, 0), b2, voffB);
            PG8_BAR; PG8_WAIT_L(0); PG8_MMA(0, 1, At, B1); PG8_BAR;
            PG8_LDA(At, 0, 1); PG8_STAGE(PG8_SA(0, 0), a2, voffA);
            PG8_BAR; PG8_WAIT_L(0); PG8_MMA(1, 0, At, B0); PG8_BAR; PG8_SCHED;
            PG8_STAGE(PG8_SB(0, 1), b2 + hstep, voffB);
            PG8_WAIT_V(6); PG8_BAR; PG8_MMA(1, 1, At, B1); PG8_BAR;
            PG8_LDB(B0, 1, 0); PG8_SCHED; PG8_LDA(At, 1, 0); PG8_STAGE(PG8_SA(0, 1), a2 + hstep, voffA);
            PG8_WAIT_L(8); PG8_BAR; PG8_WAIT_L(0); PG8_MMA(0, 0, At, B0); PG8_BAR; PG8_SCHED;
            PG8_LDB(B1, 1, 1); PG8_STAGE(PG8_SB(1, 0), b3, voffB);
            PG8_BAR; PG8_WAIT_L(0); PG8_MMA(0, 1, At, B1); PG8_BAR;
            PG8_LDA(At, 1, 1); PG8_STAGE(PG8_SA(1, 0), a3, voffA);
            PG8_BAR; PG8_WAIT_L(0); PG8_MMA(1, 0, At, B0); PG8_BAR; PG8_SCHED;
            PG8_STAGE(PG8_SB(1, 1), b3 + hstep, voffB);
            PG8_WAIT_V(6); PG8_BAR; PG8_MMA(1, 1, At, B1); PG8_BAR;
            }
        }
        if constexpr (ALIGN_EPI) { if (wr == 0) PG8_BAR; }
        if constexpr (!Epi::AFTER_DRAIN) { E(acc, cur, wr, wc, fr, fq, pre); S.done(cur); }
        if (!has_next) break;
        PG8_ZERO_ACC();
        cur = nxt; cA = nA; cB = nB; ++ui;
        if constexpr (ALIGN_EPI) { if (wr == 1) PG8_BAR; }
    }
    PG8_WAIT_V(0);
    if constexpr (!ALIGN_EPI) { if (wr == 0) PG8_BAR; }
    PG8_BAR;
    if constexpr (Epi::AFTER_DRAIN) { E.fused(acc, cur, wr, wc, fr, fq, lds, wid, lane); S.done(cur); }
#undef PG8_SA
#undef PG8_SB
#undef PG8_STAGE
#undef PG8_LDA
#undef PG8_LDB
#undef PG8_MMA
#undef PG8_WAIT_V
#undef PG8_WAIT_L
#undef PG8_BAR
#undef PG8_SCHED
}
}
constexpr int BATCH = 2, SEQ = 16384, DM = 2048, M = BATCH * SEQ, DFF = 5632, NGU = 2 * DFF, NIN = 6152, NPROJ = 6144, DEPTH = 4, GW = 512;
constexpr float NORM_EPS = 1e-6f;
constexpr int PC_AQ = 0, PC_AF = 512, PC_AI = 1024, PC_AG = 1536, PC_BQ = 2048, PC_BK = 2560, PC_BV = 3072, PC_CZ = 3584, PC_CX = 4096, PC_DX = 5120, PC_DG = 5632;
constexpr int NWAVES = 8, NTHR = 512;
#ifndef MK_ONE_LAUNCH
#define MK_ONE_LAUNCH 1
#endif
constexpr size_t MiB = 1u << 20;
constexpr size_t WS_CTL = 0, CTL_ZERO_BYTES = 4 * MiB;
constexpr size_t WS_ROWSS = 64 * 1024;
typedef unsigned rs_t;
constexpr float RS_SCALE = 1024.0f, RS_INV = 1.0f / 1024.0f;
constexpr size_t WS_WGU1 = 4 * MiB, WS_WD1 = 48 * MiB, WS_WGU2 = 70 * MiB, WS_WD2 = 114 * MiB, WS_WIN = 136 * MiB, WS_WOUT = 160 * MiB, WS_WDT = 168 * MiB;
constexpr size_t WS_XB = 170 * MiB;
constexpr size_t WS_HP = 298 * MiB;
constexpr size_t WS_Y = 682 * MiB;
constexpr size_t WS_XBCC = 810 * MiB;
constexpr size_t WS_DTV = 938 * MiB;
constexpr size_t WS_LA = 939 * MiB, WS_LB = 1003 * MiB;
constexpr size_t WS_OA = 1067 * MiB, WS_OB = 1131 * MiB, WS_OC = 1195 * MiB, WS_OD = 1259 * MiB;
constexpr size_t WS_HGU = 1323 * MiB, WS_HGD = 1451 * MiB, WS_HGS = 1452 * MiB;
constexpr size_t WS_WDTB = WS_WDT + 65536, WS_CDEC = WS_WDT + 131072;
constexpr size_t WS_SDST = WS_XBCC, WS_SDPV = WS_OA;
constexpr size_t WS_LRA = WS_LA, WS_LRH = WS_LA + MiB, WS_LRC = WS_LA + 2 * MiB;
constexpr size_t WS_XLO = WS_OB;
constexpr size_t WS_PAO = WS_OC, WS_PAM = WS_OC + 32 * MiB;
constexpr size_t WS_END = 1516 * MiB;
static_assert(WS_ROWSS + 13 * (size_t)M * 8 <= CTL_ZERO_BYTES, "ctl");
static_assert(WS_WGU1 + (size_t)NGU * DM * 2 <= WS_WD1 && WS_WD1 + (size_t)DM * DFF * 2 <= WS_WGU2 && WS_WGU2 + (size_t)NGU * DM * 2 <= WS_WD2 && WS_WD2 + (size_t)DM * DFF * 2 <= WS_WIN &&
              WS_WIN + (size_t)NPROJ * DM * 2 <= WS_WOUT && WS_WOUT + (size_t)DM * DM * 2 <= WS_WDT && WS_WDT + 8 * DM * 4 <= WS_XB && WS_XB + (size_t)M * DM * 2 <= WS_HP &&
              WS_HP + (size_t)M * NPROJ * 2 <= WS_Y && WS_Y + (size_t)M * DM * 2 <= WS_XBCC && WS_XBCC + (size_t)M * 1024 * 4 <= WS_DTV && WS_DTV + (size_t)M * 8 * 4 <= WS_LA &&
              WS_LA + (size_t)M * 512 * 4 <= WS_LB && WS_LB + (size_t)M * 512 * 4 <= WS_OA && WS_OD + (size_t)M * 512 * 4 <= WS_END, "d_ws map");
constexpr int CW_BAR = 1024;
constexpr int RING_BYTES = 131072, LDSCTL_OFF = 143360, MISC_OFF = LDSCTL_OFF + 320, LDS_BYTES = 147456;

#define GAS __attribute__((address_space(1)))
#define LAS __attribute__((address_space(3)))
typedef unsigned short bf16;
typedef unsigned v4u __attribute__((ext_vector_type(4)));
typedef unsigned v2u __attribute__((ext_vector_type(2)));
typedef float f32x4 __attribute__((ext_vector_type(4)));
#define LDS_WAIT() asm volatile("s_waitcnt lgkmcnt(0)" ::: "memory")
typedef float f32x2_t __attribute__((ext_vector_type(2)));
typedef __bf16 bf16x2_t __attribute__((ext_vector_type(2)));
__device__ __forceinline__ unsigned pk2(float lo, float hi) { const f32x2_t v = {lo, hi}; return __builtin_bit_cast(unsigned, __builtin_convertvector(v, bf16x2_t)); }
__device__ __forceinline__ unsigned f2bf(float f) { return pk2(f, f) & 0xffffu; }
__device__ __forceinline__ float bf2f(unsigned b) { return __builtin_bit_cast(float, b << 16); }
__device__ __forceinline__ float bflo(unsigned w) { return __builtin_bit_cast(float, w << 16); }
__device__ __forceinline__ float bfhi(unsigned w) { return __builtin_bit_cast(float, w & 0xffff0000u); }
__device__ __forceinline__ float wave_sum(float v) {
#pragma unroll
    for (int o = 1; o < 64; o <<= 1) v += __shfl_xor(v, o);
    return v;
}
__device__ __forceinline__ float sigmoidf_(float v) { return __builtin_amdgcn_rcpf(1.0f + __builtin_amdgcn_exp2f(v * -1.4426950408889634f)); }
__device__ __forceinline__ float siluf_(float v) { return v * __builtin_amdgcn_rcpf(1.0f + __builtin_amdgcn_exp2f(v * -1.4426950408889634f)); }
__device__ __forceinline__ float softplusf_(float v) { return v > 20.f ? v : log1pf(__expf(v)); }
__device__ __forceinline__ float geluf_(float v) { const float u = 0.7978845608028654f * (v + 0.044715f * v * v * v); return 0.5f * v * (1.0f + tanhf(u)); }
#define XB_TMO      128
#define XB_XCNT(j)  (256  + 64 * (j))
#define XB_XSUB(j)  (1280 + 64 * (j))
#define XB_XGEN(j)  (2304 + 64 * (j))
#define XB_TOP      3328
#define XB_TOPGEN   3392
#define XCD_BAR_WORDS 3456
#define XB_SPIN_CAP (1u << 18)

__device__ __forceinline__ unsigned xb_ld(unsigned* p)              { return __hip_atomic_load(p, __ATOMIC_RELAXED, __HIP_MEMORY_SCOPE_AGENT); }
__device__ __forceinline__ unsigned xb_add(unsigned* p, unsigned v) { return __hip_atomic_fetch_add(p, v, __ATOMIC_RELAXED, __HIP_MEMORY_SCOPE_AGENT); }
__device__ __forceinline__ unsigned xb_xcc_id() { return (unsigned)__builtin_amdgcn_s_getreg((3 << 11) | 20) & 0xFu; }
#define XB_SPIN(cond, bar) do { unsigned _sp = 0; while (cond) { __builtin_amdgcn_s_sleep(1); \
    if ((++_sp & 255u) == 0u) { if (xb_ld(&(bar)[XB_TMO])) break; if (_sp > XB_SPIN_CAP) { atomicAdd(&(bar)[XB_TMO], 1u); break; } } } } while (0)

struct XcdBarrier {
    unsigned* bar; unsigned x;
    volatile LAS unsigned* st;
};

__device__ __forceinline__ XcdBarrier xcd_barrier_post(unsigned* bar, volatile LAS unsigned* st) {
    XcdBarrier b; b.bar = bar; b.x = xb_xcc_id(); b.st = st;
    if (threadIdx.x == 0) (void)xb_add(&bar[XB_XCNT(b.x)], 1u);
    return b;
}
__device__ __forceinline__ void xcd_barrier_complete(unsigned* bar, unsigned x, unsigned& nloc, unsigned& nx) {
    const unsigned G = gridDim.x * gridDim.y * gridDim.z;
    unsigned sum, cnt, mine, sp = 0u;
    for (;;) {
        sum = 0u; cnt = 0u; mine = 0u;
#pragma unroll
        for (unsigned j = 0; j < 16; ++j) { const unsigned c = xb_ld(&bar[XB_XCNT(j)]); sum += c; cnt += (c > 0u) ? 1u : 0u; mine = (j == x) ? c : mine; }
        if (sum == G) break;
        __builtin_amdgcn_s_sleep(1);
        if ((++sp & 255u) == 0u) { if (xb_ld(&bar[XB_TMO])) break; if (sp > XB_SPIN_CAP) { atomicAdd(&bar[XB_TMO], 1u); break; } }
    }
    nloc = mine > 0u ? mine : 1u; nx = cnt > 0u ? cnt : 1u;
}

__device__ __forceinline__ void xcd_barrier(const XcdBarrier& b) {
    asm volatile("s_waitcnt vmcnt(0)" ::: "memory");
    __syncthreads();
    if (threadIdx.x == 0) {
        unsigned* bar = b.bar;
        __builtin_amdgcn_s_waitcnt(0);
        unsigned nloc = b.st[0], nx = b.st[1];
        if (nloc == 0u) { xcd_barrier_complete(bar, b.x, nloc, nx); b.st[0] = nloc; b.st[1] = nx; }
        const unsigned old = xb_add(&bar[XB_XSUB(b.x)], 1u);
        const unsigned gen = old / nloc;
        if (old + 1u == (gen + 1u) * nloc) {
            __builtin_amdgcn_fence(__ATOMIC_RELEASE, "agent");
            asm volatile("s_waitcnt vmcnt(0)" ::: "memory");
            const unsigned og = xb_add(&bar[XB_TOP], 1u);
            const unsigned tg = og / nx;
            if (og + 1u == (tg + 1u) * nx) xb_add(&bar[XB_TOPGEN], 1u);
            else XB_SPIN(xb_ld(&bar[XB_TOPGEN]) == tg, bar);
            __builtin_amdgcn_fence(__ATOMIC_ACQUIRE, "agent");
            xb_add(&bar[XB_XGEN(b.x)], 1u);
            asm volatile("s_waitcnt vmcnt(0)" ::: "memory");
        } else {
            XB_SPIN(xb_ld(&bar[XB_XGEN(b.x)]) == gen, bar);
            __builtin_amdgcn_fence(__ATOMIC_ACQUIRE, "agent");
            asm volatile("s_waitcnt vmcnt(0)" ::: "memory");
        }
    }
    __syncthreads();
}

struct Args {
    const float* in[30];
    float* out; unsigned char* ws; int ph_lo, ph_hi;
};
enum { I_X = 0, I_F1N, I_F1G, I_F1U, I_F1D, I_MIXN, I_WIN, I_WOUT, I_LBL, I_HGN, I_ATN, I_SCW, I_SCB, I_SDTB, I_SALOG, I_SD, I_SNORM, I_LCW, I_LCB, I_LWA, I_LBA, I_LWX, I_LBX, I_LAP, I_LNORM,
       I_F2N, I_F2G, I_F2U, I_F2D, I_FINN };

__device__ __forceinline__ void ph_prep(const float* x, bf16* xb, unsigned char* xlo, rs_t* rowss, int vcu, int G, int tid) {
    const int lane = tid & 63, wave = tid >> 6, wr = wave >> 2, wc = wave & 3, fr = lane & 15, fq = lane >> 4;
    for (int t = vcu; t < (M / 256) * (DM / 256); t += G) { const int pm = t >> 3, pn = t & 7;
#pragma unroll
        for (int am = 0; am < 8; ++am) { const int row = pm * 256 + (am >> 2) * 128 + wr * 64 + (am & 3) * 16 + fr; float ss = 0.f; v4u wl = {0u, 0u, 0u, 0u};
#pragma unroll
            for (int bj = 0; bj < 2; ++bj) { const size_t o2 = (size_t)row * DM + pn * 256 + bj * 128 + wc * 32 + 8 * fq; const f32x4 v0 = *(const f32x4*)(x + o2), v1 = *(const f32x4*)(x + o2 + 4);
                ss += (v0.x * v0.x + v0.y * v0.y) + (v0.z * v0.z + v0.w * v0.w) + (v1.x * v1.x + v1.y * v1.y) + (v1.z * v1.z + v1.w * v1.w);
                v4u w; w.x = pk2(v0.x, v0.y); w.y = pk2(v0.z, v0.w); w.z = pk2(v1.x, v1.y); w.w = pk2(v1.z, v1.w); *(v4u*)(xb + o2) = w;
                if (MK_LO) { wl[2 * bj] = pg8::lo_enc(v0.x, w.x & 0xffffu) | (pg8::lo_enc(v0.y, w.x >> 16) << 8) | (pg8::lo_enc(v0.z, w.y & 0xffffu) << 16) | (pg8::lo_enc(v0.w, w.y >> 16) << 24);
                wl[2 * bj + 1] = pg8::lo_enc(v1.x, w.z & 0xffffu) | (pg8::lo_enc(v1.y, w.z >> 16) << 8) | (pg8::lo_enc(v1.z, w.w & 0xffffu) << 16) | (pg8::lo_enc(v1.w, w.w >> 16) << 24); } }
            if (MK_LO) *(v4u*)(xlo + pg8::lo_addr(pm, pn, am, wave, lane)) = wl;
            ss += __shfl_xor(ss, 16); ss += __shfl_xor(ss, 32);
            if (fq == 0) atomicAdd(rowss + row, (rs_t)(ss * RS_SCALE + 0.5f)); } }
}
struct CvtDesc { const float* W; const float* kscale; bf16* WT; int K, N, mode, r; };
constexpr int CV_G = (DM / 64) * (DFF / 32), CV_IN = (DM / 64) * ((NIN + 31) / 32), CV_OUT = (DM / 64) * (DM / 32);
static_assert((DFF / 64) * (DM / 32) == CV_G, "items");
constexpr int CVM_F1 = 1, CVM_F2 = 2, CVM_IN = 4, CVM_OUT = 8;
__host__ __device__ constexpr int cvt_nitems(int mask) { return ((mask & CVM_F1) ? 3 * CV_G : 0) + ((mask & CVM_F2) ? 3 * CV_G : 0) + ((mask & CVM_IN) ? CV_IN : 0) + ((mask & CVM_OUT) ? CV_OUT : 0); }
__device__ __forceinline__ CvtDesc cvt_decode(const Args& a, unsigned char* ws, int l, int mask, int it) {
    const size_t oF = (size_t)l * DM * DFF, oN = (size_t)l * DM; int r = it; CvtDesc d;
    if (mask & CVM_F1) {
        if (r < CV_G) { d = CvtDesc{a.in[I_F1G] + oF, a.in[I_F1N] + oN, (bf16*)(ws + WS_WGU1), DM, DFF, 1, r}; return d; } r -= CV_G;
        if (r < CV_G) { d = CvtDesc{a.in[I_F1U] + oF, a.in[I_F1N] + oN, (bf16*)(ws + WS_WGU1), DM, DFF, 2, r}; return d; } r -= CV_G;
        if (r < CV_G) { d = CvtDesc{a.in[I_F1D] + oF, nullptr, (bf16*)(ws + WS_WD1), DFF, DM, 0, r}; return d; } r -= CV_G; }
    if (mask & CVM_F2) {
        if (r < CV_G) { d = CvtDesc{a.in[I_F2G] + oF, a.in[I_F2N] + oN, (bf16*)(ws + WS_WGU2), DM, DFF, 1, r}; return d; } r -= CV_G;
        if (r < CV_G) { d = CvtDesc{a.in[I_F2U] + oF, a.in[I_F2N] + oN, (bf16*)(ws + WS_WGU2), DM, DFF, 2, r}; return d; } r -= CV_G;
        if (r < CV_G) { d = CvtDesc{a.in[I_F2D] + oF, nullptr, (bf16*)(ws + WS_WD2), DFF, DM, 0, r}; return d; } r -= CV_G; }
    if (mask & CVM_IN) { if (r < CV_IN) { d = CvtDesc{a.in[I_WIN] + (size_t)l * DM * NIN, a.in[I_MIXN] + oN, (bf16*)(ws + WS_WIN), DM, NIN, 3, r}; return d; } r -= CV_IN; }
    d = CvtDesc{a.in[I_WOUT] + (size_t)l * DM * DM, nullptr, (bf16*)(ws + WS_WOUT), DM, DM, 0, r}; return d;
}
__device__ __forceinline__ void cvt_load(const CvtDesc& d, int lane, f32x4 (&v)[8]) {
    const int nblk = (d.N + 31) / 32, kb = d.r / nblk, nb = d.r % nblk, k0 = 64 * kb, n = 32 * nb + (lane & 7) * 4, kr = lane >> 3;
#pragma unroll
    for (int i = 0; i < 8; ++i) v[i] = (n < d.N) ? *(const f32x4*)(d.W + (size_t)(k0 + kr + 8 * i) * d.N + n) : (f32x4){0.f, 0.f, 0.f, 0.f};
}
__device__ __forceinline__ void cvt_store(const CvtDesc& d, unsigned char* ws, int lane, const f32x4 (&v)[8], LAS float* scr) {
    const int nblk = (d.N + 31) / 32, kb = d.r / nblk, nb = d.r % nblk, k0 = 64 * kb, n0 = 32 * nb, kr = lane >> 3, n4 = (lane & 7) * 4, K = d.K;
#pragma unroll
    for (int i = 0; i < 8; ++i) { const int kk = kr + 8 * i; const float sc = d.kscale ? d.kscale[k0 + kk] : 1.0f; LAS float* s = scr + kk * 33 + n4; s[0] = v[i][0] * sc; s[1] = v[i][1] * sc; s[2] = v[i][2] * sc; s[3] = v[i][3] * sc; }
    LDS_WAIT(); asm volatile("" ::: "memory");
    const int c = lane & 7;
#pragma unroll
    for (int j = 0; j < 4; ++j) { const int nl = (lane >> 3) + 8 * j, n = n0 + nl; const LAS float* s = scr + (8 * c) * 33 + nl;
        const float a0 = s[0 * 33], a1 = s[1 * 33], a2 = s[2 * 33], a3 = s[3 * 33], a4 = s[4 * 33], a5 = s[5 * 33], a6 = s[6 * 33], a7 = s[7 * 33];
        if (n < d.N) {
            int dr = n; bool special = false;
            if (d.mode == 1) dr = 256 * (n >> 7) + (n & 127);
            if (d.mode == 2) dr = 256 * (n >> 7) + 128 + (n & 127);
            if (d.mode == 3) { if (n >= 5128) dr = n - 8; else if (n >= 5120) special = true; }
            v4u o; o.x = pk2(a0, a1); o.y = pk2(a2, a3); o.z = pk2(a4, a5); o.w = pk2(a6, a7);
            if (special) { float* f = (float*)(ws + WS_WDT) + (size_t)(n - 5120) * K + k0 + 8 * c; *(f32x4*)f = (f32x4){a0, a1, a2, a3}; *(f32x4*)(f + 4) = (f32x4){a4, a5, a6, a7};
                *(v4u*)((bf16*)(ws + WS_WDTB) + (size_t)(n - 5120) * K + k0 + 8 * c) = o; }
            else *(v4u*)(d.WT + (size_t)dr * K + k0 + 8 * c) = o;
        } }
    LDS_WAIT(); asm volatile("" ::: "memory");
}
__device__ __forceinline__ void ph_convert(const Args& a, unsigned char* ws, int l, int mask, LAS unsigned char* lds, int gw, int ngw, int wave, int lane) {
    LAS float* scr = (LAS float*)(lds + wave * 16384);
    const int nitems = cvt_nitems(mask);
    int it = gw; if (it >= nitems) return;
    CvtDesc d0 = cvt_decode(a, ws, l, mask, it); f32x4 v[8]; cvt_load(d0, lane, v);
    for (; it < nitems; it += ngw) {
        const int nx = it + ngw; CvtDesc d1 = d0; f32x4 vn[8];
        if (nx < nitems) { d1 = cvt_decode(a, ws, l, mask, nx); cvt_load(d1, lane, vn); }
        else {
#pragma unroll
            for (int i = 0; i < 8; ++i) vn[i] = v[i]; }
        cvt_store(d0, ws, lane, v, scr);
        d0 = d1;
#pragma unroll
        for (int i = 0; i < 8; ++i) v[i] = vn[i];
    }
}
typedef short bf16x8_t __attribute__((ext_vector_type(8)));
typedef short s16x4_t __attribute__((ext_vector_type(4)));
constexpr int HG_NCH = SEQ / 64;
constexpr int HG_TS = 72;
constexpr int HG_RS = 136;
__device__ __forceinline__ float hg_lb(const float* lg, int l, int ch) {
    float mx = lg[ch];
#pragma unroll
    for (int i = 1; i < DEPTH; ++i) mx = fmaxf(mx, lg[i * 512 + ch]);
    float den = 0.f, num = 0.f;
#pragma unroll
    for (int i = 0; i < DEPTH; ++i) { const float e = __expf(lg[i * 512 + ch] - mx); den += e; if (i >= 1 && i <= l) num += e; }
    return num / den;
}
__device__ __forceinline__ unsigned pkbf(float a, float b) { return pk2(a, b); }
struct HgRaw { bf16 z[16], v[16], q[16]; };
template <bool WITHQ> __device__ __forceinline__ void hg_load(HgRaw& R, unsigned char* ws, int unit, int tid) {
    const bf16* proj = (const bf16*)(ws + WS_HP);
    const int h = unit & 3, chunk = (unit >> 2) & (HG_NCH - 1), b = unit >> 10, qt = tid >> 7, col = tid & 127, ch = h * 128 + col;
    const size_t row0 = (size_t)b * SEQ + (size_t)chunk * 64 + 16 * qt;
#pragma unroll
    for (int i = 0; i < 16; ++i) { const bf16* p = proj + (row0 + i) * NPROJ + ch; R.z[i] = p[PC_AF]; R.v[i] = p[PC_AI]; if (WITHQ) R.q[i] = p[PC_AQ]; }
}
__device__ __forceinline__ void hg_p1_unit(const Args& a, unsigned char* ws, int l, int unit, int next, HgRaw& R, LAS unsigned char* lds, int tid_in) {
    int tid = tid_in; asm volatile("" : "+v"(tid));
    const bf16* proj = (const bf16*)(ws + WS_HP); bf16* UT = (bf16*)(ws + WS_HGU); float* DCH = (float*)(ws + WS_HGD);
    const int h = unit & 3, chunk = (unit >> 2) & (HG_NCH - 1), b = unit >> 10;
    const int qt = tid >> 7, col = tid & 127, ch = h * 128 + col, lane = tid & 63, wave = tid >> 6;
    LAS bf16* kT = (LAS bf16*)lds; LAS bf16* vT = kT + 128 * HG_TS; LAS float* tots = (LAS float*)(vT + 128 * HG_TS);
    const float lb = hg_lb(a.in[I_LBL], l, ch);
    const size_t row0 = (size_t)b * SEQ + (size_t)chunk * 64 + 16 * qt;
    float suf[16], kk[16], vv[16];
    { float ff[16];
#pragma unroll
      for (int i = 0; i < 16; ++i) { const float z = bf2f(R.z[i]); vv[i] = bf2f(R.v[i]);
          const float sg = sigmoidf_(z); ff[i] = lb + (1.0f - lb) * sg; kk[i] = (1.0f - lb) * (1.0f - sg); }
      float run = 1.0f;
#pragma unroll
      for (int i = 15; i >= 0; --i) { suf[i] = run; run *= ff[i]; }
      tots[qt * 128 + col] = run; }
    if (next >= 0) hg_load<false>(R, ws, next, tid);
    __syncthreads();
    float post = 1.0f, total = 1.0f;
#pragma unroll
    for (int q = 0; q < 4; ++q) { const float t = tots[q * 128 + col]; total *= t; if (q > qt) post *= t; }
    { unsigned wk[8], wv[8];
#pragma unroll
      for (int i = 0; i < 8; ++i) { const float e0 = kk[2 * i] * (suf[2 * i] * post), e1 = kk[2 * i + 1] * (suf[2 * i + 1] * post); wk[i] = pkbf(e0, e1); wv[i] = pkbf(vv[2 * i], vv[2 * i + 1]); }
      LAS v4u* pk = (LAS v4u*)(kT + col * HG_TS + 16 * qt); LAS v4u* pv = (LAS v4u*)(vT + col * HG_TS + 16 * qt);
      pk[0] = (v4u){wk[0], wk[1], wk[2], wk[3]}; pk[1] = (v4u){wk[4], wk[5], wk[6], wk[7]}; pv[0] = (v4u){wv[0], wv[1], wv[2], wv[3]}; pv[1] = (v4u){wv[4], wv[5], wv[6], wv[7]}; }
    const size_t ubase = ((size_t)(b * 4 + h) * HG_NCH + chunk);
    if (qt == 0) DCH[ubase * 128 + col] = total;
    __syncthreads();
    { const int fr = lane & 15, g = lane >> 4;
      bf16x8_t af[2];
#pragma unroll
      for (int ks = 0; ks < 2; ++ks) af[ks] = *(const LAS bf16x8_t*)(kT + (16 * wave + fr) * HG_TS + 8 * g + 32 * ks);
      bf16* up = UT + ubase * 16384 + (size_t)fr * 128 + 16 * wave + 4 * g;
#pragma unroll
      for (int n = 0; n < 8; ++n) { pg8::f32x4 acc = {0.f, 0.f, 0.f, 0.f};
#pragma unroll
          for (int ks = 0; ks < 2; ++ks) { const bf16x8_t bfr = *(const LAS bf16x8_t*)(vT + (16 * n + fr) * HG_TS + 8 * g + 32 * ks); acc = __builtin_amdgcn_mfma_f32_16x16x32_bf16(af[ks], bfr, acc, 0, 0, 0); }
          *(v2u*)(up + (size_t)(16 * n) * 128) = (v2u){pkbf(acc[0], acc[1]), pkbf(acc[2], acc[3])}; } }
    __syncthreads();
}
__device__ __forceinline__ void hg_p2_item(unsigned char* ws, int item, int tid) {
    const bf16* UT = (const bf16*)(ws + WS_HGU); const float* DCH = (const float*)(ws + WS_HGD); bf16* SPT = (bf16*)(ws + WS_HGS);
    const int bh = item >> 4, v = (item & 15) * 8 + (tid >> 6), k = 2 * (tid & 63);
    typedef float f32x2 __attribute__((ext_vector_type(2)));
    const size_t cb = (size_t)bh * HG_NCH;
    float s0 = 0.f, s1 = 0.f; constexpr int U = 8;
    unsigned ru[U]; f32x2 rd[U];
#pragma unroll
    for (int i = 0; i < U; ++i) { ru[i] = *(const unsigned*)(UT + (cb + i) * 16384 + v * 128 + k); rd[i] = *(const f32x2*)(DCH + (cb + i) * 128 + k); }
    for (int c0 = 0; c0 < HG_NCH; c0 += U) {
        unsigned cu[U]; f32x2 cd[U];
#pragma unroll
        for (int i = 0; i < U; ++i) { cu[i] = ru[i]; cd[i] = rd[i]; }
        if (c0 + U < HG_NCH) {
#pragma unroll
            for (int i = 0; i < U; ++i) { ru[i] = *(const unsigned*)(UT + (cb + c0 + U + i) * 16384 + v * 128 + k); rd[i] = *(const f32x2*)(DCH + (cb + c0 + U + i) * 128 + k); } }
#pragma unroll
        for (int i = 0; i < U; ++i) { *(unsigned*)(SPT + (cb + c0 + i) * 16384 + v * 128 + k) = pkbf(s0, s1); s0 = cd[i].x * s0 + bflo(cu[i]); s1 = cd[i].y * s1 + bfhi(cu[i]); }
    }
}
__device__ __forceinline__ void hg_p3_unit(const Args& a, unsigned char* ws, int l, int unit, int next, HgRaw& R, LAS unsigned char* lds, int tid_in) {
    int tid = tid_in; asm volatile("" : "+v"(tid));
    const bf16* proj = (const bf16*)(ws + WS_HP); const bf16* SPT = (const bf16*)(ws + WS_HGS); bf16* Y = (bf16*)(ws + WS_Y);
    const int h = unit & 3, chunk = (unit >> 2) & (HG_NCH - 1), b = unit >> 10;
    const int qt = tid >> 7, col = tid & 127, ch = h * 128 + col, lane = tid & 63, wave = tid >> 6, fr = lane & 15, g = lane >> 4;
    LAS bf16* Qm = (LAS bf16*)lds; LAS bf16* Qs = Qm + 64 * HG_RS; LAS bf16* Km = Qs + 64 * HG_RS; LAS bf16* vT = Km + 64 * HG_RS; LAS bf16* PT = vT + 128 * HG_TS;
    LAS float* tots = (LAS float*)(PT + 64 * HG_TS); LAS float* ssq = tots + 512;
    const float lb = hg_lb(a.in[I_LBL], l, ch);
    const size_t rowc = (size_t)b * SEQ + (size_t)chunk * 64, row0 = rowc + 16 * qt;
    bf16x8_t sf[4]; v2u grv[4];
    { const size_t sbase = ((size_t)(b * 4 + h) * HG_NCH + chunk) * 16384 + (size_t)(16 * wave + fr) * 128 + 8 * g;
#pragma unroll
      for (int ks = 0; ks < 4; ++ks) sf[ks] = *(const bf16x8_t*)(SPT + sbase + 32 * ks);
#pragma unroll
      for (int j = 0; j < 4; ++j) grv[j] = *(const v2u*)(proj + (rowc + 16 * j + fr) * NPROJ + PC_AG + h * 128 + 16 * wave + 4 * g); }
    float rr[16], kk[16], qq[16], vv[16];
    { float ff[16];
#pragma unroll
      for (int i = 0; i < 16; ++i) { const float z = bf2f(R.z[i]); vv[i] = bf2f(R.v[i]); qq[i] = siluf_(bf2f(R.q[i]));
          const float sg = sigmoidf_(z); ff[i] = lb + (1.0f - lb) * sg; kk[i] = (1.0f - lb) * (1.0f - sg); }
      float run = 1.0f;
      if (qt < 2) {
#pragma unroll
          for (int i = 15; i >= 0; --i) { rr[i] = run; run *= ff[i]; }
      } else {
#pragma unroll
          for (int i = 0; i < 16; ++i) { run *= ff[i]; rr[i] = run; } }
      tots[qt * 128 + col] = run; }
    if (next >= 0) hg_load<true>(R, ws, next, tid);
    if (tid < 128) { const int which = tid >> 6, t = (which ? 32 : 0) + ((tid & 63) >> 2), sq = (which ? 48 : 16) + 4 * (tid & 3); unsigned z0 = 0u; asm volatile("" : "+v"(z0));     *(LAS v2u*)(PT + t * HG_TS + sq) = (v2u){z0, z0}; }
    __syncthreads();
    const float t0_ = tots[col], t1_ = tots[128 + col], t2_ = tots[256 + col];
    const float em = t0_ * t1_, xq = (qt == 0) ? t1_ : (qt == 3) ? t2_ : 1.0f;
    { unsigned wv[8];
#pragma unroll
      for (int i = 0; i < 16; ++i) { const float rv = fmaxf(rr[i] * xq, 1e-30f), ri = __builtin_amdgcn_rcpf(rv); const int t = 16 * qt + i;
          const float ea = (qt < 2) ? ri : rv, eb = (qt < 2) ? rv : ri;
          Qm[t * HG_RS + col] = (bf16)f2bf(qq[i] * ea); Qs[t * HG_RS + col] = (bf16)f2bf(qq[i] * (em * ea)); Km[t * HG_RS + col] = (bf16)f2bf(kk[i] * eb); }
#pragma unroll
      for (int i = 0; i < 8; ++i) wv[i] = pkbf(vv[2 * i], vv[2 * i + 1]);
      LAS v4u* pv = (LAS v4u*)(vT + col * HG_TS + 16 * qt); pv[0] = (v4u){wv[0], wv[1], wv[2], wv[3]}; pv[1] = (v4u){wv[4], wv[5], wv[6], wv[7]}; }
    __syncthreads();
    for (int tt = wave; tt < 10; tt += 8) {
        int ti, tj; { const int ii[10] = {0, 0, 0, 0, 1, 1, 1, 2, 2, 3}, jj[10] = {0, 1, 2, 3, 1, 2, 3, 2, 3, 3}; ti = ii[0]; tj = jj[0];
#pragma unroll
          for (int q = 1; q < 10; ++q) if (tt == q) { ti = ii[q]; tj = jj[q]; } }
        pg8::f32x4 acc = {0.f, 0.f, 0.f, 0.f};
#pragma unroll
        for (int ks = 0; ks < 4; ++ks) { const bf16x8_t af = *(const LAS bf16x8_t*)(Km + (16 * ti + fr) * HG_RS + 8 * g + 32 * ks), bfr = *(const LAS bf16x8_t*)(Qm + (16 * tj + fr) * HG_RS + 8 * g + 32 * ks);
            acc = __builtin_amdgcn_mfma_f32_16x16x32_bf16(af, bfr, acc, 0, 0, 0); }
        const int t = 16 * tj + fr, s0 = 16 * ti + 4 * g;
#pragma unroll
        for (int r = 0; r < 4; ++r) if (s0 + r > t) acc[r] = 0.f;
        *(LAS v2u*)(PT + t * HG_TS + s0) = (v2u){pkbf(acc[0], acc[1]), pkbf(acc[2], acc[3])};
    }
    __syncthreads();
    pg8::f32x4 o[4];
    { bf16x8_t vf[2];
#pragma unroll
      for (int ks = 0; ks < 2; ++ks) vf[ks] = *(const LAS bf16x8_t*)(vT + (16 * wave + fr) * HG_TS + 8 * g + 32 * ks);
#pragma unroll
      for (int j = 0; j < 4; ++j) { pg8::f32x4 acc = {0.f, 0.f, 0.f, 0.f};
#pragma unroll
          for (int ks = 0; ks < 4; ++ks) { const bf16x8_t bfr = *(const LAS bf16x8_t*)(Qs + (16 * j + fr) * HG_RS + 8 * g + 32 * ks); acc = __builtin_amdgcn_mfma_f32_16x16x32_bf16(sf[ks], bfr, acc, 0, 0, 0); }
#pragma unroll
          for (int ks = 0; ks < 2; ++ks) if (ks == 0 || j >= 2) { const bf16x8_t bfr = *(const LAS bf16x8_t*)(PT + (16 * j + fr) * HG_TS + 8 * g + 32 * ks); acc = __builtin_amdgcn_mfma_f32_16x16x32_bf16(vf[ks], bfr, acc, 0, 0, 0); }
          o[j] = acc; } }
#pragma unroll
    for (int j = 0; j < 4; ++j) { float s = (o[j][0] * o[j][0] + o[j][1] * o[j][1]) + (o[j][2] * o[j][2] + o[j][3] * o[j][3]); s += __shfl_xor(s, 16); s += __shfl_xor(s, 32); if (g == 0) ssq[wave * 64 + 16 * j + fr] = s; }
    __syncthreads();
    { const float* nw = a.in[I_HGN] + l * 512 + h * 128 + 16 * wave + 4 * g; const float w0 = nw[0], w1 = nw[1], w2 = nw[2], w3 = nw[3];
#pragma unroll
      for (int j = 0; j < 4; ++j) { const int t = 16 * j + fr; float s = 0.f;
#pragma unroll
          for (int w = 0; w < 8; ++w) s += ssq[w * 64 + t];
          const float r = 1.0f / sqrtf(s * (1.0f / 128.0f) + NORM_EPS);
          const v2u gr = grv[j];
          const float y0 = o[j][0] * r * w0 * siluf_(bflo(gr.x)), y1 = o[j][1] * r * w1 * siluf_(bfhi(gr.x)), y2 = o[j][2] * r * w2 * siluf_(bflo(gr.y)), y3 = o[j][3] * r * w3 * siluf_(bfhi(gr.y));
          *(v2u*)(Y + (rowc + t) * DM + h * 128 + 16 * wave + 4 * g) = (v2u){pkbf(y0, y1), pkbf(y2, y3)}; } }
    __syncthreads();
}
constexpr int SD_TS = 72, SD_RS = 136;
#define SD_CONV8(dst, tok0) do { _Pragma("unroll") for (int i_ = 0; i_ < 8; ++i_) { const float xn_ = bf2f(xr[(tok0) + i_]); \
        const float y_ = cb + cw0 * xm3 + cw1 * xm2 + cw2 * xm1 + cw3 * xn_; xm3 = xm2; xm2 = xm1; xm1 = xn_; dst[i_] = siluf_(y_); } } while (0)
__device__ __forceinline__ void sd_p1_unit(const Args& a, unsigned char* ws, int l, const rs_t* rowss, int unit, LAS unsigned char* lds, int tid_in) {
    int tid = tid_in; asm volatile("" : "+v"(tid));
    const bf16* proj = (const bf16*)(ws + WS_HP); const bf16* xb = (const bf16*)(ws + WS_XB); const bf16* wdtb = (const bf16*)(ws + WS_WDTB);
    bf16* STATES = (bf16*)(ws + WS_SDST); float* CDEC = (float*)(ws + WS_CDEC); float* DTV = (float*)(ws + WS_DTV);
    const int chunk = unit & 255, b = unit >> 8, lane = tid & 63, wave = tid >> 6, fr = lane & 15, g = lane >> 4;
    const size_t row0 = (size_t)b * SEQ + (size_t)chunk * 64;
    LAS float* dtl = (LAS float*)lds; LAS float* acs = dtl + 512;
    LAS float* part = (LAS float*)(lds + 4096);
    LAS bf16* XT = (LAS bf16*)(lds + 4096); LAS bf16* BT = XT + 512 * SD_TS;
    { pg8::f32x4 acc[4];
#pragma unroll
      for (int tt = 0; tt < 4; ++tt) acc[tt] = (pg8::f32x4){0.f, 0.f, 0.f, 0.f};
#pragma unroll 4
      for (int ks = 0; ks < 8; ++ks) { const int k = 256 * wave + 32 * ks + 8 * g;
          bf16x8_t bfr = {0, 0, 0, 0, 0, 0, 0, 0}; if (fr < 8) bfr = *(const bf16x8_t*)(wdtb + fr * DM + k);
#pragma unroll
          for (int tt = 0; tt < 4; ++tt) { const bf16x8_t af = *(const bf16x8_t*)(xb + (row0 + 16 * tt + fr) * DM + k); acc[tt] = __builtin_amdgcn_mfma_f32_16x16x32_bf16(af, bfr, acc[tt], 0, 0, 0); } }
      if (fr < 8) {
#pragma unroll
          for (int tt = 0; tt < 4; ++tt)
#pragma unroll
              for (int r = 0; r < 4; ++r) part[(wave * 64 + 16 * tt + 4 * g + r) * 8 + fr] = acc[tt][r]; } }
    __syncthreads();
    { const int t = tid >> 3, h = tid & 7; float s = 0.f;
#pragma unroll
      for (int w = 0; w < 8; ++w) s += part[(w * 64 + t) * 8 + h];
      const float r = 1.0f / sqrtf((float)rowss[row0 + t] * (RS_INV / DM) + NORM_EPS);
      const float dt = softplusf_(s * r + a.in[I_SDTB][l * 8 + h]); dtl[t * 8 + h] = dt; DTV[(row0 + t) * 8 + h] = dt; }
    __syncthreads();
    if (tid < 8) { const float An = -__expf(a.in[I_SALOG][l * 8 + tid]); float run = 0.f; for (int t = 0; t < 64; ++t) { run += dtl[t * 8 + tid] * An; acs[t * 8 + tid] = run; }
        CDEC[(size_t)(b * 256 + chunk) * 8 + tid] = __expf(run); }
    __syncthreads();
    { const float* cwp = a.in[I_SCW] + (size_t)l * 4 * 1024; const float* cbp = a.in[I_SCB] + (size_t)l * 1024;
#pragma unroll
      for (int pass = 0; pass < 2; ++pass) { if (pass == 1 && tid >= 256) break;
          const int c = pass * 512 + tid; const float cw0 = cwp[c], cw1 = cwp[1024 + c], cw2 = cwp[2048 + c], cw3 = cwp[3072 + c], cb = cbp[c];
          const bf16* xp = proj + row0 * NPROJ + PC_CX + c;
          float xm3 = 0.f, xm2 = 0.f, xm1 = 0.f; if (chunk > 0) { xm3 = bf2f(xp[-3 * (ptrdiff_t)NPROJ]); xm2 = bf2f(xp[-2 * (ptrdiff_t)NPROJ]); xm1 = bf2f(xp[-(ptrdiff_t)NPROJ]); }
          const int h = tid >> 6; const float al = acs[63 * 8 + h];
          LAS bf16* dst = (pass == 0) ? (XT + tid * SD_TS) : (BT + tid * SD_TS);
          bf16 xr[64];
#pragma unroll
          for (int t = 0; t < 64; ++t) xr[t] = xp[(ptrdiff_t)t * NPROJ];
#pragma unroll
          for (int s8 = 0; s8 < 8; ++s8) { float v[8]; SD_CONV8(v, 8 * s8);
              if (pass == 0) {
#pragma unroll
                  for (int i = 0; i < 8; ++i) { const int s = 8 * s8 + i; v[i] *= dtl[s * 8 + h] * __expf(al - acs[s * 8 + h]); } }
              *(LAS v4u*)(dst + 8 * s8) = (v4u){pkbf(v[0], v[1]), pkbf(v[2], v[3]), pkbf(v[4], v[5]), pkbf(v[6], v[7])}; } } }
    __syncthreads();
    { const int grp = wave >> 2; bf16* sp = STATES + ((size_t)(b * 256 + chunk) * 8 + wave) * 8192;
#pragma unroll 1
      for (int mt = 0; mt < 4; ++mt) { bf16x8_t bfx[2];
#pragma unroll
          for (int ks = 0; ks < 2; ++ks) bfx[ks] = *(const LAS bf16x8_t*)(XT + (wave * 64 + 16 * mt + fr) * SD_TS + 8 * g + 32 * ks);
#pragma unroll
          for (int nt = 0; nt < 8; ++nt) { pg8::f32x4 acc = {0.f, 0.f, 0.f, 0.f};
#pragma unroll
              for (int ks = 0; ks < 2; ++ks) { const bf16x8_t afn = *(const LAS bf16x8_t*)(BT + (grp * 128 + 16 * nt + fr) * SD_TS + 8 * g + 32 * ks); acc = __builtin_amdgcn_mfma_f32_16x16x32_bf16(afn, bfx[ks], acc, 0, 0, 0); }
              *(v2u*)(sp + (16 * mt + fr) * 128 + 16 * nt + 4 * g) = (v2u){pkbf(acc[0], acc[1]), pkbf(acc[2], acc[3])}; } } }
    __syncthreads();
}
__device__ __forceinline__ void sd_p2_item(unsigned char* ws, int item, int tid) {
    const bf16* STATES = (const bf16*)(ws + WS_SDST); const float* CDEC = (const float*)(ws + WS_CDEC); bf16* PREV = (bf16*)(ws + WS_SDPV);
    const int bh = item >> 3, b = bh >> 3, h = bh & 7, p = (item & 7) * 8 + (tid >> 6), n = 2 * (tid & 63);
    typedef float f32x2 __attribute__((ext_vector_type(2)));
    float s0 = 0.f, s1 = 0.f; constexpr int U = 8;
    unsigned ru[U]; float rd[U];
#define SD_IDX(c_) (((size_t)(b * 256 + (c_)) * 8 + h) * 8192 + p * 128 + n)
#pragma unroll
    for (int i = 0; i < U; ++i) { ru[i] = *(const unsigned*)(STATES + SD_IDX(i)); rd[i] = CDEC[(size_t)(b * 256 + i) * 8 + h]; }
    for (int c0 = 0; c0 < 256; c0 += U) {
        unsigned cu[U]; float cd[U];
#pragma unroll
        for (int i = 0; i < U; ++i) { cu[i] = ru[i]; cd[i] = rd[i]; }
        if (c0 + U < 256) {
#pragma unroll
            for (int i = 0; i < U; ++i) { ru[i] = *(const unsigned*)(STATES + SD_IDX(c0 + U + i)); rd[i] = CDEC[(size_t)(b * 256 + c0 + U + i) * 8 + h]; } }
#pragma unroll
        for (int i = 0; i < U; ++i) { *(unsigned*)(PREV + SD_IDX(c0 + i)) = pkbf(s0, s1); s0 = cd[i] * s0 + bflo(cu[i]); s1 = cd[i] * s1 + bfhi(cu[i]); }
    }
#undef SD_IDX
}
__device__ __forceinline__ void sd_p3_unit(const Args& a, unsigned char* ws, int l, int unit, LAS unsigned char* lds, int tid_in) {
    int tid = tid_in; asm volatile("" : "+v"(tid));
    const bf16* proj = (const bf16*)(ws + WS_HP); const bf16* PREV = (const bf16*)(ws + WS_SDPV); const float* DTV = (const float*)(ws + WS_DTV); bf16* Y = (bf16*)(ws + WS_Y);
    const int grp = unit & 1, chunk = (unit >> 1) & 255, b = unit >> 9, lane = tid & 63, wave = tid >> 6, fr = lane & 15, g = lane >> 4;
    const size_t row0 = (size_t)b * SEQ + (size_t)chunk * 64;
    LAS float* dtl = (LAS float*)lds; LAS float* acs = dtl + 256; LAS float* ssq = acs + 256;
    LAS bf16* XT = (LAS bf16*)(lds + 4096); LAS bf16* Brm = XT + 256 * SD_TS; LAS bf16* Crm = Brm + 64 * SD_RS;
    if (tid < 256) { const int t = tid >> 2, hh = tid & 3; dtl[t * 4 + hh] = DTV[(row0 + t) * 8 + 4 * grp + hh]; }
    v2u zrv[2][4];
    { const int hh_ = wave >> 1, half_ = wave & 1;
#pragma unroll
      for (int pt = 0; pt < 2; ++pt) {
#pragma unroll
          for (int j = 0; j < 4; ++j) zrv[pt][j] = *(const v2u*)(proj + (row0 + 16 * j + fr) * NPROJ + PC_CZ + grp * 256 + hh_ * 64 + 16 * (2 * half_ + pt) + 4 * g); } }
    __syncthreads();
    if (tid < 4) { const float An = -__expf(a.in[I_SALOG][l * 8 + 4 * grp + tid]); float run = 0.f; for (int t = 0; t < 64; ++t) { run += dtl[t * 4 + tid] * An; acs[t * 4 + tid] = run; } }
    { const float* cwp = a.in[I_SCW] + (size_t)l * 4 * 1024; const float* cbp = a.in[I_SCB] + (size_t)l * 1024;
      const int c = (tid < 256) ? (grp * 256 + tid) : (tid < 384) ? (512 + grp * 128 + (tid - 256)) : (768 + grp * 128 + (tid - 384));
      const float cw0 = cwp[c], cw1 = cwp[1024 + c], cw2 = cwp[2048 + c], cw3 = cwp[3072 + c], cb = cbp[c];
      const bf16* xp = proj + row0 * NPROJ + PC_CX + c;
      float xm3 = 0.f, xm2 = 0.f, xm1 = 0.f; if (chunk > 0) { xm3 = bf2f(xp[-3 * (ptrdiff_t)NPROJ]); xm2 = bf2f(xp[-2 * (ptrdiff_t)NPROJ]); xm1 = bf2f(xp[-(ptrdiff_t)NPROJ]); }
      bf16 xr[64];
#pragma unroll
      for (int t = 0; t < 64; ++t) xr[t] = xp[(ptrdiff_t)t * NPROJ];
#pragma unroll
      for (int s8 = 0; s8 < 8; ++s8) { float v[8]; SD_CONV8(v, 8 * s8);
          if (tid < 256) *(LAS v4u*)(XT + tid * SD_TS + 8 * s8) = (v4u){pkbf(v[0], v[1]), pkbf(v[2], v[3]), pkbf(v[4], v[5]), pkbf(v[6], v[7])};
          else { LAS bf16* d = ((tid < 384) ? Brm : Crm) + (8 * s8) * SD_RS + ((tid - 256) & 127);
#pragma unroll
              for (int i = 0; i < 8; ++i) d[i * SD_RS] = (bf16)f2bf(v[i]); } } }
    __syncthreads();
    const int hh = wave >> 1, half = wave & 1, hd = 4 * grp + hh;
    bf16x8_t mf[4][2];
    { const float Dk = a.in[I_SD][l * 8 + hd];
      float acl[4], acsv[16], dts[16];
#pragma unroll
      for (int j = 0; j < 4; ++j) acl[j] = acs[(16 * j + fr) * 4 + hh];
#pragma unroll
      for (int i = 0; i < 4; ++i)
#pragma unroll
          for (int r = 0; r < 4; ++r) { acsv[4 * i + r] = acs[(16 * i + 4 * g + r) * 4 + hh]; dts[4 * i + r] = dtl[(16 * i + 4 * g + r) * 4 + hh]; }
#pragma unroll
      for (int j = 0; j < 4; ++j) { unsigned pw[4][2];
#pragma unroll
          for (int i = 0; i < 4; ++i) { pw[i][0] = 0u; pw[i][1] = 0u;
              if (i <= j) { pg8::f32x4 acc = {0.f, 0.f, 0.f, 0.f};
#pragma unroll
                  for (int ks = 0; ks < 4; ++ks) { const bf16x8_t af = *(const LAS bf16x8_t*)(Brm + (16 * i + fr) * SD_RS + 8 * g + 32 * ks), bfr = *(const LAS bf16x8_t*)(Crm + (16 * j + fr) * SD_RS + 8 * g + 32 * ks);
                      acc = __builtin_amdgcn_mfma_f32_16x16x32_bf16(af, bfr, acc, 0, 0, 0); }
                  float m[4];
#pragma unroll
                  for (int r = 0; r < 4; ++r) { const int s = 16 * i + 4 * g + r, ll = 16 * j + fr; float v = acc[r] * __expf(fminf(acl[j] - acsv[4 * i + r], 0.f)) * dts[4 * i + r]; if (s > ll) v = 0.f; if (s == ll) v += Dk; m[r] = v; }
                  pw[i][0] = pkbf(m[0], m[1]); pw[i][1] = pkbf(m[2], m[3]); } }
          mf[j][0] = __builtin_bit_cast(bf16x8_t, (v4u){pw[0][0], pw[0][1], pw[1][0], pw[1][1]}); mf[j][1] = __builtin_bit_cast(bf16x8_t, (v4u){pw[2][0], pw[2][1], pw[3][0], pw[3][1]}); } }
    pg8::f32x4 yv[2][4];
    { const bf16* pv = PREV + ((size_t)(b * 256 + chunk) * 8 + hd) * 8192;
#pragma unroll
      for (int pt = 0; pt < 2; ++pt) { const int prow = 16 * (2 * half + pt) + fr;
          bf16x8_t pf[4];
#pragma unroll
          for (int ks = 0; ks < 4; ++ks) pf[ks] = *(const bf16x8_t*)(pv + prow * 128 + 8 * g + 32 * ks);
          bf16x8_t xf[2];
#pragma unroll
          for (int ks = 0; ks < 2; ++ks) { const v2u lo = *(const LAS v2u*)(XT + (hh * 64 + prow) * SD_TS + 32 * ks + 4 * g), hi = *(const LAS v2u*)(XT + (hh * 64 + prow) * SD_TS + 32 * ks + 16 + 4 * g);
              xf[ks] = __builtin_bit_cast(bf16x8_t, (v4u){lo.x, lo.y, hi.x, hi.y}); }
#pragma unroll
          for (int j = 0; j < 4; ++j) { pg8::f32x4 off = {0.f, 0.f, 0.f, 0.f};
#pragma unroll
              for (int ks = 0; ks < 4; ++ks) { const bf16x8_t bfr = *(const LAS bf16x8_t*)(Crm + (16 * j + fr) * SD_RS + 8 * g + 32 * ks); off = __builtin_amdgcn_mfma_f32_16x16x32_bf16(pf[ks], bfr, off, 0, 0, 0); }
              const float el = __expf(acs[(16 * j + fr) * 4 + hh]);
              pg8::f32x4 acc = off * el;
              acc = __builtin_amdgcn_mfma_f32_16x16x32_bf16(xf[0], mf[j][0], acc, 0, 0, 0);
              if (j >= 2) acc = __builtin_amdgcn_mfma_f32_16x16x32_bf16(xf[1], mf[j][1], acc, 0, 0, 0);
              yv[pt][j] = acc; } } }
    const int cbase = grp * 256 + hh * 64;
#pragma unroll
    for (int j = 0; j < 4; ++j) { const int ll = 16 * j + fr; float s = 0.f;
#pragma unroll
        for (int pt = 0; pt < 2; ++pt) { const v2u zr = zrv[pt][j];
            yv[pt][j][0] *= siluf_(bflo(zr.x)); yv[pt][j][1] *= siluf_(bfhi(zr.x)); yv[pt][j][2] *= siluf_(bflo(zr.y)); yv[pt][j][3] *= siluf_(bfhi(zr.y));
            s += (yv[pt][j][0] * yv[pt][j][0] + yv[pt][j][1] * yv[pt][j][1]) + (yv[pt][j][2] * yv[pt][j][2] + yv[pt][j][3] * yv[pt][j][3]); }
        s += __shfl_xor(s, 16); s += __shfl_xor(s, 32); if (g == 0) ssq[wave * 64 + ll] = s; }
    __syncthreads();
#pragma unroll
    for (int j = 0; j < 4; ++j) { const int ll = 16 * j + fr; float s = 0.f;
#pragma unroll
        for (int w = 0; w < 8; ++w) s += ssq[w * 64 + ll];
        const float r = 1.0f / sqrtf(s * (1.0f / 256.0f) + NORM_EPS);
#pragma unroll
        for (int pt = 0; pt < 2; ++pt) { const int cc = cbase + 16 * (2 * half + pt) + 4 * g; const float* nw = a.in[I_SNORM] + l * 512 + cc;
            *(v2u*)(Y + (row0 + ll) * DM + 1024 + cc) = (v2u){pkbf(yv[pt][j][0] * r * nw[0], yv[pt][j][1] * r * nw[1]), pkbf(yv[pt][j][2] * r * nw[2], yv[pt][j][3] * r * nw[3])}; } }
    __syncthreads();
}
constexpr int LR_RS = 520;
struct LruW { bf16x8_t wa[4][2], wx[4][2]; };
__device__ __forceinline__ void lru_load_w(const Args& a, int l, int wave, int lane, LruW& W) {
    const int fr = lane & 15, g = lane >> 4; const float* wa = a.in[I_LWA] + ((size_t)l * 8 + wave) * 4096; const float* wx = a.in[I_LWX] + ((size_t)l * 8 + wave) * 4096;
#pragma unroll
    for (int nt = 0; nt < 4; ++nt)
#pragma unroll
        for (int ks = 0; ks < 2; ++ks) { unsigned pa[4], px[4];
#pragma unroll
            for (int e = 0; e < 4; ++e) { const int i0 = 32 * ks + 8 * g + 2 * e, j = 16 * nt + fr; pa[e] = pkbf(wa[i0 * 64 + j], wa[(i0 + 1) * 64 + j]); px[e] = pkbf(wx[i0 * 64 + j], wx[(i0 + 1) * 64 + j]); }
            W.wa[nt][ks] = __builtin_bit_cast(bf16x8_t, (v4u){pa[0], pa[1], pa[2], pa[3]}); W.wx[nt][ks] = __builtin_bit_cast(bf16x8_t, (v4u){px[0], px[1], px[2], px[3]}); }
}
template <bool FINAL> __device__ __forceinline__ void lru_unit(const Args& a, unsigned char* ws, int l, int unit, const LruW& W, LAS unsigned char* lds, int tid_in) {
    int tid = tid_in; asm volatile("" : "+v"(tid));
    const bf16* proj = (const bf16*)(ws + WS_HP); float* LRA = (float*)(ws + WS_LRA); float* LRH = (float*)(ws + WS_LRH); const float* LRC = (const float*)(ws + WS_LRC); bf16* Y = (bf16*)(ws + WS_Y);
    const int chunk = unit & 255, b = unit >> 8, lane = tid & 63, wave = tid >> 6, fr = lane & 15, g = lane >> 4;
    const size_t row0 = (size_t)b * SEQ + (size_t)chunk * 64;
    LAS bf16* Xrm = (LAS bf16*)lds; LAS bf16* Hrm = Xrm + 64 * LR_RS; LAS float* ssq = (LAS float*)(lds + 2 * 64 * LR_RS * 2); LAS float* rst = ssq + 512;
    { const int c = tid; const float* cwp = a.in[I_LCW] + (size_t)l * 4 * 512; const float cw0 = cwp[c], cw1 = cwp[512 + c], cw2 = cwp[1024 + c], cw3 = cwp[1536 + c], cb = a.in[I_LCB][l * 512 + c];
      const bf16* xp = proj + row0 * NPROJ + PC_DX + c;
      float xm3 = 0.f, xm2 = 0.f, xm1 = 0.f; if (chunk > 0) { xm3 = bf2f(xp[-3 * (ptrdiff_t)NPROJ]); xm2 = bf2f(xp[-2 * (ptrdiff_t)NPROJ]); xm1 = bf2f(xp[-(ptrdiff_t)NPROJ]); }
      bf16 xr[64];
#pragma unroll
      for (int t = 0; t < 64; ++t) xr[t] = xp[(ptrdiff_t)t * NPROJ];
#pragma unroll
      for (int t = 0; t < 64; ++t) { const float xn = bf2f(xr[t]); const float y = cb + cw0 * xm3 + cw1 * xm2 + cw2 * xm1 + cw3 * xn; xm3 = xm2; xm2 = xm1; xm1 = xn; Xrm[t * LR_RS + c] = (bf16)f2bf(y); } }
    __syncthreads();
    float ssp[4][4];
#pragma unroll
    for (int mt = 0; mt < 4; ++mt)
#pragma unroll
        for (int r = 0; r < 4; ++r) ssp[mt][r] = 0.f;
#pragma unroll
    for (int nt = 0; nt < 4; ++nt) {
        const int c = wave * 64 + 16 * nt + fr;
        const float ba = a.in[I_LBA][l * 512 + c], bx = a.in[I_LBX][l * 512 + c], spn = softplusf_(-a.in[I_LAP][l * 512 + c]);
        float av[4][4], bv[4][4]; const float carry0 = FINAL ? LRC[((size_t)b * 256 + chunk) * 512 + c] : 0.f;
#pragma unroll
        for (int mt = 0; mt < 4; ++mt) { pg8::f32x4 ra = {0.f, 0.f, 0.f, 0.f}, ri = {0.f, 0.f, 0.f, 0.f};
#pragma unroll
            for (int ks = 0; ks < 2; ++ks) { const bf16x8_t af = *(const LAS bf16x8_t*)(Xrm + (16 * mt + fr) * LR_RS + wave * 64 + 32 * ks + 8 * g);
                ra = __builtin_amdgcn_mfma_f32_16x16x32_bf16(af, W.wa[nt][ks], ra, 0, 0, 0); ri = __builtin_amdgcn_mfma_f32_16x16x32_bf16(af, W.wx[nt][ks], ri, 0, 0, 0); }
#pragma unroll
            for (int r = 0; r < 4; ++r) { const float rg = sigmoidf_(ra[r] + ba), ig = sigmoidf_(ri[r] + bx), la = -8.0f * rg * spn, xc = bf2f(Xrm[(16 * mt + 4 * g + r) * LR_RS + c]);
                const float x2 = 2.0f * la, em = (x2 > -0.25f) ? -x2 * (1.0f + x2 * (0.5f + x2 * (0.16666667f + x2 * (0.041666668f + x2 * 0.0083333338f)))) : 1.0f - __expf(x2);
                av[mt][r] = __expf(la); bv[mt][r] = __builtin_amdgcn_sqrtf(fmaxf(em, 0.f)) * (ig * xc); } }
        float carry = carry0, atot = 1.f;
#pragma unroll
        for (int mt = 0; mt < 4; ++mt) {
            float As = av[mt][0], Hs = bv[mt][0];
#pragma unroll
            for (int r = 1; r < 4; ++r) { Hs = av[mt][r] * Hs + bv[mt][r]; As *= av[mt][r]; }
            float Ai = As, Hi = Hs;
            { const float Ap = __shfl_up(Ai, 16), Hp = __shfl_up(Hi, 16); if (g >= 1) { Hi = Ai * Hp + Hi; Ai = Ai * Ap; } }
            { const float Ap = __shfl_up(Ai, 32), Hp = __shfl_up(Hi, 32); if (g >= 2) { Hi = Ai * Hp + Hi; Ai = Ai * Ap; } }
            float Ae = __shfl_up(Ai, 16), He = __shfl_up(Hi, 16); if (g == 0) { Ae = 1.f; He = 0.f; }
            const float At = __shfl(Ai, fr + 48), Ht = __shfl(Hi, fr + 48);
            if (FINAL) { float hc = Ae * carry + He;
#pragma unroll
                for (int r = 0; r < 4; ++r) { hc = av[mt][r] * hc + bv[mt][r]; const float gt = bf2f(proj[(row0 + 16 * mt + 4 * g + r) * NPROJ + PC_DG + c]); const float u2 = 1.5957691216057308f * (gt + 0.044715f * gt * gt * gt); const float o = hc * gt * sigmoidf_(u2);
                    Hrm[(16 * mt + 4 * g + r) * LR_RS + c] = (bf16)f2bf(o); ssp[mt][r] += o * o; } }
            carry = At * carry + Ht; atot *= At;
        }
        if (!FINAL && g == 0) { LRA[((size_t)b * 256 + chunk) * 512 + c] = atot; LRH[((size_t)b * 256 + chunk) * 512 + c] = carry; }
        asm volatile("" ::: "memory");
    }
    if (FINAL) {
#pragma unroll
        for (int mt = 0; mt < 4; ++mt)
#pragma unroll
            for (int r = 0; r < 4; ++r) { float s = ssp[mt][r]; s += __shfl_xor(s, 1); s += __shfl_xor(s, 2); s += __shfl_xor(s, 4); s += __shfl_xor(s, 8); if (fr == 0) ssq[wave * 64 + 16 * mt + 4 * g + r] = s; }
        __syncthreads();
        if (tid < 64) { float s = 0.f;
#pragma unroll
            for (int w = 0; w < 8; ++w) s += ssq[w * 64 + tid];
            rst[tid] = 1.0f / sqrtf(s * (1.0f / 512.0f) + NORM_EPS); }
        __syncthreads();
        { const float* nw = a.in[I_LNORM] + l * 512;
#pragma unroll
          for (int i = 0; i < 8; ++i) { const int item = tid + NTHR * i, t = item >> 6, cg = (item & 63) * 8; const float rs = rst[t]; const v4u hv = *(const LAS v4u*)(Hrm + t * LR_RS + cg);
              const f32x4 w0 = *(const f32x4*)(nw + cg), w1 = *(const f32x4*)(nw + cg + 4);
              v4u o; o.x = pkbf(bflo(hv.x) * rs * w0.x, bfhi(hv.x) * rs * w0.y); o.y = pkbf(bflo(hv.y) * rs * w0.z, bfhi(hv.y) * rs * w0.w); o.z = pkbf(bflo(hv.z) * rs * w1.x, bfhi(hv.z) * rs * w1.y); o.w = pkbf(bflo(hv.w) * rs * w1.z, bfhi(hv.w) * rs * w1.w);
              *(v4u*)(Y + (row0 + t) * DM + 1536 + cg) = o; } }
    }
    __syncthreads();
}
__device__ __forceinline__ void lru_p2_item(unsigned char* ws, int item, int tid) {
    const float* LRA = (const float*)(ws + WS_LRA); const float* LRH = (const float*)(ws + WS_LRH); float* LRC = (float*)(ws + WS_LRC);
    const int idx = item * NTHR + tid, b = idx >> 9, c = idx & 511; const size_t base = (size_t)b * 256 * 512 + c;
    float hh = 0.f; constexpr int U = 16;
    float ra[U], rb[U];
#pragma unroll
    for (int i = 0; i < U; ++i) { ra[i] = LRA[base + (size_t)i * 512]; rb[i] = LRH[base + (size_t)i * 512]; }
    for (int k0 = 0; k0 < 256; k0 += U) {
        float ca[U], cbv[U];
#pragma unroll
        for (int i = 0; i < U; ++i) { ca[i] = ra[i]; cbv[i] = rb[i]; }
        if (k0 + U < 256) {
#pragma unroll
            for (int i = 0; i < U; ++i) { ra[i] = LRA[base + (size_t)(k0 + U + i) * 512]; rb[i] = LRH[base + (size_t)(k0 + U + i) * 512]; } }
#pragma unroll
        for (int i = 0; i < U; ++i) { LRC[base + (size_t)(k0 + i) * 512] = hh; hh = ca[i] * hh + cbv[i]; }
    }
}
typedef short v4i16_t __attribute__((ext_vector_type(4)));
constexpr float AT_DEFER = 8.0f;
constexpr int AT_VS = 72;
template <int KIND> struct AtCfg;
template <> struct AtCfg<0> { static constexpr int NSTEP = 5; };
template <> struct AtCfg<1> { static constexpr int NSTEP = 6 + 5; };
template <int KIND> __device__ __forceinline__ void at_pat(int gs, int& dsh, int& qsh, int& kk0) {
    if (KIND == 0) { dsh = 0; qsh = 0; kk0 = 32 * gs; }
    else { const bool p2 = gs >= 6; dsh = p2 ? 4 : 2; qsh = p2 ? 0 : 2; kk0 = 32 * (p2 ? gs - 6 : gs); }
}
struct AtLoad { bf16x8_t kf[2][2]; v4u vr[4]; };
template <int KIND> __device__ __forceinline__ void at_issue(AtLoad& L, const bf16* proj, size_t rowb, int tb0, int head, int gs, int lane) {
    const int fr = lane & 15, g = lane >> 4; int dsh, qsh, kk0; at_pat<KIND>(gs, dsh, qsh, kk0);
    const char* pb = (const char*)proj; const unsigned rb = (unsigned)rowb;
#pragma unroll
    for (int t2 = 0; t2 < 2; ++t2) { int pos = tb0 + (kk0 + 16 * t2 + fr - 128) * (1 << dsh); pos = max(0, min(pos, SEQ - 1)); const unsigned off = (rb + (unsigned)pos) * (unsigned)(NPROJ * 2) + (unsigned)((PC_BK + head * 64 + 8 * g) * 2);
#pragma unroll
        for (int ks = 0; ks < 2; ++ks) L.kf[t2][ks] = *(const bf16x8_t*)(pb + off + 64 * ks); }
#pragma unroll
    for (int i = 0; i < 4; ++i) { int pos = tb0 + (kk0 + 8 * i + (lane >> 3) - 128) * (1 << dsh); pos = max(0, min(pos, SEQ - 1));
        L.vr[i] = *(const v4u*)(pb + (rb + (unsigned)pos) * (unsigned)(NPROJ * 2) + (unsigned)((PC_BV + head * 64 + 8 * (lane & 7)) * 2)); }
}
template <int KIND> struct AtHead { v4u q[2]; v2u pao[4]; f32x2_t ml; };
template <int KIND> __device__ __forceinline__ void at_unit_pos(int unit, size_t& rowb, int& tb0) { rowb = (size_t)(unit >> 10) * SEQ; tb0 = (KIND == 0) ? 16 * (unit & 1023) : ((unit >> 4) & 63) * 256 + (unit & 15); }
template <int KIND> __device__ __forceinline__ void at_head_load(AtHead<KIND>& H, unsigned char* ws, size_t rowb, int tb0, int head, int lane) {
    const bf16* proj = (const bf16*)(ws + WS_HP); const int fr = lane & 15, g = lane >> 4; const size_t qrow = rowb + tb0 + ((KIND == 0) ? fr : 16 * fr);
    const bf16* qp = proj + qrow * NPROJ + PC_BQ + head * 64 + 8 * g; H.q[0] = *(const v4u*)qp; H.q[1] = *(const v4u*)(qp + 32);
    if (KIND == 1) { const bf16* PAO = (const bf16*)(ws + WS_PAO); const float* PAM = (const float*)(ws + WS_PAM);
#pragma unroll
        for (int dt = 0; dt < 4; ++dt) H.pao[dt] = *(const v2u*)(PAO + qrow * 512 + head * 64 + 16 * dt + 4 * g);
        H.ml = *(const f32x2_t*)(PAM + (qrow * 8 + head) * 2); }
}
template <int KIND> __device__ __forceinline__ void attn_pass(const Args& a, unsigned char* ws, int l, int vcu, int G, LAS unsigned char* lds, int tid) {
    constexpr int NSTEP = AtCfg<KIND>::NSTEP, NUNIT = 2048; static_assert(NSTEP % 3 == 2, "loop shape");
    const bf16* proj = (const bf16*)(ws + WS_HP); bf16* Y = (bf16*)(ws + WS_Y); bf16* PAO = (bf16*)(ws + WS_PAO); float* PAM = (float*)(ws + WS_PAM);
    const int lane = tid & 63, head = tid >> 6, fr = lane & 15, g = lane >> 4;
    LAS bf16* Vb = (LAS bf16*)(lds + head * (32 * AT_VS * 2)); LAS float* ssq = (LAS float*)(lds + 8 * 32 * AT_VS * 2);
    int unit = vcu; if (unit >= NUNIT) return;
    size_t rowb; int tb0; at_unit_pos<KIND>(unit, rowb, tb0);
    AtHead<KIND> H; at_head_load<KIND>(H, ws, rowb, tb0, head, lane);
    AtLoad c0, c1, c2; at_issue<KIND>(c0, proj, rowb, tb0, head, 0, lane); at_issue<KIND>(c1, proj, rowb, tb0, head, 1, lane); c2 = c0;
#pragma unroll 1
    for (;;) {
        const int nunit = unit + G; const bool has_next = nunit < NUNIT; size_t rowb_n = rowb; int tb0_n = tb0; if (has_next) at_unit_pos<KIND>(nunit, rowb_n, tb0_n);
        const size_t qrow = rowb + tb0 + ((KIND == 0) ? fr : 16 * fr);
        bf16x8_t qf[2]; constexpr float QS = 0.125f * 1.4426950408889634f;
#pragma unroll
        for (int ks = 0; ks < 2; ++ks) { const v4u u = H.q[ks];
            qf[ks] = __builtin_bit_cast(bf16x8_t, (v4u){pkbf(bflo(u.x) * QS, bfhi(u.x) * QS), pkbf(bflo(u.y) * QS, bfhi(u.y) * QS), pkbf(bflo(u.z) * QS, bfhi(u.z) * QS), pkbf(bflo(u.w) * QS, bfhi(u.w) * QS)}); }
        v2u pao[4]; float pam = 0.f, pal = 0.f;
        if (KIND == 1) {
#pragma unroll
            for (int dt = 0; dt < 4; ++dt) pao[dt] = H.pao[dt];
            pam = H.ml.x; pal = H.ml.y; }
        pg8::f32x4 o[4];
#pragma unroll
        for (int dt = 0; dt < 4; ++dt) o[dt] = (pg8::f32x4){0.f, 0.f, 0.f, 0.f};
        float mrun = -1e30f, lsum = 0.f;
#define AT_STEP(gs, CUR_, TGT_) do { if ((gs) + 2 < NSTEP) at_issue<KIND>(TGT_, proj, rowb, tb0, head, (gs) + 2, lane); else if (has_next) at_issue<KIND>(TGT_, proj, rowb_n, tb0_n, head, (gs) + 2 - NSTEP, lane); \
        int dsh, qsh, kk0; at_pat<KIND>(gs, dsh, qsh, kk0); \
        const int qlo = fr << qsh, klo = max(qlo, 128 - (tb0 >> dsh)); const unsigned kspan = (unsigned)(qlo + 128 - klo); \
        _Pragma("unroll") \
        for (int i = 0; i < 4; ++i) *(LAS v4u*)(Vb + (8 * i + (lane >> 3)) * AT_VS + 8 * (lane & 7)) = CUR_.vr[i]; \
        pg8::f32x4 st[2]; \
        _Pragma("unroll") \
        for (int t2 = 0; t2 < 2; ++t2) { pg8::f32x4 acc = {0.f, 0.f, 0.f, 0.f}; acc = __builtin_amdgcn_mfma_f32_16x16x32_bf16(CUR_.kf[t2][0], qf[0], acc, 0, 0, 0); acc = __builtin_amdgcn_mfma_f32_16x16x32_bf16(CUR_.kf[t2][1], qf[1], acc, 0, 0, 0); st[t2] = acc; } \
        bool val[2][4]; float mx = -1e30f; \
        _Pragma("unroll") \
        for (int t2 = 0; t2 < 2; ++t2) \
        _Pragma("unroll") \
            for (int r = 0; r < 4; ++r) { const int kk = kk0 + 16 * t2 + 4 * g + r; val[t2][r] = (unsigned)(kk - klo) <= kspan; if (val[t2][r]) mx = fmaxf(mx, st[t2][r]); } \
        if (__builtin_amdgcn_ballot_w64(mx > mrun + AT_DEFER) != 0ull) {       \
            mx = fmaxf(mx, __shfl_xor(mx, 16)); mx = fmaxf(mx, __shfl_xor(mx, 32)); \
            const float mn_ = fmaxf(mrun, mx), corr = __builtin_amdgcn_exp2f(mrun - mn_); mrun = mn_; lsum *= corr; \
            _Pragma("unroll") \
            for (int dt = 0; dt < 4; ++dt) o[dt] = o[dt] * corr; } \
        const float mn = mrun; \
        float p[2][4], ps = 0.f; \
        _Pragma("unroll") \
        for (int t2 = 0; t2 < 2; ++t2) \
        _Pragma("unroll") \
            for (int r = 0; r < 4; ++r) { p[t2][r] = val[t2][r] ? __builtin_amdgcn_exp2f(st[t2][r] - mn) : 0.f; ps += p[t2][r]; } \
        lsum += ps; \
        const bf16x8_t pf = __builtin_bit_cast(bf16x8_t, (v4u){pkbf(p[0][0], p[0][1]), pkbf(p[0][2], p[0][3]), pkbf(p[1][0], p[1][1]), pkbf(p[1][2], p[1][3])}); \
        { const int qq = fr >> 2, pp = fr & 3; \
        _Pragma("unroll") \
          for (int dt = 0; dt < 4; ++dt) { const v4i16_t lo = __builtin_amdgcn_ds_read_tr16_b64_v4i16((LAS v4i16_t*)(Vb + (4 * g + qq) * AT_VS + 16 * dt + 4 * pp)), hi = __builtin_amdgcn_ds_read_tr16_b64_v4i16((LAS v4i16_t*)(Vb + (16 + 4 * g + qq) * AT_VS + 16 * dt + 4 * pp)); \
              const bf16x8_t vf = {lo[0], lo[1], lo[2], lo[3], hi[0], hi[1], hi[2], hi[3]}; \
              o[dt] = __builtin_amdgcn_mfma_f32_16x16x32_bf16(vf, pf, o[dt], 0, 0, 0); } } \
    } while (0)
#pragma unroll 1
        for (int gs = 0; gs + 2 < NSTEP; gs += 3) { AT_STEP((gs), c0, c2); AT_STEP((gs + 1), c1, c0); AT_STEP((gs + 2), c2, c1); }
        if (has_next) at_head_load<KIND>(H, ws, rowb_n, tb0_n, head, lane);
        AT_STEP((NSTEP - 2), c0, c2); AT_STEP((NSTEP - 1), c1, c0);
#undef AT_STEP
        lsum += __shfl_xor(lsum, 16); lsum += __shfl_xor(lsum, 32);
        if (KIND == 0) {
#pragma unroll
            for (int dt = 0; dt < 4; ++dt) *(v2u*)(PAO + qrow * 512 + head * 64 + 16 * dt + 4 * g) = (v2u){pkbf(o[dt][0], o[dt][1]), pkbf(o[dt][2], o[dt][3])};
            if (g == 0) *(f32x2_t*)(PAM + (qrow * 8 + head) * 2) = (f32x2_t){mrun, lsum};
        } else {
            const float mm = fmaxf(mrun, pam), fa = __builtin_amdgcn_exp2f(pam - mm), fb = __builtin_amdgcn_exp2f(mrun - mm), inv = 1.0f / (pal * fa + lsum * fb); float ss = 0.f;
#pragma unroll
            for (int dt = 0; dt < 4; ++dt) { const pg8::f32x4 oa = {bflo(pao[dt].x), bfhi(pao[dt].x), bflo(pao[dt].y), bfhi(pao[dt].y)}; o[dt] = (oa * fa + o[dt] * fb) * inv;
                ss += (o[dt][0] * o[dt][0] + o[dt][1] * o[dt][1]) + (o[dt][2] * o[dt][2] + o[dt][3] * o[dt][3]); }
            ss += __shfl_xor(ss, 16); ss += __shfl_xor(ss, 32);
            __syncthreads();
            if (g == 0) ssq[head * 16 + fr] = ss;
            __syncthreads();
            { float s = 0.f;
#pragma unroll
              for (int w = 0; w < 8; ++w) s += ssq[w * 16 + fr];
              const float rs = 1.0f / sqrtf(s * (1.0f / 512.0f) + NORM_EPS); const float* nw = a.in[I_ATN] + l * 512 + head * 64;
#pragma unroll
              for (int dt = 0; dt < 4; ++dt) { const int dd = 16 * dt + 4 * g;
                  *(v2u*)(Y + qrow * DM + 512 + head * 64 + dd) = (v2u){pkbf(o[dt][0] * rs * nw[dd], o[dt][1] * rs * nw[dd + 1]), pkbf(o[dt][2] * rs * nw[dd + 2], o[dt][3] * rs * nw[dd + 3])}; } }
        }
        if (!has_next) break;
        { const AtLoad t = c0; c0 = c2; c1 = t; }
        unit = nunit; rowb = rowb_n; tb0 = tb0_n;
    }
    __syncthreads();
}
__device__ __forceinline__ void m2_hgrn(const Args& a, unsigned char* ws, int l, int w, LAS unsigned char* lds, int tid) {
    const bf16* proj = (const bf16*)(ws + WS_HP); float* OA = (float*)(ws + WS_OA);
    const int b = w >> 2, h = w & 3, v = tid >> 2, kq = tid & 3;
    constexpr int TB = 16, RS = 144;
    LAS float* fs = (LAS float*)lds; LAS float* ks = fs + TB * RS; LAS float* qs = ks + TB * RS; LAS float* vs = qs + TB * RS;
    const int kl = tid & 127, ch = h * 128 + kl;
    float lb = 0.f;
    { const float* lg = a.in[I_LBL]; float mx = lg[ch]; for (int i = 1; i < DEPTH; ++i) mx = fmaxf(mx, lg[i * 512 + ch]); float den = 0.f, num = 0.f;
      for (int i = 0; i < DEPTH; ++i) { const float e = __expf(lg[i * 512 + ch] - mx); den += e; if (i >= 1 && i <= l) num += e; } lb = num / den; }
    float S[32];
#pragma unroll
    for (int j = 0; j < 32; ++j) S[j] = 0.f;
    const size_t rowb = (size_t)b * SEQ;
    bf16 rq[4], rf[4], ri[4];
#define HG_LDBATCH(t0_) do { _Pragma("unroll") for (int i = 0; i < 4; ++i) { const int s_ = (tid >> 7) + 4 * i; const bf16* p_ = proj + (rowb + (t0_) + s_) * NPROJ + ch; rq[i] = p_[PC_AQ]; rf[i] = p_[PC_AF]; ri[i] = p_[PC_AI]; } } while (0)
    HG_LDBATCH(0);
    for (int t0 = 0; t0 < SEQ; t0 += TB) {
#pragma unroll
        for (int i = 0; i < 4; ++i) { const int s = (tid >> 7) + 4 * i; const int kp = kl + 4 * (kl >> 5);
            const float sg = sigmoidf_(bf2f(rf[i])); fs[s * RS + kp] = lb + (1.0f - lb) * sg; ks[s * RS + kp] = (1.0f - lb) * (1.0f - sg); qs[s * RS + kp] = siluf_(bf2f(rq[i])); vs[s * 128 + kl] = bf2f(ri[i]); }
        __syncthreads();
        if (t0 + TB < SEQ) HG_LDBATCH(t0 + TB);
        for (int s = 0; s < TB; ++s) {
            const float vv = vs[s * 128 + v]; float part = 0.f; const int kb = 36 * kq;
#pragma unroll
            for (int j4 = 0; j4 < 8; ++j4) { const f32x4 f4 = *(const LAS f32x4*)(fs + s * RS + kb + 4 * j4), k4 = *(const LAS f32x4*)(ks + s * RS + kb + 4 * j4), q4 = *(const LAS f32x4*)(qs + s * RS + kb + 4 * j4);
#pragma unroll
                for (int jj = 0; jj < 4; ++jj) { const int j = 4 * j4 + jj; S[j] = f4[jj] * S[j] + k4[jj] * vv; part += S[j] * q4[jj]; } }
            part += __shfl_xor(part, 1); part += __shfl_xor(part, 2);
            if (kq == 0) OA[(rowb + t0 + s) * 512 + h * 128 + v] = part;
        }
        __syncthreads();
    }
}
__device__ __forceinline__ void m2_ssd(const Args& a, unsigned char* ws, int l, int w, LAS unsigned char* lds, int tid) {
    const float* xbcc = (const float*)(ws + WS_XBCC); const float* dtv = (const float*)(ws + WS_DTV); float* OC = (float*)(ws + WS_OC);
    const int b = w >> 3, h = w & 7, g = h >> 2, p = tid >> 3, ns = tid & 7;
    constexpr int TB = 16, RS = 160;
    LAS float* Bs = (LAS float*)lds; LAS float* Cs = Bs + TB * RS; LAS float* xs = Cs + TB * RS; LAS float* dts = xs + TB * 64;
    const float Aneg = -__expf(a.in[I_SALOG][l * 8 + h]), Dk = a.in[I_SD][l * 8 + h];
    float hs[16];
#pragma unroll
    for (int j = 0; j < 16; ++j) hs[j] = 0.f;
    const size_t rowb = (size_t)b * SEQ;
    float rB[4], rC[4], rx[2], rdt = 0.f;
    const int nl = tid & 127, pl = tid & 63;
#define SSD_LDBATCH(t0_) do { _Pragma("unroll") for (int i = 0; i < 4; ++i) { const int s_ = (tid >> 7) + 4 * i; const float* q_ = xbcc + (rowb + (t0_) + s_) * 1024; rB[i] = q_[512 + g * 128 + nl]; rC[i] = q_[768 + g * 128 + nl]; } \
        _Pragma("unroll") for (int i = 0; i < 2; ++i) { const int s_ = (tid >> 6) + 8 * i; rx[i] = xbcc[(rowb + (t0_) + s_) * 1024 + h * 64 + pl]; } \
        if (tid < TB) rdt = dtv[(rowb + (t0_) + tid) * 8 + h]; } while (0)
    SSD_LDBATCH(0);
    for (int t0 = 0; t0 < SEQ; t0 += TB) {
#pragma unroll
        for (int i = 0; i < 4; ++i) { const int s = (tid >> 7) + 4 * i; const int np = nl + 4 * (nl >> 4); Bs[s * RS + np] = rB[i]; Cs[s * RS + np] = rC[i]; }
#pragma unroll
        for (int i = 0; i < 2; ++i) { const int s = (tid >> 6) + 8 * i; xs[s * 64 + pl] = rx[i]; }
        if (tid < TB) dts[tid] = rdt;
        __syncthreads();
        if (t0 + TB < SEQ) SSD_LDBATCH(t0 + TB);
        for (int s = 0; s < TB; ++s) {
            const float dt = dts[s], dA = __expf(dt * Aneg), xv = xs[s * 64 + p], xdt = xv * dt; float part = 0.f; const int nb = 20 * ns;
#pragma unroll
            for (int j4 = 0; j4 < 4; ++j4) { const f32x4 b4 = *(const LAS f32x4*)(Bs + s * RS + nb + 4 * j4), c4 = *(const LAS f32x4*)(Cs + s * RS + nb + 4 * j4);
#pragma unroll
                for (int jj = 0; jj < 4; ++jj) { const int j = 4 * j4 + jj; hs[j] = dA * hs[j] + b4[jj] * xdt; part += c4[jj] * hs[j]; } }
            part += __shfl_xor(part, 1); part += __shfl_xor(part, 2); part += __shfl_xor(part, 4);
            if (ns == 0) OC[(rowb + t0 + s) * 512 + h * 64 + p] = part + Dk * xv;
        }
        __syncthreads();
    }
}
__device__ __forceinline__ void m2_lru(const Args& a, unsigned char* ws, int w, int tid) {
    const float* LA = (const float*)(ws + WS_LA); const float* LB = (const float*)(ws + WS_LB); float* OD = (float*)(ws + WS_OD);
    const int idx = w * NTHR + tid, b = idx >> 9, c = idx & 511; const size_t base = (size_t)b * SEQ * 512 + c;
    float hh = 0.f; constexpr int U = 16;
    float ra[U], rb[U];
#pragma unroll
    for (int i = 0; i < U; ++i) { ra[i] = LA[base + (size_t)i * 512]; rb[i] = LB[base + (size_t)i * 512]; }
    for (int t0 = 0; t0 < SEQ; t0 += U) {
        float ca[U], cbv[U];
#pragma unroll
        for (int i = 0; i < U; ++i) { ca[i] = ra[i]; cbv[i] = rb[i]; }
        if (t0 + U < SEQ) {
#pragma unroll
            for (int i = 0; i < U; ++i) { ra[i] = LA[base + (size_t)(t0 + U + i) * 512]; rb[i] = LB[base + (size_t)(t0 + U + i) * 512]; } }
#pragma unroll
        for (int i = 0; i < U; ++i) { hh = ca[i] * hh + cbv[i]; OD[base + (size_t)(t0 + i) * 512] = hh; }
    }
}
__device__ __forceinline__ void m2_attn(const Args& a, unsigned char* ws, int item, int tid) {
    const bf16* proj = (const bf16*)(ws + WS_HP); float* OB = (float*)(ws + WS_OB);
    const int head = item & 7, blk = item >> 3, t = blk * NTHR + tid, tb = t & (SEQ - 1); const size_t rowb = (size_t)(t - tb);
    float q[64], acc[64];
    { const v4u* qp = (const v4u*)(proj + (size_t)t * NPROJ + PC_BQ + head * 64);
#pragma unroll
      for (int i = 0; i < 8; ++i) { const v4u u = qp[i]; q[8 * i + 0] = bflo(u.x) * 0.125f; q[8 * i + 1] = bfhi(u.x) * 0.125f; q[8 * i + 2] = bflo(u.y) * 0.125f; q[8 * i + 3] = bfhi(u.y) * 0.125f;
          q[8 * i + 4] = bflo(u.z) * 0.125f; q[8 * i + 5] = bfhi(u.z) * 0.125f; q[8 * i + 6] = bflo(u.w) * 0.125f; q[8 * i + 7] = bfhi(u.w) * 0.125f; } }
#pragma unroll
    for (int d = 0; d < 64; ++d) acc[d] = 0.f;
    float mrun = -1e30f, lrun = 0.f;
    for (int pat = 0; pat < 3; ++pat) { const int dil = (pat == 0) ? 1 : (pat == 1) ? 4 : 16;
        for (int j = 0; j <= 128; ++j) { const int pos = tb - j * dil;
            if (pos >= 0) {
                const v4u* kp = (const v4u*)(proj + (rowb + pos) * NPROJ + PC_BK + head * 64); const v4u* vp = (const v4u*)(proj + (rowb + pos) * NPROJ + PC_BV + head * 64);
                float s = 0.f;
#pragma unroll
                for (int i = 0; i < 8; ++i) { const v4u u = kp[i]; s += (q[8 * i] * bflo(u.x) + q[8 * i + 1] * bfhi(u.x)) + (q[8 * i + 2] * bflo(u.y) + q[8 * i + 3] * bfhi(u.y))
                        + (q[8 * i + 4] * bflo(u.z) + q[8 * i + 5] * bfhi(u.z)) + (q[8 * i + 6] * bflo(u.w) + q[8 * i + 7] * bfhi(u.w)); }
                const float mn = fmaxf(mrun, s), corr = __expf(mrun - mn), pr = __expf(s - mn); lrun = lrun * corr + pr; mrun = mn;
#pragma unroll
                for (int i = 0; i < 8; ++i) { const v4u u = vp[i];
                    acc[8 * i + 0] = acc[8 * i + 0] * corr + pr * bflo(u.x); acc[8 * i + 1] = acc[8 * i + 1] * corr + pr * bfhi(u.x); acc[8 * i + 2] = acc[8 * i + 2] * corr + pr * bflo(u.y); acc[8 * i + 3] = acc[8 * i + 3] * corr + pr * bfhi(u.y);
                    acc[8 * i + 4] = acc[8 * i + 4] * corr + pr * bflo(u.z); acc[8 * i + 5] = acc[8 * i + 5] * corr + pr * bfhi(u.z); acc[8 * i + 6] = acc[8 * i + 6] * corr + pr * bflo(u.w); acc[8 * i + 7] = acc[8 * i + 7] * corr + pr * bfhi(u.w); }
            } } }
    const float inv = 1.0f / lrun; float* o = OB + (size_t)t * 512 + head * 64;
#pragma unroll
    for (int i = 0; i < 16; ++i) *(f32x4*)(o + 4 * i) = (f32x4){acc[4 * i] * inv, acc[4 * i + 1] * inv, acc[4 * i + 2] * inv, acc[4 * i + 3] * inv};
}
__device__ __forceinline__ void hg_p2_item4(unsigned char* ws, int item, int t) {
    const bf16* UT = (const bf16*)(ws + WS_HGU); const float* DCH = (const float*)(ws + WS_HGD); bf16* SPT = (bf16*)(ws + WS_HGS);
    const int bh = item >> 4, v = (item & 15) * 8 + (t >> 5), k = 4 * (t & 31); const size_t cb = (size_t)bh * HG_NCH;
    f32x4 s = {0.f, 0.f, 0.f, 0.f}; constexpr int U = 8; v2u ru[U]; f32x4 rd[U];
#pragma unroll
    for (int i = 0; i < U; ++i) { ru[i] = *(const v2u*)(UT + (cb + i) * 16384 + v * 128 + k); rd[i] = *(const f32x4*)(DCH + (cb + i) * 128 + k); }
    for (int c0 = 0; c0 < HG_NCH; c0 += U) {
        v2u cu[U]; f32x4 cd[U];
#pragma unroll
        for (int i = 0; i < U; ++i) { cu[i] = ru[i]; cd[i] = rd[i]; }
        if (c0 + U < HG_NCH) {
#pragma unroll
            for (int i = 0; i < U; ++i) { ru[i] = *(const v2u*)(UT + (cb + c0 + U + i) * 16384 + v * 128 + k); rd[i] = *(const f32x4*)(DCH + (cb + c0 + U + i) * 128 + k); } }
#pragma unroll
        for (int i = 0; i < U; ++i) { *(v2u*)(SPT + (cb + c0 + i) * 16384 + v * 128 + k) = (v2u){pk2(s.x, s.y), pk2(s.z, s.w)};
            s = cd[i] * s + (f32x4){bflo(cu[i].x), bfhi(cu[i].x), bflo(cu[i].y), bfhi(cu[i].y)}; }
    }
}
__device__ __forceinline__ void sd_p2_item4(unsigned char* ws, int item, int t) {
    const bf16* STATES = (const bf16*)(ws + WS_SDST); const float* CDEC = (const float*)(ws + WS_CDEC); bf16* PREV = (bf16*)(ws + WS_SDPV);
    const int bh = item >> 3, b = bh >> 3, h = bh & 7, pp = (item & 7) * 8 + (t >> 5), n = 4 * (t & 31);
    f32x4 s = {0.f, 0.f, 0.f, 0.f}; constexpr int U = 8; v2u ru[U]; float rd[U];
#define SD_IDX4(c_) (((size_t)(b * 256 + (c_)) * 8 + h) * 8192 + pp * 128 + n)
#pragma unroll
    for (int i = 0; i < U; ++i) { ru[i] = *(const v2u*)(STATES + SD_IDX4(i)); rd[i] = CDEC[(size_t)(b * 256 + i) * 8 + h]; }
    for (int c0 = 0; c0 < 256; c0 += U) {
        v2u cu[U]; float cd[U];
#pragma unroll
        for (int i = 0; i < U; ++i) { cu[i] = ru[i]; cd[i] = rd[i]; }
        if (c0 + U < 256) {
#pragma unroll
            for (int i = 0; i < U; ++i) { ru[i] = *(const v2u*)(STATES + SD_IDX4(c0 + U + i)); rd[i] = CDEC[(size_t)(b * 256 + c0 + U + i) * 8 + h]; } }
#pragma unroll
        for (int i = 0; i < U; ++i) { *(v2u*)(PREV + SD_IDX4(c0 + i)) = (v2u){pk2(s.x, s.y), pk2(s.z, s.w)};
            s = s * cd[i] + (f32x4){bflo(cu[i].x), bfhi(cu[i].x), bflo(cu[i].y), bfhi(cu[i].y)}; }
    }
#undef SD_IDX4
}
__device__ __forceinline__ void lru_p2_item4(unsigned char* ws, int item, int t) {
    const float* LRA = (const float*)(ws + WS_LRA); const float* LRH = (const float*)(ws + WS_LRH); float* LRC = (float*)(ws + WS_LRC);
    const int idx = item * 256 + t, b = idx >> 9, c = idx & 511; const size_t base = (size_t)b * 256 * 512 + c;
    float hh = 0.f; constexpr int U = 16; float ra[U], rb[U];
#pragma unroll
    for (int i = 0; i < U; ++i) { ra[i] = LRA[base + (size_t)i * 512]; rb[i] = LRH[base + (size_t)i * 512]; }
    for (int k0 = 0; k0 < 256; k0 += U) {
        float ca[U], cbv[U];
#pragma unroll
        for (int i = 0; i < U; ++i) { ca[i] = ra[i]; cbv[i] = rb[i]; }
        if (k0 + U < 256) {
#pragma unroll
            for (int i = 0; i < U; ++i) { ra[i] = LRA[base + (size_t)(k0 + U + i) * 512]; rb[i] = LRH[base + (size_t)(k0 + U + i) * 512]; } }
#pragma unroll
        for (int i = 0; i < U; ++i) { LRC[base + (size_t)(k0 + i) * 512] = hh; hh = ca[i] * hh + cbv[i]; }
    }
}
__device__ __forceinline__ void ph_m2_half(unsigned char* ws, int vcu, int G, int t) {
    constexpr int N_ITEMS = 4 + 128 + 128;
    for (int w = vcu; w < N_ITEMS; w += G) {
        if (w < 4) lru_p2_item4(ws, w, t);
        else if (w < 132) hg_p2_item4(ws, w - 4, t);
        else sd_p2_item4(ws, w - 132, t);
    }
}
__device__ __forceinline__ void ph_convert_dyn(const Args& a, unsigned char* ws, int l, int mask, LAS unsigned char* lds, int vcu, int G, int wave, int lane, LAS unsigned* ctr) {
    LAS float* scr = (LAS float*)(lds + wave * 16384);
    const int nitems = cvt_nitems(mask);
#define CV_GRAB(dst) do { unsigned j_ = 0; if (lane == 0) j_ = __hip_atomic_fetch_add(ctr, 1u, __ATOMIC_RELAXED, __HIP_MEMORY_SCOPE_WORKGROUP); dst = vcu + G * (int)__builtin_amdgcn_readfirstlane(j_); } while (0)
    int it; CV_GRAB(it); if (it >= nitems) return;
    CvtDesc d0 = cvt_decode(a, ws, l, mask, it); f32x4 v[8]; cvt_load(d0, lane, v);
    for (;;) {
        int nx; CV_GRAB(nx); CvtDesc d1 = d0; f32x4 vn[8];
        if (nx < nitems) { d1 = cvt_decode(a, ws, l, mask, nx); cvt_load(d1, lane, vn); }
        else {
#pragma unroll
            for (int i = 0; i < 8; ++i) vn[i] = v[i]; }
        cvt_store(d0, ws, lane, v, scr);
        if (nx >= nitems) break;
        d0 = d1;
#pragma unroll
        for (int i = 0; i < 8; ++i) v[i] = vn[i];
    }
#undef CV_GRAB
}
__device__ __forceinline__ void ld8(const float* p, float (&o)[8]) { const f32x4 u0 = *(const f32x4*)p, u1 = *(const f32x4*)(p + 4); o[0] = u0.x; o[1] = u0.y; o[2] = u0.z; o[3] = u0.w; o[4] = u1.x; o[5] = u1.y; o[6] = u1.z; o[7] = u1.w; }
__device__ __forceinline__ void ldb8(const bf16* p, float (&o)[8]) { const v4u u = *(const v4u*)p; o[0] = bflo(u.x); o[1] = bfhi(u.x); o[2] = bflo(u.y); o[3] = bfhi(u.y); o[4] = bflo(u.z); o[5] = bfhi(u.z); o[6] = bflo(u.w); o[7] = bfhi(u.w); }
__device__ __forceinline__ void st8(bf16* p, const float (&o)[8]) { v4u u; u.x = pk2(o[0], o[1]); u.y = pk2(o[2], o[3]); u.z = pk2(o[4], o[5]); u.w = pk2(o[6], o[7]); *(v4u*)p = u; }
__device__ __forceinline__ void ph_m3(const Args& a, unsigned char* ws, int l, int gw, int ngw, int lane) {
    const bf16* proj = (const bf16*)(ws + WS_HP); bf16* Y = (bf16*)(ws + WS_Y);
    const float* OA = (const float*)(ws + WS_OA); const float* OB = (const float*)(ws + WS_OB); const float* OC = (const float*)(ws + WS_OC); const float* OD = (const float*)(ws + WS_OD);
    const float* nA = a.in[I_HGN] + l * 512; const float* nB = a.in[I_ATN] + l * 512; const float* nC = a.in[I_SNORM] + l * 512; const float* nD = a.in[I_LNORM] + l * 512;
    const int c = lane * 8;
    for (int t = gw; t < M; t += ngw) {
        float vb[8];
        ld8(OB + (size_t)t * 512 + c, vb);
        const bf16* pr = proj + (size_t)t * NPROJ;
        { float ss = 0.f;
#pragma unroll
          for (int i = 0; i < 8; ++i) ss += vb[i] * vb[i];
          ss = wave_sum(ss); const float r = 1.0f / sqrtf(ss * (1.0f / 512.0f) + NORM_EPS); float w[8]; ld8(nB + c, w);
#pragma unroll
          for (int i = 0; i < 8; ++i) vb[i] = vb[i] * r * w[i];
          st8(Y + (size_t)t * DM + 512 + c, vb); }
    }
}
__device__ __forceinline__ void ph_final(float* out, const bf16* xh, const unsigned char* xl, const rs_t* rowss, const float* w, int vcu, int G, int tid) {
    const int lane = tid & 63, wave = tid >> 6, wr = wave >> 2, wc = wave & 3, fr = lane & 15, fq = lane >> 4;
    for (int t = vcu; t < (M / 256) * (DM / 256); t += G) { const int pm = t >> 3, pn = t & 7;
#pragma unroll
        for (int am = 0; am < 8; ++am) { const int row = pm * 256 + (am >> 2) * 128 + wr * 64 + (am & 3) * 16 + fr; const float r = 1.0f / sqrtf((float)rowss[row] * (RS_INV / DM) + NORM_EPS);
            v4u lw = {0x80808080u, 0x80808080u, 0x80808080u, 0x80808080u}; if (MK_LO) lw = *(const v4u*)(xl + pg8::lo_addr(pm, pn, am, wave, lane));
#pragma unroll
            for (int bj = 0; bj < 2; ++bj) { const int col = pn * 256 + bj * 128 + wc * 32 + 8 * fq; const size_t o2 = (size_t)row * DM + col; const v4u h = *(const v4u*)(xh + o2);
                const f32x4 w0 = *(const f32x4*)(w + col), w1 = *(const f32x4*)(w + col + 4); const unsigned l0 = lw[2 * bj], l1 = lw[2 * bj + 1];
                f32x4 v0 = {bflo(h.x) + pg8::lo_dec(h.x & 0xffffu, l0 & 0xffu), bfhi(h.x) + pg8::lo_dec(h.x >> 16, (l0 >> 8) & 0xffu), bflo(h.y) + pg8::lo_dec(h.y & 0xffffu, (l0 >> 16) & 0xffu), bfhi(h.y) + pg8::lo_dec(h.y >> 16, l0 >> 24)};
                f32x4 v1 = {bflo(h.z) + pg8::lo_dec(h.z & 0xffffu, l1 & 0xffu), bfhi(h.z) + pg8::lo_dec(h.z >> 16, (l1 >> 8) & 0xffu), bflo(h.w) + pg8::lo_dec(h.w & 0xffffu, (l1 >> 16) & 0xffu), bfhi(h.w) + pg8::lo_dec(h.w >> 16, l1 >> 24)};
                *(f32x4*)(out + o2) = v0 * r * w0; *(f32x4*)(out + o2 + 4) = v1 * r * w1; } } }
}
constexpr int NPH = 66;
__host__ __device__ inline bool phase_active(int p) {
    if (p == 0 || p == NPH - 1) return true;
    const int f = (p - 1) >> 3, k = (p - 1) & 7, second = f & 1, l = f >> 1;
    if (k == 0) return false;
    if (k == 1 || k == 2) return true;
    return !second;
}
__global__ void __launch_bounds__(NTHR, 2) fwd_kernel(Args args) {
    extern __shared__ __attribute__((aligned(16))) unsigned char lds_raw[];
    LAS unsigned char* lds = (LAS unsigned char*)lds_raw;
    volatile LAS unsigned* MISC = (volatile LAS unsigned*)(lds + MISC_OFF);
    const int tid0 = threadIdx.x;
    const int G = gridDim.x, bx = blockIdx.x, vcu = (G % 8 == 0) ? (bx % 8) * (G / 8) + bx / 8 : bx;
    const int ngw = G * NWAVES;
    unsigned* ctl = (unsigned*)(args.ws + WS_CTL);
    for (int u = tid0; u < (LDS_BYTES - LDSCTL_OFF) / 4; u += NTHR) ((LAS unsigned*)(lds + LDSCTL_OFF))[u] = 0u;
    __syncthreads();
    const int lo = args.ph_lo, hi = args.ph_hi;
    const bool multi = (hi - lo) > 1;
    XcdBarrier bar; bar.bar = ctl + CW_BAR; bar.x = 0; bar.st = nullptr;
    if (multi) bar = xcd_barrier_post(ctl + CW_BAR, MISC + 8);
#define IN(k) (lo <= (k) && (k) < hi)
#define SEAM(k) do { if ((k) + 1 < hi) xcd_barrier(bar); } while (0)

    if (IN(0)) { unsigned char* ws = args.ws; rs_t* rowss_all = (rs_t*)(ws + WS_ROWSS); const int lane = tid0 & 63, wave = __builtin_amdgcn_readfirstlane(tid0 >> 6), gw = vcu * NWAVES + wave;
        ph_prep(args.in[I_X], (bf16*)(ws + WS_XB), (unsigned char*)(ws + WS_XLO), rowss_all, vcu, G, tid0); ph_convert(args, ws, 0, CVM_F1 | CVM_IN, lds, gw, ngw, wave, lane); SEAM(0); }

    for (int f = 0; f < 2 * DEPTH; ++f) {
        const int l = f >> 1, second = f & 1, base = 1 + 8 * f;
        unsigned long long wsv_ = (unsigned long long)args.ws, outv_ = (unsigned long long)args.out; asm volatile("" : "+s"(wsv_), "+s"(outv_));
        unsigned char* ws = (unsigned char*)(GAS unsigned char*)wsv_; float* out = (float*)(GAS float*)outv_; rs_t* rowss_all = (rs_t*)(ws + WS_ROWSS);
        int tid = tid0; asm volatile("" : "+v"(tid));
        const int lane = tid & 63, wave = __builtin_amdgcn_readfirstlane(tid >> 6), gw = vcu * NWAVES + wave;
        bf16* XB = (bf16*)(ws + WS_XB); bf16* HP = (bf16*)(ws + WS_HP); bf16* Y = (bf16*)(ws + WS_Y);
        const rs_t* rs_in = rowss_all + (size_t)(3 * l + 2 * second) * M;
        rs_t* rs_out = rowss_all + (size_t)(3 * l + 1 + 2 * second) * M;
        if (IN(base + 1)) {
            pg8::Gemm g{XB, (const bf16*)(ws + (second ? WS_WGU2 : WS_WGU1)), M, NGU, DM}; pg8::StaticOrder S; S.init(M, NGU, G, bx);
            pg8::EpiSwiglu E{HP, DFF, rs_in, RS_INV / DM, NORM_EPS};
            pg8::gemm_phase<pg8::EpiSwiglu, pg8::StaticOrder, false, true>(lds, g, S, E);
            SEAM(base + 1);
        }
        if (IN(base + 2)) {
            pg8::Gemm g{HP, (const bf16*)(ws + (second ? WS_WD2 : WS_WD1)), M, DM, DFF}; pg8::StaticOrderT<4, true> S; S.init(M, DM, G, bx);
            pg8::EpiResid E{XB, (unsigned char*)(ws + WS_XLO), rs_out, DM, 0.5f};
            pg8::gemm_phase<pg8::EpiResid, pg8::StaticOrderT<4, true>, true, true>(lds, g, S, E);
            SEAM(base + 2);
        }
        if (!second) {
            if (IN(base + 3)) {
                pg8::Gemm g{XB, (const bf16*)(ws + WS_WIN), M, NPROJ, DM}; pg8::StaticOrder S; S.init(M, NPROJ, G, bx);
                pg8::EpiRowScale E{HP, NPROJ, rs_out, RS_INV / DM, NORM_EPS};
                pg8::gemm_phase<pg8::EpiRowScale, pg8::StaticOrder, true, true>(lds, g, S, E);
                SEAM(base + 3);
            }
            if (IN(base + 4)) { const bool cfirst = vcu & 1;
                if (cfirst) { ph_convert(args, ws, l, CVM_OUT, lds, gw, ngw, wave, lane); __syncthreads(); }
                { LruW W; lru_load_w(args, l, wave, lane, W); for (int u = vcu; u < 512; u += G) lru_unit<false>(args, ws, l, u, W, lds, tid); }
                for (int u = vcu; u < 512; u += G) sd_p1_unit(args, ws, l, rs_out, u, lds, tid);
                { HgRaw R; hg_load<false>(R, ws, vcu, tid); for (int u = vcu; u < 2048; u += G) hg_p1_unit(args, ws, l, u, (u + G < 2048) ? u + G : -1, R, lds, tid); }
                attn_pass<0>(args, ws, l, vcu, G, lds, tid);
                if (!cfirst) { __syncthreads(); ph_convert(args, ws, l, CVM_OUT, lds, gw, ngw, wave, lane); } SEAM(base + 4); }
            if (IN(base + 5)) {
                LAS unsigned* cctr = (LAS unsigned*)(lds + LDSCTL_OFF + 64);
                if (tid == 0) *cctr = 0u;
                __syncthreads();
                if (wave < 4) ph_m2_half(ws, vcu, G, tid);
                if (l + 1 < DEPTH) ph_convert_dyn(args, ws, l + 1, CVM_F1 | CVM_IN, lds, vcu, G, wave, lane, cctr);
                __syncthreads();
                attn_pass<1>(args, ws, l, vcu, G, lds, tid);
                SEAM(base + 5); }
            if (IN(base + 6)) { const bool cfirst = vcu & 1;
                if (cfirst) { ph_convert(args, ws, l, CVM_F2, lds, gw, ngw, wave, lane); __syncthreads(); }
                { HgRaw R; hg_load<true>(R, ws, vcu, tid); for (int u = vcu; u < 2048; u += G) hg_p3_unit(args, ws, l, u, (u + G < 2048) ? u + G : -1, R, lds, tid); } for (int u = vcu; u < 1024; u += G) sd_p3_unit(args, ws, l, u, lds, tid);
                { LruW W; lru_load_w(args, l, wave, lane, W); for (int u = vcu; u < 512; u += G) lru_unit<true>(args, ws, l, u, W, lds, tid); }
                if (!cfirst) { __syncthreads(); ph_convert(args, ws, l, CVM_F2, lds, gw, ngw, wave, lane); } SEAM(base + 6); }
            if (IN(base + 7)) {
                pg8::Gemm g{Y, (const bf16*)(ws + WS_WOUT), M, DM, DM}; pg8::StaticOrderT<4> S; S.init(M, DM, G, bx);
                pg8::EpiResid E{XB, (unsigned char*)(ws + WS_XLO), rowss_all + (size_t)(3 * l + 2) * M, DM, 1.0f};
                pg8::gemm_phase<pg8::EpiResid, pg8::StaticOrderT<4>, true, true>(lds, g, S, E);
                SEAM(base + 7);
            }
        }
    }
    if (IN(NPH - 1)) { const int lane = tid0 & 63, wave = __builtin_amdgcn_readfirstlane(tid0 >> 6), gw = vcu * NWAVES + wave; ph_final(args.out, (const bf16*)(args.ws + WS_XB), (const unsigned char*)(args.ws + WS_XLO), (const rs_t*)(args.ws + WS_ROWSS) + (size_t)12 * M, args.in[I_FINN], vcu, G, tid0); }
#undef IN
#undef SEAM
}

extern "C" void kernel_launch(void* const* d_in, const int* in_sizes, int n_in, void* d_out, int out_size, void* d_ws, size_t ws_size, hipStream_t stream) {
    static int grid = 0;
    if (grid == 0) {
        if (n_in != 30 || in_sizes[0] != M * DM || out_size != M * DM || ws_size < WS_END) { fprintf(stderr, "kernel_launch: unexpected problem shape / workspace (n_in %d, ws %zu, need %zu); nothing launched\n", n_in, ws_size, (size_t)WS_END); grid = -1; return; }
        int dev = 0, cus = 0;
        if (hipGetDevice(&dev) != hipSuccess || hipDeviceGetAttribute(&cus, hipDeviceAttributeMultiprocessorCount, dev) != hipSuccess) { grid = -1; return; }
        if (hipFuncSetAttribute((const void*)fwd_kernel, hipFuncAttributeMaxDynamicSharedMemorySize, LDS_BYTES) != hipSuccess) { fprintf(stderr, "kernel_launch: hipFuncSetAttribute failed\n"); grid = -1; return; }
        int per_cu = 0;
        if (hipOccupancyMaxActiveBlocksPerMultiprocessor(&per_cu, (const void*)fwd_kernel, NTHR, LDS_BYTES) != hipSuccess || per_cu < 1) { fprintf(stderr, "kernel_launch: occupancy query says %d; nothing launched\n", per_cu); (void)hipGetLastError(); grid = -1; return; }
        grid = cus;
    }
    if (grid < 0) return;
    if (hipMemsetAsync((char*)d_ws + WS_CTL, 0, CTL_ZERO_BYTES, stream) != hipSuccess) return;
    Args a{};
    for (int i = 0; i < 30; ++i) a.in[i] = (const float*)d_in[i];
    a.out = (float*)d_out; a.ws = (unsigned char*)d_ws;
#if MK_ONE_LAUNCH
    a.ph_lo = 0; a.ph_hi = NPH;
    hipLaunchKernelGGL(fwd_kernel, dim3(grid), dim3(NTHR), LDS_BYTES, stream, a);
#else
    for (int p = 0; p < NPH; ++p) { if (!phase_active(p)) continue; a.ph_lo = p; a.ph_hi = p + 1; hipLaunchKernelGGL(fwd_kernel, dim3(grid), dim3(NTHR), LDS_BYTES, stream, a); }
#endif
}
```

```cpp
#include <hip/hip_runtime.h>
#include <cstdio>
#include <cstdint>
namespace pg8 {
#define PG8_LAS __attribute__((address_space(3)))
typedef unsigned short bf16_t;
typedef short bf16x8 __attribute__((ext_vector_type(8)));
typedef float f32x4 __attribute__((ext_vector_type(4)));
typedef unsigned u32x4 __attribute__((ext_vector_type(4)));
constexpr int BM = 256, BK = 64, HALF = 128, HTB = HALF * BK * 2  , STAGE_BYTES = 8 * HTB, NXCD = 8, WGM = 8;

__host__ __device__ __forceinline__ int lds_byte(int r, int c) { const int st = (r >> 4) * 2 + (c >> 5), rr = r & 15, cc = c & 31, ob = rr * 64 + cc * 2; return st * 1024 + (ob ^ (((ob >> 9) & 1) << 5)); }
__host__ __device__ __forceinline__ void stage_rc(int b, int& R, int& C) { const int st = b / 1024, sb = b % 1024, swz = sb ^ (((sb >> 9) & 1) << 5); R = (st >> 1) * 16 + swz / 64; C = (st & 1) * 32 + (swz % 64) / 2; }
__host__ __device__ __forceinline__ int perm32(int rho) { const int n = rho >> 4, i = rho & 15; return 8 * (i >> 2) + 4 * n + (i & 3); }

struct Unit { int pm, pn; };
struct Gemm { const bf16_t* A; const bf16_t* Bt; int M, N, K; };

template <int GH, bool REV = false> struct StaticOrderT {
    int nM, nN, nwg, G, c;
    __host__ __device__ void init(int M, int N, int G_, int c_) { nM = M / BM; nN = N / BM; nwg = nM * nN; G = G_; c = c_; }
    __host__ __device__ bool next(int i, Unit& u) const {
        if ((long)i * G + c >= nwg) return false;
        const long L = (long)((REV && nwg % G == 0) ? nwg / G - 1 - i : i) * G + c;
        int wgid = (int)L; { const int q = nwg / NXCD, r = nwg % NXCD, xcd = wgid % NXCD, off = wgid / NXCD; wgid = (xcd < r ? xcd * (q + 1) : r * (q + 1) + (xcd - r) * q) + off; }
        const int nig = GH * nN, gid = wgid / nig, fm = gid * GH, gsz = (nM % GH == 0) ? GH : ((nM - fm) < GH ? (nM - fm) : GH);
        u.pm = fm + ((wgid % nig) % gsz); u.pn = (wgid % nig) / gsz; return true;
    }
    __device__ __forceinline__ void a_ready(const Unit&) const {}
    __device__ __forceinline__ void done(const Unit&) const {}
};
typedef StaticOrderT<WGM> StaticOrder;

__device__ __forceinline__ unsigned cvt_pk_bf16(float lo, float hi) { unsigned r; asm volatile("v_cvt_pk_bf16_f32 %0, %1, %2" : "=v"(r) : "v"(lo), "v"(hi)); return r; }
__device__ __forceinline__ float fast_sigmoid(float v) { return __builtin_amdgcn_rcpf(1.0f + __expf(-v)); }
struct EpiSwiglu {
    static constexpr bool PERM = true, AFTER_DRAIN = false;
    bf16_t* H; int ldh; const unsigned* rowss; float inv_d, eps;
    struct Pre { const PG8_LAS unsigned* rs; };
    __device__ __forceinline__ void prefetch(Pre& p, const Unit& u, int wr, int fr, PG8_LAS unsigned char* lds, int ui, int wid, int lane) const {
        PG8_LAS unsigned* area = (PG8_LAS unsigned*)(lds + STAGE_BYTES + (ui & 1) * 1024);
        if (wid < 4) __builtin_amdgcn_global_load_lds((const unsigned*)(rowss + u.pm * BM + wid * 64 + lane), area + wid * 64, 4, 0, 0);
        p.rs = area; }
    __device__ __forceinline__ void operator()(const f32x4 (&acc)[2][2][4][2], const Unit& u, int wr, int wc, int fr, int fq, const Pre& pre) const {
        const int row0 = u.pm * BM + wr * 64 + fr, col0 = u.pn * HALF + wc * 32 + 8 * fq;
        unsigned rsv[2][4];
#pragma unroll
        for (int ai = 0; ai < 2; ++ai)
#pragma unroll
            for (int m = 0; m < 4; ++m) rsv[ai][m] = pre.rs[wr * 64 + fr + ai * HALF + m * 16];
        __builtin_amdgcn_sched_barrier(0);
#pragma unroll
        for (int ai = 0; ai < 2; ++ai)
#pragma unroll
            for (int m = 0; m < 4; ++m) { const int row = row0 + ai * HALF + m * 16; const float ms = (float)rsv[ai][m] * inv_d + eps, rl = __builtin_amdgcn_rsqf(ms) * -1.4426950408889634f;
                float o[8], e8[8];
#pragma unroll
                for (int n = 0; n < 2; ++n)
#pragma unroll
                    for (int j = 0; j < 4; ++j) { const float g = acc[ai][0][m][n][j], uu = acc[ai][1][m][n][j]; e8[4 * n + j] = g * rl; o[4 * n + j] = g * uu; }
#pragma unroll
                for (int i = 0; i < 8; ++i) e8[i] = __builtin_amdgcn_exp2f(e8[i]);
#pragma unroll
                for (int i = 0; i < 8; ++i) e8[i] = __builtin_fmaf(e8[i], ms, ms);
#pragma unroll
                for (int i = 0; i < 8; ++i) e8[i] = __builtin_amdgcn_rcpf(e8[i]);
#pragma unroll
                for (int i = 0; i < 8; ++i) o[i] *= e8[i];
                u32x4 w; w.x = cvt_pk_bf16(o[0], o[1]); w.y = cvt_pk_bf16(o[2], o[3]); w.z = cvt_pk_bf16(o[4], o[5]); w.w = cvt_pk_bf16(o[6], o[7]);
                *(u32x4*)(H + (size_t)row * ldh + col0) = w; }
    }
};
struct EpiRowScale {
    static constexpr bool PERM = true, AFTER_DRAIN = false;
    bf16_t* O; int ldc; const unsigned* rowss; float inv_d, eps;
    struct Pre { const PG8_LAS unsigned* rs; };
    __device__ __forceinline__ void prefetch(Pre& p, const Unit& u, int wr, int fr, PG8_LAS unsigned char* lds, int ui, int wid, int lane) const {
        PG8_LAS unsigned* area = (PG8_LAS unsigned*)(lds + STAGE_BYTES + (ui & 1) * 1024);
        if (wid < 4) __builtin_amdgcn_global_load_lds((const unsigned*)(rowss + u.pm * BM + wid * 64 + lane), area + wid * 64, 4, 0, 0);
        p.rs = area; }
    __device__ __forceinline__ void operator()(const f32x4 (&acc)[2][2][4][2], const Unit& u, int wr, int wc, int fr, int fq, const Pre& pre) const {
        const int row0 = u.pm * BM + wr * 64 + fr, col0 = u.pn * BM + wc * 32 + 8 * fq;
        unsigned rsv[2][4];
#pragma unroll
        for (int ai = 0; ai < 2; ++ai)
#pragma unroll
            for (int m = 0; m < 4; ++m) rsv[ai][m] = pre.rs[wr * 64 + fr + ai * HALF + m * 16];
        __builtin_amdgcn_sched_barrier(0);
#pragma unroll
        for (int ai = 0; ai < 2; ++ai)
#pragma unroll
            for (int m = 0; m < 4; ++m) { const int row = row0 + ai * HALF + m * 16; const float r = __builtin_amdgcn_rsqf((float)rsv[ai][m] * inv_d + eps);
                bf16_t* rowp = O + (size_t)row * ldc + col0;
#pragma unroll
                for (int bj = 0; bj < 2; ++bj) { const f32x4 v0 = acc[ai][bj][m][0] * r, v1 = acc[ai][bj][m][1] * r;
                    u32x4 w; w.x = cvt_pk_bf16(v0[0], v0[1]); w.y = cvt_pk_bf16(v0[2], v0[3]); w.z = cvt_pk_bf16(v1[0], v1[1]); w.w = cvt_pk_bf16(v1[2], v1[3]);
                    *(u32x4*)(rowp + bj * HALF) = w; } }
    }
};
__device__ __forceinline__ float lo_scale(unsigned hb) { int se = (int)((hb >> 7) & 0xffu) - 15; se = se < 0 ? 0 : se; return __builtin_bit_cast(float, (unsigned)se << 23); }
__device__ __forceinline__ float lo_inv(unsigned hb) { int ie = 269 - (int)((hb >> 7) & 0xffu); ie = ie > 254 ? 254 : ie; return __builtin_bit_cast(float, (unsigned)ie << 23); }
__device__ __forceinline__ float lo_dec(unsigned hb, unsigned byte) { return ((float)byte - 128.0f) * lo_scale(hb); }
__device__ __forceinline__ unsigned lo_enc(float x, unsigned hb) { const float hf = __builtin_bit_cast(float, hb << 16); float t = (x - hf) * lo_inv(hb) + 128.0f; t = fminf(fmaxf(t, 1.0f), 255.0f); return (unsigned)__builtin_rintf(t); }
#ifndef MK_LO
#define MK_LO 0
#endif
__device__ __forceinline__ size_t lo_addr(int pm, int pn, int am, int wave, int lane) { return ((((size_t)(pm * 8 + pn) * 8 + am) * 8 + wave) * 64 + lane) * 16; }
struct EpiResid {
    static constexpr bool PERM = true, AFTER_DRAIN = false;
    bf16_t* xh; unsigned char* xl; unsigned* rowss_out; int ldc; float scale;
    struct Pre {}; __device__ __forceinline__ void prefetch(Pre&, const Unit&, int, int, PG8_LAS unsigned char*, int, int, int) const {}
    __device__ __forceinline__ void operator()(const f32x4 (&acc)[2][2][4][2], const Unit& u, int wr, int wc, int fr, int fq, const Pre&) const {
        const int row0 = u.pm * BM + wr * 64 + fr, col0 = u.pn * BM + wc * 32 + 8 * fq, wave = wr * 4 + wc, lane = fq * 16 + fr;
        constexpr int NB = MK_LO ? 2 : 4;
#pragma unroll
        for (int ab = 0; ab < 8 / NB; ++ab) {
            u32x4 hi[NB][2], lo[NB];
#pragma unroll
            for (int mm = 0; mm < NB; ++mm) { const int am = NB * ab + mm, ai = am >> 2, m = am & 3; if (MK_LO) lo[mm] = *(const u32x4*)(xl + lo_addr(u.pm, u.pn, am, wave, lane)); else lo[mm] = (u32x4){0x80808080u, 0x80808080u, 0x80808080u, 0x80808080u};
#pragma unroll
                for (int bj = 0; bj < 2; ++bj) hi[mm][bj] = *(const u32x4*)(xh + (size_t)(row0 + ai * HALF + m * 16) * ldc + col0 + bj * HALF); }
#pragma unroll
            for (int mm = 0; mm < NB; ++mm) { const int am = NB * ab + mm, ai = am >> 2, m = am & 3; const int row = row0 + ai * HALF + m * 16; float ss = 0.f; u32x4 wl = {0u, 0u, 0u, 0u};
#pragma unroll
                for (int bj = 0; bj < 2; ++bj) { const size_t o2 = (size_t)row * ldc + col0 + bj * HALF; u32x4 wh;
#pragma unroll
                    for (int q = 0; q < 4; ++q) { const unsigned h = hi[mm][bj][q], lw = lo[mm][2 * bj + (q >> 1)] >> (16 * (q & 1));
                        float x0 = __builtin_bit_cast(float, h << 16), x1 = __builtin_bit_cast(float, h & 0xffff0000u); if (MK_LO) { x0 += lo_dec(h & 0xffffu, lw & 0xffu); x1 += lo_dec(h >> 16, (lw >> 8) & 0xffu); }
                        x0 += acc[ai][bj][m][q >> 1][2 * (q & 1)] * scale; x1 += acc[ai][bj][m][q >> 1][2 * (q & 1) + 1] * scale;
                        ss += x0 * x0 + x1 * x1;
                        const unsigned nh = cvt_pk_bf16(x0, x1); wh[q] = nh;
                        if (MK_LO) wl[2 * bj + (q >> 1)] |= (lo_enc(x0, nh & 0xffffu) | (lo_enc(x1, nh >> 16) << 8)) << (16 * (q & 1)); }
                    *(u32x4*)(xh + o2) = wh; }
                if (MK_LO) *(u32x4*)(xl + lo_addr(u.pm, u.pn, am, wave, lane)) = wl;
                ss += __shfl_xor(ss, 16); ss += __shfl_xor(ss, 32);
                if (fq == 0) atomicAdd(rowss_out + row, (unsigned)(ss * 1024.0f + 0.5f)); } }
    }
};
struct EpiNull {
    static constexpr bool PERM = true, AFTER_DRAIN = false;
    float* sink;
    struct Pre {}; __device__ __forceinline__ void prefetch(Pre&, const Unit&, int, int, PG8_LAS unsigned char*, int, int, int) const {}
    __device__ __forceinline__ void operator()(const f32x4 (&acc)[2][2][4][2], const Unit& u, int wr, int wc, int fr, int fq, const Pre&) const {
        float s = 0.f;
#pragma unroll
        for (int ai = 0; ai < 2; ++ai)
#pragma unroll
            for (int bj = 0; bj < 2; ++bj)
#pragma unroll
                for (int m = 0; m < 4; ++m)
#pragma unroll
                    for (int n = 0; n < 2; ++n) s += (acc[ai][bj][m][n][0] + acc[ai][bj][m][n][1]) + (acc[ai][bj][m][n][2] + acc[ai][bj][m][n][3]);
        if (s == 1234567.125f) sink[0] = s;
    }
};
template <class Epi, class Sched, bool ALIGN_EPI = false, bool SP2 = false>
__device__ __forceinline__ void gemm_phase(PG8_LAS unsigned char* lds, const Gemm g, const Sched& S, const Epi& E) {
    int tid_ = threadIdx.x; asm volatile("" : "+v"(tid_));
    const int tid = tid_, wid = __builtin_amdgcn_readfirstlane(tid >> 6), lane = tid & 63, wr = wid >> 2, wc = wid & 3, fr = lane & 15, fq = lane >> 4;
    const int K = g.K, nt = K / BK;
    unsigned voffA[2], voffB[2];
#pragma unroll
    for (int i = 0; i < 2; ++i) { int R, C; stage_rc(tid * 16 + i * 8192, R, C); const int Rb = Epi::PERM ? ((R & ~31) + perm32(R & 31)) : R;
        voffA[i] = (unsigned)(R * K + C) * 2u; voffB[i] = (unsigned)(Rb * K + C) * 2u; }
    const size_t kstep = (size_t)(BK * 2);
    const size_t hstep = (size_t)HALF * K * 2;
    const size_t tstep = 2 * hstep;
    const unsigned ldsw = (unsigned)wid * 1024u;
    const int aoff = lds_byte(wr * 64 + fr, fq * 8), boff = lds_byte(wc * 32 + fr, fq * 8);
#define PG8_SA(b, h) (((b) * 2 + (h)) * HTB)
#define PG8_SB(b, h) ((4 + (b) * 2 + (h)) * HTB)
#define PG8_STAGE(bufoff, gbase, voff) do { _Pragma("unroll") for (int _i = 0; _i < 2; ++_i) \
        __builtin_amdgcn_global_load_lds((const unsigned*)((const char*)(gbase) + (voff)[_i]), (PG8_LAS unsigned*)(lds + (bufoff) + ldsw + _i * 8192), 16, 0, 0); } while (0)
#define PG8_LDA(dst, b, h) do { _Pragma("unroll") for (int m = 0; m < 4; ++m) _Pragma("unroll") for (int k = 0; k < 2; ++k) dst[m][k] = *(const PG8_LAS bf16x8*)(lds + PG8_SA(b, h) + aoff + m * 2048 + k * 1024); } while (0)
#define PG8_LDB(dst, b, h) do { _Pragma("unroll") for (int n = 0; n < 2; ++n) _Pragma("unroll") for (int k = 0; k < 2; ++k) dst[n][k] = *(const PG8_LAS bf16x8*)(lds + PG8_SB(b, h) + boff + n * 2048 + k * 1024); } while (0)
#define PG8_MMA(ai, bj, At, Bt) do { __builtin_amdgcn_s_setprio(1); _Pragma("unroll") for (int m = 0; m < 4; ++m) _Pragma("unroll") for (int n = 0; n < 2; ++n) _Pragma("unroll") for (int k = 0; k < 2; ++k) \
        acc[ai][bj][m][n] = __builtin_amdgcn_mfma_f32_16x16x32_bf16(Bt[n][k], At[m][k], acc[ai][bj][m][n], 0, 0, 0); __builtin_amdgcn_s_setprio(0); } while (0)
#define PG8_WAIT_V(n) asm volatile("s_waitcnt vmcnt(" #n ")" ::: "memory")
#define PG8_WAIT_L(n) asm volatile("s_waitcnt lgkmcnt(" #n ")" ::: "memory")
#define PG8_BAR __builtin_amdgcn_s_barrier()
#define PG8_SCHED __builtin_amdgcn_sched_barrier(0)
    Unit cur, nxt; int ui = 0;
    if (!S.next(0, cur)) return;
    f32x4 acc[2][2][4][2];
#define PG8_ZERO_ACC() do { _Pragma("unroll") for (int a = 0; a < 2; ++a) _Pragma("unroll") for (int b = 0; b < 2; ++b) _Pragma("unroll") for (int m = 0; m < 4; ++m) _Pragma("unroll") for (int n = 0; n < 2; ++n) { \
        typedef unsigned long long u64x2_ __attribute__((ext_vector_type(2))); unsigned long long z0_, z1_; asm volatile("v_mov_b64 %0, 0\n\tv_mov_b64 %1, 0" : "=v"(z0_), "=v"(z1_)); \
        acc[a][b][m][n] = __builtin_bit_cast(f32x4, (u64x2_){z0_, z1_}); } } while (0)
    PG8_ZERO_ACC();
    bf16x8 At[4][2], B0[2][2], B1[2][2];
    const char* cA = (const char*)g.A + (size_t)cur.pm * tstep; const char* cB = (const char*)g.Bt + (size_t)cur.pn * tstep;
    S.a_ready(cur);
    if constexpr (SP2) {
        PG8_STAGE(PG8_SB(0, 0), cB, voffB); PG8_STAGE(PG8_SB(0, 1), cB + hstep, voffB); PG8_STAGE(PG8_SA(0, 0), cA, voffA); PG8_STAGE(PG8_SA(0, 1), cA + hstep, voffA);
        if (wr == 1) PG8_BAR;
        PG8_WAIT_V(2); PG8_BAR;
        PG8_STAGE(PG8_SB(1, 0), cB + kstep, voffB); PG8_STAGE(PG8_SA(1, 0), cA + kstep, voffA); PG8_STAGE(PG8_SB(1, 1), cB + hstep + kstep, voffB);
        PG8_WAIT_V(6); PG8_BAR;
    } else {
        PG8_STAGE(PG8_SB(0, 0), cB, voffB); PG8_STAGE(PG8_SA(0, 0), cA, voffA); PG8_STAGE(PG8_SB(0, 1), cB + hstep, voffB); PG8_STAGE(PG8_SA(0, 1), cA + hstep, voffA);
        if (wr == 1) PG8_BAR;
        PG8_WAIT_V(4); PG8_BAR;
        PG8_STAGE(PG8_SB(1, 0), cB + kstep, voffB); PG8_STAGE(PG8_SA(1, 0), cA + kstep, voffA); PG8_STAGE(PG8_SB(1, 1), cB + hstep + kstep, voffB);
        PG8_WAIT_V(6); PG8_BAR;
    }
    for (;;) {
        const bool has_next = S.next(ui + 1, nxt);
        typename Epi::Pre pre; E.prefetch(pre, cur, wr, fr, lds, ui, wid, lane);
        const char* nA = has_next ? (const char*)g.A + (size_t)nxt.pm * tstep : cA; const char* nB = has_next ? (const char*)g.Bt + (size_t)nxt.pn * tstep : cB;
        for (int t = 0; t < nt; t += 2) {
            const bool last = (t == nt - 2);
            const char* a1 = cA + (size_t)(t + 1) * kstep;
            const char* a2 = last ? nA : cA + (size_t)(t + 2) * kstep; const char* b2 = last ? nB : cB + (size_t)(t + 2) * kstep;
            const char* a3 = a2 + kstep; const char* b3 = b2 + kstep;
            if (last && has_next) S.a_ready(nxt);
            if constexpr (SP2) {
            PG8_LDB(B0, 0, 0); PG8_LDB(B1, 0, 1); PG8_SCHED; PG8_LDA(At, 0, 0); PG8_STAGE(PG8_SA(1, 1), a1 + hstep, voffA);
            PG8_WAIT_V(8); PG8_WAIT_L(0); PG8_BAR; PG8_MMA(0, 0, At, B0); PG8_MMA(0, 1, At, B1); PG8_BAR; PG8_SCHED;
            PG8_LDA(At, 0, 1); PG8_STAGE(PG8_SB(0, 0), b2, voffB); PG8_STAGE(PG8_SB(0, 1), b2 + hstep, voffB); PG8_STAGE(PG8_SA(0, 0), a2, voffA);
            PG8_WAIT_V(8); PG8_WAIT_L(0); PG8_BAR; PG8_MMA(1, 0, At, B0); PG8_MMA(1, 1, At, B1); PG8_BAR; PG8_SCHED;
            PG8_LDB(B0, 1, 0); PG8_LDB(B1, 1, 1); PG8_SCHED; PG8_LDA(At, 1, 0); PG8_STAGE(PG8_SA(0, 1), a2 + hstep, voffA);
            PG8_WAIT_V(8); PG8_WAIT_L(0); PG8_BAR; PG8_MMA(0, 0, At, B0); PG8_MMA(0, 1, At, B1); PG8_BAR; PG8_SCHED;
            PG8_LDA(At, 1, 1); PG8_STAGE(PG8_SB(1, 0), b3, voffB); PG8_STAGE(PG8_SB(1, 1), b3 + hstep, voffB); PG8_STAGE(PG8_SA(1, 0), a3, voffA);
            PG8_WAIT_V(8); PG8_WAIT_L(0); PG8_BAR; PG8_MMA(1, 0, At, B0); PG8_MMA(1, 1, At, B1); PG8_BAR; PG8_SCHED;
            } else {
            PG8_LDB(B0, 0, 0); PG8_SCHED; PG8_LDA(At, 0, 0); PG8_STAGE(PG8_SA(1, 1), a1 + hstep, voffA);
            PG8_WAIT_L(8); PG8_BAR; PG8_WAIT_L(0); PG8_MMA(0, 0, At, B0); PG8_BAR; PG8_SCHED;
            PG8_LDB(B1, 0, 1); PG8_STAGE(PG8_SB(0, 0), b2, voffB);
            PG8_BAR; PG8_WAIT_L(0); PG8_MMA(0, 1, At, B1); PG8_BAR;
            PG8_LDA(At, 0, 1); PG8_STAGE(PG8_SA(0, 0), a2, voffA);
            PG8_BAR; PG8_WAIT_L(0); PG8_MMA(1, 0, At, B0); PG8_BAR; PG8_SCHED;
            PG8_STAGE(PG8_SB(0, 1), b2 + hstep, voffB);
            PG8_WAIT_V(6); PG8_BAR; PG8_MMA(1, 1, At, B1); PG8_BAR;
            PG8_LDB(B0, 1, 0); PG8_SCHED; PG8_LDA(At, 1, 0); PG8_STAGE(PG8_SA(0, 1), a2 + hstep, voffA);
            PG8_WAIT_L(8); PG8_BAR; PG8_WAIT_L(0); PG8_MMA(0, 0, At, B0); PG8_BAR; PG8_SCHED;
            PG8_LDB(B1, 1, 1); PG8_STAGE(PG8_SB(1, 0), b3, voffB);
            PG8_BAR; PG8_WAIT_L(0); PG8_MMA(0, 1, At, B1); PG8_BAR;
            PG8_LDA(At, 1, 1); PG8_STAGE(PG8_SA(1, 0), a3, voffA);
            PG8_BAR; PG8_WAIT_L(0); PG8_MMA(1, 0, At, B0); PG8_BAR; PG8_SCHED;
            PG8_STAGE(PG8_SB(1, 1), b3 + hstep, voffB);
            PG8_WAIT_V(6); PG8_BAR; PG8_MMA(1, 1, At, B1); PG8_BAR;
            }
        }
        if constexpr (ALIGN_EPI) { if (wr == 0) PG8_BAR; }
        if constexpr (!Epi::AFTER_DRAIN) { E(acc, cur, wr, wc, fr, fq, pre); S.done(cur); }
        if (!has_next) break;
        PG8_ZERO_ACC();
        cur = nxt; cA = nA; cB = nB; ++ui;
        if constexpr (ALIGN_EPI) { if (wr == 1) PG8_BAR; }
    }
    PG8_WAIT_V(0);
    if constexpr (!ALIGN_EPI) { if (wr == 0) PG8_BAR; }
    PG8_BAR;
    if constexpr (Epi::AFTER_DRAIN) { E.fused(acc, cur, wr, wc, fr, fq, lds, wid, lane); S.done(cur); }
#undef PG8_SA
#undef PG8_SB
#undef PG8_STAGE
#undef PG8_LDA
#undef PG8_LDB
#undef PG8_MMA
#undef PG8_WAIT_V
#undef PG8_WAIT_L
#undef PG8_BAR
#undef PG8_SCHED
}
}
constexpr int BATCH = 2, SEQ = 16384, DM = 2048, M = BATCH * SEQ, DFF = 5632, NGU = 2 * DFF, NIN = 6152, NPROJ = 6144, DEPTH = 4, GW = 512;
constexpr float NORM_EPS = 1e-6f;
constexpr int PC_AQ = 0, PC_AF = 512, PC_AI = 1024, PC_AG = 1536, PC_BQ = 2048, PC_BK = 2560, PC_BV = 3072, PC_CZ = 3584, PC_CX = 4096, PC_DX = 5120, PC_DG = 5632;
constexpr int NWAVES = 8, NTHR = 512;
#ifndef MK_ONE_LAUNCH
#define MK_ONE_LAUNCH 1
#endif
constexpr size_t MiB = 1u << 20;
constexpr size_t WS_CTL = 0, CTL_ZERO_BYTES = 4 * MiB;
constexpr size_t WS_ROWSS = 64 * 1024;
typedef unsigned rs_t;
constexpr float RS_SCALE = 1024.0f, RS_INV = 1.0f / 1024.0f;
constexpr size_t WS_WGU1 = 4 * MiB, WS_WD1 = 48 * MiB, WS_WGU2 = 70 * MiB, WS_WD2 = 114 * MiB, WS_WIN = 136 * MiB, WS_WOUT = 160 * MiB, WS_WDT = 168 * MiB;
constexpr size_t WS_XB = 170 * MiB;
constexpr size_t WS_HP = 298 * MiB;
constexpr size_t WS_Y = 682 * MiB;
constexpr size_t WS_XBCC = 810 * MiB;
constexpr size_t WS_DTV = 938 * MiB;
constexpr size_t WS_LA = 939 * MiB, WS_LB = 1003 * MiB;
constexpr size_t WS_OA = 1067 * MiB, WS_OB = 1131 * MiB, WS_OC = 1195 * MiB, WS_OD = 1259 * MiB;
constexpr size_t WS_HGU = 1323 * MiB, WS_HGD = 1451 * MiB, WS_HGS = 1452 * MiB;
constexpr size_t WS_WDTB = WS_WDT + 65536, WS_CDEC = WS_WDT + 131072;
constexpr size_t WS_SDST = WS_XBCC, WS_SDPV = WS_OA;
constexpr size_t WS_LRA = WS_LA, WS_LRH = WS_LA + MiB, WS_LRC = WS_LA + 2 * MiB;
constexpr size_t WS_XLO = WS_OB;
constexpr size_t WS_PAO = WS_OC, WS_PAM = WS_OC + 32 * MiB;
constexpr size_t WS_END = 1516 * MiB;
static_assert(WS_ROWSS + 13 * (size_t)M * 8 <= CTL_ZERO_BYTES, "ctl");
static_assert(WS_WGU1 + (size_t)NGU * DM * 2 <= WS_WD1 && WS_WD1 + (size_t)DM * DFF * 2 <= WS_WGU2 && WS_WGU2 + (size_t)NGU * DM * 2 <= WS_WD2 && WS_WD2 + (size_t)DM * DFF * 2 <= WS_WIN &&
              WS_WIN + (size_t)NPROJ * DM * 2 <= WS_WOUT && WS_WOUT + (size_t)DM * DM * 2 <= WS_WDT && WS_WDT + 8 * DM * 4 <= WS_XB && WS_XB + (size_t)M * DM * 2 <= WS_HP &&
              WS_HP + (size_t)M * NPROJ * 2 <= WS_Y && WS_Y + (size_t)M * DM * 2 <= WS_XBCC && WS_XBCC + (size_t)M * 1024 * 4 <= WS_DTV && WS_DTV + (size_t)M * 8 * 4 <= WS_LA &&
              WS_LA + (size_t)M * 512 * 4 <= WS_LB && WS_LB + (size_t)M * 512 * 4 <= WS_OA && WS_OD + (size_t)M * 512 * 4 <= WS_END, "d_ws map");
constexpr int CW_BAR = 1024;
constexpr int RING_BYTES = 131072, LDSCTL_OFF = 143360, MISC_OFF = LDSCTL_OFF + 320, LDS_BYTES = 147456;

#define GAS __attribute__((address_space(1)))
#define LAS __attribute__((address_space(3)))
typedef unsigned short bf16;
typedef unsigned v4u __attribute__((ext_vector_type(4)));
typedef unsigned v2u __attribute__((ext_vector_type(2)));
typedef float f32x4 __attribute__((ext_vector_type(4)));
#define LDS_WAIT() asm volatile("s_waitcnt lgkmcnt(0)" ::: "memory")
typedef float f32x2_t __attribute__((ext_vector_type(2)));
typedef __bf16 bf16x2_t __attribute__((ext_vector_type(2)));
__device__ __forceinline__ unsigned pk2(float lo, float hi) { const f32x2_t v = {lo, hi}; return __builtin_bit_cast(unsigned, __builtin_convertvector(v, bf16x2_t)); }
__device__ __forceinline__ unsigned f2bf(float f) { return pk2(f, f) & 0xffffu; }
__device__ __forceinline__ float bf2f(unsigned b) { return __builtin_bit_cast(float, b << 16); }
__device__ __forceinline__ float bflo(unsigned w) { return __builtin_bit_cast(float, w << 16); }
__device__ __forceinline__ float bfhi(unsigned w) { return __builtin_bit_cast(float, w & 0xffff0000u); }
__device__ __forceinline__ float wave_sum(float v) {
#pragma unroll
    for (int o = 1; o < 64; o <<= 1) v += __shfl_xor(v, o);
    return v;
}
__device__ __forceinline__ float sigmoidf_(float v) { return __builtin_amdgcn_rcpf(1.0f + __builtin_amdgcn_exp2f(v * -1.4426950408889634f)); }
__device__ __forceinline__ float siluf_(float v) { return v * __builtin_amdgcn_rcpf(1.0f + __builtin_amdgcn_exp2f(v * -1.4426950408889634f)); }
__device__ __forceinline__ float softplusf_(float v) { return v > 20.f ? v : log1pf(__expf(v)); }
__device__ __forceinline__ float geluf_(float v) { const float u = 0.7978845608028654f * (v + 0.044715f * v * v * v); return 0.5f * v * (1.0f + tanhf(u)); }
#define XB_TMO      128
#define XB_XCNT(j)  (256  + 64 * (j))
#define XB_XSUB(j)  (1280 + 64 * (j))
#define XB_XGEN(j)  (2304 + 64 * (j))
#define XB_TOP      3328
#define XB_TOPGEN   3392
#define XCD_BAR_WORDS 3456
#define XB_SPIN_CAP (1u << 18)

__device__ __forceinline__ unsigned xb_ld(unsigned* p)              { return __hip_atomic_load(p, __ATOMIC_RELAXED, __HIP_MEMORY_SCOPE_AGENT); }
__device__ __forceinline__ unsigned xb_add(unsigned* p, unsigned v) { return __hip_atomic_fetch_add(p, v, __ATOMIC_RELAXED, __HIP_MEMORY_SCOPE_AGENT); }
__device__ __forceinline__ unsigned xb_xcc_id() { return (unsigned)__builtin_amdgcn_s_getreg((3 << 11) | 20) & 0xFu; }
#define XB_SPIN(cond, bar) do { unsigned _sp = 0; while (cond) { __builtin_amdgcn_s_sleep(1); \
    if ((++_sp & 255u) == 0u) { if (xb_ld(&(bar)[XB_TMO])) break; if (_sp > XB_SPIN_CAP) { atomicAdd(&(bar)[XB_TMO], 1u); break; } } } } while (0)

struct XcdBarrier {
    unsigned* bar; unsigned x;
    volatile LAS unsigned* st;
};

__device__ __forceinline__ XcdBarrier xcd_barrier_post(unsigned* bar, volatile LAS unsigned* st) {
    XcdBarrier b; b.bar = bar; b.x = xb_xcc_id(); b.st = st;
    if (threadIdx.x == 0) (void)xb_add(&bar[XB_XCNT(b.x)], 1u);
    return b;
}
__device__ __forceinline__ void xcd_barrier_complete(unsigned* bar, unsigned x, unsigned& nloc, unsigned& nx) {
    const unsigned G = gridDim.x * gridDim.y * gridDim.z;
    unsigned sum, cnt, mine, sp = 0u;
    for (;;) {
        sum = 0u; cnt = 0u; mine = 0u;
#pragma unroll
        for (unsigned j = 0; j < 16; ++j) { const unsigned c = xb_ld(&bar[XB_XCNT(j)]); sum += c; cnt += (c > 0u) ? 1u : 0u; mine = (j == x) ? c : mine; }
        if (sum == G) break;
        __builtin_amdgcn_s_sleep(1);
        if ((++sp & 255u) == 0u) { if (xb_ld(&bar[XB_TMO])) break; if (sp > XB_SPIN_CAP) { atomicAdd(&bar[XB_TMO], 1u); break; } }
    }
    nloc = mine > 0u ? mine : 1u; nx = cnt > 0u ? cnt : 1u;
}

__device__ __forceinline__ void xcd_barrier(const XcdBarrier& b) {
    asm volatile("s_waitcnt vmcnt(0)" ::: "memory");
    __syncthreads();
    if (threadIdx.x == 0) {
        unsigned* bar = b.bar;
        __builtin_amdgcn_s_waitcnt(0);
        unsigned nloc = b.st[0], nx = b.st[1];
        if (nloc == 0u) { xcd_barrier_complete(bar, b.x, nloc, nx); b.st[0] = nloc; b.st[1] = nx; }
        const unsigned old = xb_add(&bar[XB_XSUB(b.x)], 1u);
        const unsigned gen = old / nloc;
        if (old + 1u == (gen + 1u) * nloc) {
            __builtin_amdgcn_fence(__ATOMIC_RELEASE, "agent");
            asm volatile("s_waitcnt vmcnt(0)" ::: "memory");
            const unsigned og = xb_add(&bar[XB_TOP], 1u);
            const unsigned tg = og / nx;
            if (og + 1u == (tg + 1u) * nx) xb_add(&bar[XB_TOPGEN], 1u);
            else XB_SPIN(xb_ld(&bar[XB_TOPGEN]) == tg, bar);
            __builtin_amdgcn_fence(__ATOMIC_ACQUIRE, "agent");
            xb_add(&bar[XB_XGEN(b.x)], 1u);
            asm volatile("s_waitcnt vmcnt(0)" ::: "memory");
        } else {
            XB_SPIN(xb_ld(&bar[XB_XGEN(b.x)]) == gen, bar);
            __builtin_amdgcn_fence(__ATOMIC_ACQUIRE, "agent");
            asm volatile("s_waitcnt vmcnt(0)" ::: "memory");
        }
    }
    __syncthreads();
}

struct Args {
    const float* in[30];
    float* out; unsigned char* ws; int ph_lo, ph_hi;
};
enum { I_X = 0, I_F1N, I_F1G, I_F1U, I_F1D, I_MIXN, I_WIN, I_WOUT, I_LBL, I_HGN, I_ATN, I_SCW, I_SCB, I_SDTB, I_SALOG, I_SD, I_SNORM, I_LCW, I_LCB, I_LWA, I_LBA, I_LWX, I_LBX, I_LAP, I_LNORM,
       I_F2N, I_F2G, I_F2U, I_F2D, I_FINN };

__device__ __forceinline__ void ph_prep(const float* x, bf16* xb, unsigned char* xlo, rs_t* rowss, int vcu, int G, int tid) {
    const int lane = tid & 63, wave = tid >> 6, wr = wave >> 2, wc = wave & 3, fr = lane & 15, fq = lane >> 4;
    for (int t = vcu; t < (M / 256) * (DM / 256); t += G) { const int pm = t >> 3, pn = t & 7;
#pragma unroll
        for (int am = 0; am < 8; ++am) { const int row = pm * 256 + (am >> 2) * 128 + wr * 64 + (am & 3) * 16 + fr; float ss = 0.f; v4u wl = {0u, 0u, 0u, 0u};
#pragma unroll
            for (int bj = 0; bj < 2; ++bj) { const size_t o2 = (size_t)row * DM + pn * 256 + bj * 128 + wc * 32 + 8 * fq; const f32x4 v0 = *(const f32x4*)(x + o2), v1 = *(const f32x4*)(x + o2 + 4);
                ss += (v0.x * v0.x + v0.y * v0.y) + (v0.z * v0.z + v0.w * v0.w) + (v1.x * v1.x + v1.y * v1.y) + (v1.z * v1.z + v1.w * v1.w);
                v4u w; w.x = pk2(v0.x, v0.y); w.y = pk2(v0.z, v0.w); w.z = pk2(v1.x, v1.y); w.w = pk2(v1.z, v1.w); *(v4u*)(xb + o2) = w;
                if (MK_LO) { wl[2 * bj] = pg8::lo_enc(v0.x, w.x & 0xffffu) | (pg8::lo_enc(v0.y, w.x >> 16) << 8) | (pg8::lo_enc(v0.z, w.y & 0xffffu) << 16) | (pg8::lo_enc(v0.w, w.y >> 16) << 24);
                wl[2 * bj + 1] = pg8::lo_enc(v1.x, w.z & 0xffffu) | (pg8::lo_enc(v1.y, w.z >> 16) << 8) | (pg8::lo_enc(v1.z, w.w & 0xffffu) << 16) | (pg8::lo_enc(v1.w, w.w >> 16) << 24); } }
            if (MK_LO) *(v4u*)(xlo + pg8::lo_addr(pm, pn, am, wave, lane)) = wl;
            ss += __shfl_xor(ss, 16); ss += __shfl_xor(ss, 32);
            if (fq == 0) atomicAdd(rowss + row, (rs_t)(ss * RS_SCALE + 0.5f)); } }
}
struct CvtDesc { const float* W; const float* kscale; bf16* WT; int K, N, mode, r; };
constexpr int CV_G = (DM / 64) * (DFF / 32), CV_IN = (DM / 64) * ((NIN + 31) / 32), CV_OUT = (DM / 64) * (DM / 32);
static_assert((DFF / 64) * (DM / 32) == CV_G, "items");
constexpr int CVM_F1 = 1, CVM_F2 = 2, CVM_IN = 4, CVM_OUT = 8;
__host__ __device__ constexpr int cvt_nitems(int mask) { return ((mask & CVM_F1) ? 3 * CV_G : 0) + ((mask & CVM_F2) ? 3 * CV_G : 0) + ((mask & CVM_IN) ? CV_IN : 0) + ((mask & CVM_OUT) ? CV_OUT : 0); }
__device__ __forceinline__ CvtDesc cvt_decode(const Args& a, unsigned char* ws, int l, int mask, int it) {
    const size_t oF = (size_t)l * DM * DFF, oN = (size_t)l * DM; int r = it; CvtDesc d;
    if (mask & CVM_F1) {
        if (r < CV_G) { d = CvtDesc{a.in[I_F1G] + oF, a.in[I_F1N] + oN, (bf16*)(ws + WS_WGU1), DM, DFF, 1, r}; return d; } r -= CV_G;
        if (r < CV_G) { d = CvtDesc{a.in[I_F1U] + oF, a.in[I_F1N] + oN, (bf16*)(ws + WS_WGU1), DM, DFF, 2, r}; return d; } r -= CV_G;
        if (r < CV_G) { d = CvtDesc{a.in[I_F1D] + oF, nullptr, (bf16*)(ws + WS_WD1), DFF, DM, 0, r}; return d; } r -= CV_G; }
    if (mask & CVM_F2) {
        if (r < CV_G) { d = CvtDesc{a.in[I_F2G] + oF, a.in[I_F2N] + oN, (bf16*)(ws + WS_WGU2), DM, DFF, 1, r}; return d; } r -= CV_G;
        if (r < CV_G) { d = CvtDesc{a.in[I_F2U] + oF, a.in[I_F2N] + oN, (bf16*)(ws + WS_WGU2), DM, DFF, 2, r}; return d; } r -= CV_G;
        if (r < CV_G) { d = CvtDesc{a.in[I_F2D] + oF, nullptr, (bf16*)(ws + WS_WD2), DFF, DM, 0, r}; return d; } r -= CV_G; }
    if (mask & CVM_IN) { if (r < CV_IN) { d = CvtDesc{a.in[I_WIN] + (size_t)l * DM * NIN, a.in[I_MIXN] + oN, (bf16*)(ws + WS_WIN), DM, NIN, 3, r}; return d; } r -= CV_IN; }
    d = CvtDesc{a.in[I_WOUT] + (size_t)l * DM * DM, nullptr, (bf16*)(ws + WS_WOUT), DM, DM, 0, r}; return d;
}
__device__ __forceinline__ void cvt_load(const CvtDesc& d, int lane, f32x4 (&v)[8]) {
    const int nblk = (d.N + 31) / 32, kb = d.r / nblk, nb = d.r % nblk, k0 = 64 * kb, n = 32 * nb + (lane & 7) * 4, kr = lane >> 3;
#pragma unroll
    for (int i = 0; i < 8; ++i) v[i] = (n < d.N) ? *(const f32x4*)(d.W + (size_t)(k0 + kr + 8 * i) * d.N + n) : (f32x4){0.f, 0.f, 0.f, 0.f};
}
__device__ __forceinline__ void cvt_store(const CvtDesc& d, unsigned char* ws, int lane, const f32x4 (&v)[8], LAS float* scr) {
    const int nblk = (d.N + 31) / 32, kb = d.r / nblk, nb = d.r % nblk, k0 = 64 * kb, n0 = 32 * nb, kr = lane >> 3, n4 = (lane & 7) * 4, K = d.K;
#pragma unroll
    for (int i = 0; i < 8; ++i) { const int kk = kr + 8 * i; const float sc = d.kscale ? d.kscale[k0 + kk] : 1.0f; LAS float* s = scr + kk * 33 + n4; s[0] = v[i][0] * sc; s[1] = v[i][1] * sc; s[2] = v[i][2] * sc; s[3] = v[i][3] * sc; }
    LDS_WAIT(); asm volatile("" ::: "memory");
    const int c = lane & 7;
#pragma unroll
    for (int j = 0; j < 4; ++j) { const int nl = (lane >> 3) + 8 * j, n = n0 + nl; const LAS float* s = scr + (8 * c) * 33 + nl;
        const float a0 = s[0 * 33], a1 = s[1 * 33], a2 = s[2 * 33], a3 = s[3 * 33], a4 = s[4 * 33], a5 = s[5 * 33], a6 = s[6 * 33], a7 = s[7 * 33];
        if (n < d.N) {
            int dr = n; bool special = false;
            if (d.mode == 1) dr = 256 * (n >> 7) + (n & 127);
            if (d.mode == 2) dr = 256 * (n >> 7) + 128 + (n & 127);
            if (d.mode == 3) { if (n >= 5128) dr = n - 8; else if (n >= 5120) special = true; }
            v4u o; o.x = pk2(a0, a1); o.y = pk2(a2, a3); o.z = pk2(a4, a5); o.w = pk2(a6, a7);
            if (special) { float* f = (float*)(ws + WS_WDT) + (size_t)(n - 5120) * K + k0 + 8 * c; *(f32x4*)f = (f32x4){a0, a1, a2, a3}; *(f32x4*)(f + 4) = (f32x4){a4, a5, a6, a7};
                *(v4u*)((bf16*)(ws + WS_WDTB) + (size_t)(n - 5120) * K + k0 + 8 * c) = o; }
            else *(v4u*)(d.WT + (size_t)dr * K + k0 + 8 * c) = o;
        } }
    LDS_WAIT(); asm volatile("" ::: "memory");
}
__device__ __forceinline__ void ph_convert(const Args& a, unsigned char* ws, int l, int mask, LAS unsigned char* lds, int gw, int ngw, int wave, int lane) {
    LAS float* scr = (LAS float*)(lds + wave * 16384);
    const int nitems = cvt_nitems(mask);
    int it = gw; if (it >= nitems) return;
    CvtDesc d0 = cvt_decode(a, ws, l, mask, it); f32x4 v[8]; cvt_load(d0, lane, v);
    for (; it < nitems; it += ngw) {
        const int nx = it + ngw; CvtDesc d1 = d0; f32x4 vn[8];
        if (nx < nitems) { d1 = cvt_decode(a, ws, l, mask, nx); cvt_load(d1, lane, vn); }
        else {
#pragma unroll
            for (int i = 0; i < 8; ++i) vn[i] = v[i]; }
        cvt_store(d0, ws, lane, v, scr);
        d0 = d1;
#pragma unroll
        for (int i = 0; i < 8; ++i) v[i] = vn[i];
    }
}
typedef short bf16x8_t __attribute__((ext_vector_type(8)));
typedef short s16x4_t __attribute__((ext_vector_type(4)));
constexpr int HG_NCH = SEQ / 64;
constexpr int HG_TS = 72;
constexpr int HG_RS = 136;
__device__ __forceinline__ float hg_lb(const float* lg, int l, int ch) {
    float mx = lg[ch];
#pragma unroll
    for (int i = 1; i < DEPTH; ++i) mx = fmaxf(mx, lg[i * 512 + ch]);
    float den = 0.f, num = 0.f;
#pragma unroll
    for (int i = 0; i < DEPTH; ++i) { const float e = __expf(lg[i * 512 + ch] - mx); den += e; if (i >= 1 && i <= l) num += e; }
    return num / den;
}
__device__ __forceinline__ unsigned pkbf(float a, float b) { return pk2(a, b); }
struct HgRaw { bf16 z[16], v[16], q[16]; };
template <bool WITHQ> __device__ __forceinline__ void hg_load(HgRaw& R, unsigned char* ws, int unit, int tid) {
    const bf16* proj = (const bf16*)(ws + WS_HP);
    const int h = unit & 3, chunk = (unit >> 2) & (HG_NCH - 1), b = unit >> 10, qt = tid >> 7, col = tid & 127, ch = h * 128 + col;
    const size_t row0 = (size_t)b * SEQ + (size_t)chunk * 64 + 16 * qt;
#pragma unroll
    for (int i = 0; i < 16; ++i) { const bf16* p = proj + (row0 + i) * NPROJ + ch; R.z[i] = p[PC_AF]; R.v[i] = p[PC_AI]; if (WITHQ) R.q[i] = p[PC_AQ]; }
}
__device__ __forceinline__ void hg_p1_unit(const Args& a, unsigned char* ws, int l, int unit, int next, HgRaw& R, LAS unsigned char* lds, int tid_in) {
    int tid = tid_in; asm volatile("" : "+v"(tid));
    const bf16* proj = (const bf16*)(ws + WS_HP); bf16* UT = (bf16*)(ws + WS_HGU); float* DCH = (float*)(ws + WS_HGD);
    const int h = unit & 3, chunk = (unit >> 2) & (HG_NCH - 1), b = unit >> 10;
    const int qt = tid >> 7, col = tid & 127, ch = h * 128 + col, lane = tid & 63, wave = tid >> 6;
    LAS bf16* kT = (LAS bf16*)lds; LAS bf16* vT = kT + 128 * HG_TS; LAS float* tots = (LAS float*)(vT + 128 * HG_TS);
    const float lb = hg_lb(a.in[I_LBL], l, ch);
    const size_t row0 = (size_t)b * SEQ + (size_t)chunk * 64 + 16 * qt;
    float suf[16], kk[16], vv[16];
    { float ff[16];
#pragma unroll
      for (int i = 0; i < 16; ++i) { const float z = bf2f(R.z[i]); vv[i] = bf2f(R.v[i]);
          const float sg = sigmoidf_(z); ff[i] = lb + (1.0f - lb) * sg; kk[i] = (1.0f - lb) * (1.0f - sg); }
      float run = 1.0f;
#pragma unroll
      for (int i = 15; i >= 0; --i) { suf[i] = run; run *= ff[i]; }
      tots[qt * 128 + col] = run; }
    if (next >= 0) hg_load<false>(R, ws, next, tid);
    __syncthreads();
    float post = 1.0f, total = 1.0f;
#pragma unroll
    for (int q = 0; q < 4; ++q) { const float t = tots[q * 128 + col]; total *= t; if (q > qt) post *= t; }
    { unsigned wk[8], wv[8];
#pragma unroll
      for (int i = 0; i < 8; ++i) { const float e0 = kk[2 * i] * (suf[2 * i] * post), e1 = kk[2 * i + 1] * (suf[2 * i + 1] * post); wk[i] = pkbf(e0, e1); wv[i] = pkbf(vv[2 * i], vv[2 * i + 1]); }
      LAS v4u* pk = (LAS v4u*)(kT + col * HG_TS + 16 * qt); LAS v4u* pv = (LAS v4u*)(vT + col * HG_TS + 16 * qt);
      pk[0] = (v4u){wk[0], wk[1], wk[2], wk[3]}; pk[1] = (v4u){wk[4], wk[5], wk[6], wk[7]}; pv[0] = (v4u){wv[0], wv[1], wv[2], wv[3]}; pv[1] = (v4u){wv[4], wv[5], wv[6], wv[7]}; }
    const size_t ubase = ((size_t)(b * 4 + h) * HG_NCH + chunk);
    if (qt == 0) DCH[ubase * 128 + col] = total;
    __syncthreads();
    { const int fr = lane & 15, g = lane >> 4;
      bf16x8_t af[2];
#pragma unroll
      for (int ks = 0; ks < 2; ++ks) af[ks] = *(const LAS bf16x8_t*)(kT + (16 * wave + fr) * HG_TS + 8 * g + 32 * ks);
      bf16* up = UT + ubase * 16384 + (size_t)fr * 128 + 16 * wave + 4 * g;
#pragma unroll
      for (int n = 0; n < 8; ++n) { pg8::f32x4 acc = {0.f, 0.f, 0.f, 0.f};
#pragma unroll
          for (int ks = 0; ks < 2; ++ks) { const bf16x8_t bfr = *(const LAS bf16x8_t*)(vT + (16 * n + fr) * HG_TS + 8 * g + 32 * ks); acc = __builtin_amdgcn_mfma_f32_16x16x32_bf16(af[ks], bfr, acc, 0, 0, 0); }
          *(v2u*)(up + (size_t)(16 * n) * 128) = (v2u){pkbf(acc[0], acc[1]), pkbf(acc[2], acc[3])}; } }
    __syncthreads();
}
__device__ __forceinline__ void hg_p2_item(unsigned char* ws, int item, int tid) {
    const bf16* UT = (const bf16*)(ws + WS_HGU); const float* DCH = (const float*)(ws + WS_HGD); bf16* SPT = (bf16*)(ws + WS_HGS);
    const int bh = item >> 4, v = (item & 15) * 8 + (tid >> 6), k = 2 * (tid & 63);
    typedef float f32x2 __attribute__((ext_vector_type(2)));
    const size_t cb = (size_t)bh * HG_NCH;
    float s0 = 0.f, s1 = 0.f; constexpr int U = 8;
    unsigned ru[U]; f32x2 rd[U];
#pragma unroll
    for (int i = 0; i < U; ++i) { ru[i] = *(const unsigned*)(UT + (cb + i) * 16384 + v * 128 + k); rd[i] = *(const f32x2*)(DCH + (cb + i) * 128 + k); }
    for (int c0 = 0; c0 < HG_NCH; c0 += U) {
        unsigned cu[U]; f32x2 cd[U];
#pragma unroll
        for (int i = 0; i < U; ++i) { cu[i] = ru[i]; cd[i] = rd[i]; }
        if (c0 + U < HG_NCH) {
#pragma unroll
            for (int i = 0; i < U; ++i) { ru[i] = *(const unsigned*)(UT + (cb + c0 + U + i) * 16384 + v * 128 + k); rd[i] = *(const f32x2*)(DCH + (cb + c0 + U + i) * 128 + k); } }
#pragma unroll
        for (int i = 0; i < U; ++i) { *(unsigned*)(SPT + (cb + c0 + i) * 16384 + v * 128 + k) = pkbf(s0, s1); s0 = cd[i].x * s0 + bflo(cu[i]); s1 = cd[i].y * s1 + bfhi(cu[i]); }
    }
}
__device__ __forceinline__ void hg_p3_unit(const Args& a, unsigned char* ws, int l, int unit, int next, HgRaw& R, LAS unsigned char* lds, int tid_in) {
    int tid = tid_in; asm volatile("" : "+v"(tid));
    const bf16* proj = (const bf16*)(ws + WS_HP); const bf16* SPT = (const bf16*)(ws + WS_HGS); bf16* Y = (bf16*)(ws + WS_Y);
    const int h = unit & 3, chunk = (unit >> 2) & (HG_NCH - 1), b = unit >> 10;
    const int qt = tid >> 7, col = tid & 127, ch = h * 128 + col, lane = tid & 63, wave = tid >> 6, fr = lane & 15, g = lane >> 4;
    LAS bf16* Qm = (LAS bf16*)lds; LAS bf16* Qs = Qm + 64 * HG_RS; LAS bf16* Km = Qs + 64 * HG_RS; LAS bf16* vT = Km + 64 * HG_RS; LAS bf16* PT = vT + 128 * HG_TS;
    LAS float* tots = (LAS float*)(PT + 64 * HG_TS); LAS float* ssq = tots + 512;
    const float lb = hg_lb(a.in[I_LBL], l, ch);
    const size_t rowc = (size_t)b * SEQ + (size_t)chunk * 64, row0 = rowc + 16 * qt;
    bf16x8_t sf[4]; v2u grv[4];
    { const size_t sbase = ((size_t)(b * 4 + h) * HG_NCH + chunk) * 16384 + (size_t)(16 * wave + fr) * 128 + 8 * g;
#pragma unroll
      for (int ks = 0; ks < 4; ++ks) sf[ks] = *(const bf16x8_t*)(SPT + sbase + 32 * ks);
#pragma unroll
      for (int j = 0; j < 4; ++j) grv[j] = *(const v2u*)(proj + (rowc + 16 * j + fr) * NPROJ + PC_AG + h * 128 + 16 * wave + 4 * g); }
    float rr[16], kk[16], qq[16], vv[16];
    { float ff[16];
#pragma unroll
      for (int i = 0; i < 16; ++i) { const float z = bf2f(R.z[i]); vv[i] = bf2f(R.v[i]); qq[i] = siluf_(bf2f(R.q[i]));
          const float sg = sigmoidf_(z); ff[i] = lb + (1.0f - lb) * sg; kk[i] = (1.0f - lb) * (1.0f - sg); }
      float run = 1.0f;
      if (qt < 2) {
#pragma unroll
          for (int i = 15; i >= 0; --i) { rr[i] = run; run *= ff[i]; }
      } else {
#pragma unroll
          for (int i = 0; i < 16; ++i) { run *= ff[i]; rr[i] = run; } }
      tots[qt * 128 + col] = run; }
    if (next >= 0) hg_load<true>(R, ws, next, tid);
    if (tid < 128) { const int which = tid >> 6, t = (which ? 32 : 0) + ((tid & 63) >> 2), sq = (which ? 48 : 16) + 4 * (tid & 3); unsigned z0 = 0u; asm volatile("" : "+v"(z0));     *(LAS v2u*)(PT + t * HG_TS + sq) = (v2u){z0, z0}; }
    __syncthreads();
    const float t0_ = tots[col], t1_ = tots[128 + col], t2_ = tots[256 + col];
    const float em = t0_ * t1_, xq = (qt == 0) ? t1_ : (qt == 3) ? t2_ : 1.0f;
    { unsigned wv[8];
#pragma unroll
      for (int i = 0; i < 16; ++i) { const float rv = fmaxf(rr[i] * xq, 1e-30f), ri = __builtin_amdgcn_rcpf(rv); const int t = 16 * qt + i;
          const float ea = (qt < 2) ? ri : rv, eb = (qt < 2) ? rv : ri;
          Qm[t * HG_RS + col] = (bf16)f2bf(qq[i] * ea); Qs[t * HG_RS + col] = (bf16)f2bf(qq[i] * (em * ea)); Km[t * HG_RS + col] = (bf16)f2bf(kk[i] * eb); }
#pragma unroll
      for (int i = 0; i < 8; ++i) wv[i] = pkbf(vv[2 * i], vv[2 * i + 1]);
      LAS v4u* pv = (LAS v4u*)(vT + col * HG_TS + 16 * qt); pv[0] = (v4u){wv[0], wv[1], wv[2], wv[3]}; pv[1] = (v4u){wv[4], wv[5], wv[6], wv[7]}; }
    __syncthreads();
    for (int tt = wave; tt < 10; tt += 8) {
        int ti, tj; { const int ii[10] = {0, 0, 0, 0, 1, 1, 1, 2, 2, 3}, jj[10] = {0, 1, 2, 3, 1, 2, 3, 2, 3, 3}; ti = ii[0]; tj = jj[0];
#pragma unroll
          for (int q = 1; q < 10; ++q) if (tt == q) { ti = ii[q]; tj = jj[q]; } }
        pg8::f32x4 acc = {0.f, 0.f, 0.f, 0.f};
#pragma unroll
        for (int ks = 0; ks < 4; ++ks) { const bf16x8_t af = *(const LAS bf16x8_t*)(Km + (16 * ti + fr) * HG_RS + 8 * g + 32 * ks), bfr = *(const LAS bf16x8_t*)(Qm + (16 * tj + fr) * HG_RS + 8 * g + 32 * ks);
            acc = __builtin_amdgcn_mfma_f32_16x16x32_bf16(af, bfr, acc, 0, 0, 0); }
        const int t = 16 * tj + fr, s0 = 16 * ti + 4 * g;
#pragma unroll
        for (int r = 0; r < 4; ++r) if (s0 + r > t) acc[r] = 0.f;
        *(LAS v2u*)(PT + t * HG_TS + s0) = (v2u){pkbf(acc[0], acc[1]), pkbf(acc[2], acc[3])};
    }
    __syncthreads();
    pg8::f32x4 o[4];
    { bf16x8_t vf[2];
#pragma unroll
      for (int ks = 0; ks < 2; ++ks) vf[ks] = *(const LAS bf16x8_t*)(vT + (16 * wave + fr) * HG_TS + 8 * g + 32 * ks);
#pragma unroll
      for (int j = 0; j < 4; ++j) { pg8::f32x4 acc = {0.f, 0.f, 0.f, 0.f};
#pragma unroll
          for (int ks = 0; ks < 4; ++ks) { const bf16x8_t bfr = *(const LAS bf16x8_t*)(Qs + (16 * j + fr) * HG_RS + 8 * g + 32 * ks); acc = __builtin_amdgcn_mfma_f32_16x16x32_bf16(sf[ks], bfr, acc, 0, 0, 0); }
#pragma unroll
          for (int ks = 0; ks < 2; ++ks) if (ks == 0 || j >= 2) { const bf16x8_t bfr = *(const LAS bf16x8_t*)(PT + (16 * j + fr) * HG_TS + 8 * g + 32 * ks); acc = __builtin_amdgcn_mfma_f32_16x16x32_bf16(vf[ks], bfr, acc, 0, 0, 0); }
          o[j] = acc; } }
#pragma unroll
    for (int j = 0; j < 4; ++j) { float s = (o[j][0] * o[j][0] + o[j][1] * o[j][1]) + (o[j][2] * o[j][2] + o[j][3] * o[j][3]); s += __shfl_xor(s, 16); s += __shfl_xor(s, 32); if (g == 0) ssq[wave * 64 + 16 * j + fr] = s; }
    __syncthreads();
    { const float* nw = a.in[I_HGN] + l * 512 + h * 128 + 16 * wave + 4 * g; const float w0 = nw[0], w1 = nw[1], w2 = nw[2], w3 = nw[3];
#pragma unroll
      for (int j = 0; j < 4; ++j) { const int t = 16 * j + fr; float s = 0.f;
#pragma unroll
          for (int w = 0; w < 8; ++w) s += ssq[w * 64 + t];
          const float r = 1.0f / sqrtf(s * (1.0f / 128.0f) + NORM_EPS);
          const v2u gr = grv[j];
          const float y0 = o[j][0] * r * w0 * siluf_(bflo(gr.x)), y1 = o[j][1] * r * w1 * siluf_(bfhi(gr.x)), y2 = o[j][2] * r * w2 * siluf_(bflo(gr.y)), y3 = o[j][3] * r * w3 * siluf_(bfhi(gr.y));
          *(v2u*)(Y + (rowc + t) * DM + h * 128 + 16 * wave + 4 * g) = (v2u){pkbf(y0, y1), pkbf(y2, y3)}; } }
    __syncthreads();
}
constexpr int SD_TS = 72, SD_RS = 136;
#define SD_CONV8(dst, tok0) do { _Pragma("unroll") for (int i_ = 0; i_ < 8; ++i_) { const float xn_ = bf2f(xr[(tok0) + i_]); \
        const float y_ = cb + cw0 * xm3 + cw1 * xm2 + cw2 * xm1 + cw3 * xn_; xm3 = xm2; xm2 = xm1; xm1 = xn_; dst[i_] = siluf_(y_); } } while (0)
__device__ __forceinline__ void sd_p1_unit(const Args& a, unsigned char* ws, int l, const rs_t* rowss, int unit, LAS unsigned char* lds, int tid_in) {
    int tid = tid_in; asm volatile("" : "+v"(tid));
    const bf16* proj = (const bf16*)(ws + WS_HP); const bf16* xb = (const bf16*)(ws + WS_XB); const bf16* wdtb = (const bf16*)(ws + WS_WDTB);
    bf16* STATES = (bf16*)(ws + WS_SDST); float* CDEC = (float*)(ws + WS_CDEC); float* DTV = (float*)(ws + WS_DTV);
    const int chunk = unit & 255, b = unit >> 8, lane = tid & 63, wave = tid >> 6, fr = lane & 15, g = lane >> 4;
    const size_t row0 = (size_t)b * SEQ + (size_t)chunk * 64;
    LAS float* dtl = (LAS float*)lds; LAS float* acs = dtl + 512;
    LAS float* part = (LAS float*)(lds + 4096);
    LAS bf16* XT = (LAS bf16*)(lds + 4096); LAS bf16* BT = XT + 512 * SD_TS;
    { pg8::f32x4 acc[4];
#pragma unroll
      for (int tt = 0; tt < 4; ++tt) acc[tt] = (pg8::f32x4){0.f, 0.f, 0.f, 0.f};
#pragma unroll 4
      for (int ks = 0; ks < 8; ++ks) { const int k = 256 * wave + 32 * ks + 8 * g;
          bf16x8_t bfr = {0, 0, 0, 0, 0, 0, 0, 0}; if (fr < 8) bfr = *(const bf16x8_t*)(wdtb + fr * DM + k);
#pragma unroll
          for (int tt = 0; tt < 4; ++tt) { const bf16x8_t af = *(const bf16x8_t*)(xb + (row0 + 16 * tt + fr) * DM + k); acc[tt] = __builtin_amdgcn_mfma_f32_16x16x32_bf16(af, bfr, acc[tt], 0, 0, 0); } }
      if (fr < 8) {
#pragma unroll
          for (int tt = 0; tt < 4; ++tt)
#pragma unroll
              for (int r = 0; r < 4; ++r) part[(wave * 64 + 16 * tt + 4 * g + r) * 8 + fr] = acc[tt][r]; } }
    __syncthreads();
    { const int t = tid >> 3, h = tid & 7; float s = 0.f;
#pragma unroll
      for (int w = 0; w < 8; ++w) s += part[(w * 64 + t) * 8 + h];
      const float r = 1.0f / sqrtf((float)rowss[row0 + t] * (RS_INV / DM) + NORM_EPS);
      const float dt = softplusf_(s * r + a.in[I_SDTB][l * 8 + h]); dtl[t * 8 + h] = dt; DTV[(row0 + t) * 8 + h] = dt; }
    __syncthreads();
    if (tid < 8) { const float An = -__expf(a.in[I_SALOG][l * 8 + tid]); float run = 0.f; for (int t = 0; t < 64; ++t) { run += dtl[t * 8 + tid] * An; acs[t * 8 + tid] = run; }
        CDEC[(size_t)(b * 256 + chunk) * 8 + tid] = __expf(run); }
    __syncthreads();
    { const float* cwp = a.in[I_SCW] + (size_t)l * 4 * 1024; const float* cbp = a.in[I_SCB] + (size_t)l * 1024;
#pragma unroll
      for (int pass = 0; pass < 2; ++pass) { if (pass == 1 && tid >= 256) break;
          const int c = pass * 512 + tid; const float cw0 = cwp[c], cw1 = cwp[1024 + c], cw2 = cwp[2048 + c], cw3 = cwp[3072 + c], cb = cbp[c];
          const bf16* xp = proj + row0 * NPROJ + PC_CX + c;
          float xm3 = 0.f, xm2 = 0.f, xm1 = 0.f; if (chunk > 0) { xm3 = bf2f(xp[-3 * (ptrdiff_t)NPROJ]); xm2 = bf2f(xp[-2 * (ptrdiff_t)NPROJ]); xm1 = bf2f(xp[-(ptrdiff_t)NPROJ]); }
          const int h = tid >> 6; const float al = acs[63 * 8 + h];
          LAS bf16* dst = (pass == 0) ? (XT + tid * SD_TS) : (BT + tid * SD_TS);
          bf16 xr[64];
#pragma unroll
          for (int t = 0; t < 64; ++t) xr[t] = xp[(ptrdiff_t)t * NPROJ];
#pragma unroll
          for (int s8 = 0; s8 < 8; ++s8) { float v[8]; SD_CONV8(v, 8 * s8);
              if (pass == 0) {
#pragma unroll
                  for (int i = 0; i < 8; ++i) { const int s = 8 * s8 + i; v[i] *= dtl[s * 8 + h] * __expf(al - acs[s * 8 + h]); } }
              *(LAS v4u*)(dst + 8 * s8) = (v4u){pkbf(v[0], v[1]), pkbf(v[2], v[3]), pkbf(v[4], v[5]), pkbf(v[6], v[7])}; } } }
    __syncthreads();
    { const int grp = wave >> 2; bf16* sp = STATES + ((size_t)(b * 256 + chunk) * 8 + wave) * 8192;
#pragma unroll 1
      for (int mt = 0; mt < 4; ++mt) { bf16x8_t bfx[2];
#pragma unroll
          for (int ks = 0; ks < 2; ++ks) bfx[ks] = *(const LAS bf16x8_t*)(XT + (wave * 64 + 16 * mt + fr) * SD_TS + 8 * g + 32 * ks);
#pragma unroll
          for (int nt = 0; nt < 8; ++nt) { pg8::f32x4 acc = {0.f, 0.f, 0.f, 0.f};
#pragma unroll
              for (int ks = 0; ks < 2; ++ks) { const bf16x8_t afn = *(const LAS bf16x8_t*)(BT + (grp * 128 + 16 * nt + fr) * SD_TS + 8 * g + 32 * ks); acc = __builtin_amdgcn_mfma_f32_16x16x32_bf16(afn, bfx[ks], acc, 0, 0, 0); }
              *(v2u*)(sp + (16 * mt + fr) * 128 + 16 * nt + 4 * g) = (v2u){pkbf(acc[0], acc[1]), pkbf(acc[2], acc[3])}; } } }
    __syncthreads();
}
__device__ __forceinline__ void sd_p2_item(unsigned char* ws, int item, int tid) {
    const bf16* STATES = (const bf16*)(ws + WS_SDST); const float* CDEC = (const float*)(ws + WS_CDEC); bf16* PREV = (bf16*)(ws + WS_SDPV);
    const int bh = item >> 3, b = bh >> 3, h = bh & 7, p = (item & 7) * 8 + (tid >> 6), n = 2 * (tid & 63);
    typedef float f32x2 __attribute__((ext_vector_type(2)));
    float s0 = 0.f, s1 = 0.f; constexpr int U = 8;
    unsigned ru[U]; float rd[U];
#define SD_IDX(c_) (((size_t)(b * 256 + (c_)) * 8 + h) * 8192 + p * 128 + n)
#pragma unroll
    for (int i = 0; i < U; ++i) { ru[i] = *(const unsigned*)(STATES + SD_IDX(i)); rd[i] = CDEC[(size_t)(b * 256 + i) * 8 + h]; }
    for (int c0 = 0; c0 < 256; c0 += U) {
        unsigned cu[U]; float cd[U];
#pragma unroll
        for (int i = 0; i < U; ++i) { cu[i] = ru[i]; cd[i] = rd[i]; }
        if (c0 + U < 256) {
#pragma unroll
            for (int i = 0; i < U; ++i) { ru[i] = *(const unsigned*)(STATES + SD_IDX(c0 + U + i)); rd[i] = CDEC[(size_t)(b * 256 + c0 + U + i) * 8 + h]; } }
#pragma unroll
        for (int i = 0; i < U; ++i) { *(unsigned*)(PREV + SD_IDX(c0 + i)) = pkbf(s0, s1); s0 = cd[i] * s0 + bflo(cu[i]); s1 = cd[i] * s1 + bfhi(cu[i]); }
    }
#undef SD_IDX
}
__device__ __forceinline__ void sd_p3_unit(const Args& a, unsigned char* ws, int l, int unit, LAS unsigned char* lds, int tid_in) {
    int tid = tid_in; asm volatile("" : "+v"(tid));
    const bf16* proj = (const bf16*)(ws + WS_HP); const bf16* PREV = (const bf16*)(ws + WS_SDPV); const float* DTV = (const float*)(ws + WS_DTV); bf16* Y = (bf16*)(ws + WS_Y);
    const int grp = unit & 1, chunk = (unit >> 1) & 255, b = unit >> 9, lane = tid & 63, wave = tid >> 6, fr = lane & 15, g = lane >> 4;
    const size_t row0 = (size_t)b * SEQ + (size_t)chunk * 64;
    LAS float* dtl = (LAS float*)lds; LAS float* acs = dtl + 256; LAS float* ssq = acs + 256;
    LAS bf16* XT = (LAS bf16*)(lds + 4096); LAS bf16* Brm = XT + 256 * SD_TS; LAS bf16* Crm = Brm + 64 * SD_RS;
    if (tid < 256) { const int t = tid >> 2, hh = tid & 3; dtl[t * 4 + hh] = DTV[(row0 + t) * 8 + 4 * grp + hh]; }
    v2u zrv[2][4];
    { const int hh_ = wave >> 1, half_ = wave & 1;
#pragma unroll
      for (int pt = 0; pt < 2; ++pt) {
#pragma unroll
          for (int j = 0; j < 4; ++j) zrv[pt][j] = *(const v2u*)(proj + (row0 + 16 * j + fr) * NPROJ + PC_CZ + grp * 256 + hh_ * 64 + 16 * (2 * half_ + pt) + 4 * g); } }
    __syncthreads();
    if (tid < 4) { const float An = -__expf(a.in[I_SALOG][l * 8 + 4 * grp + tid]); float run = 0.f; for (int t = 0; t < 64; ++t) { run += dtl[t * 4 + tid] * An; acs[t * 4 + tid] = run; } }
    { const float* cwp = a.in[I_SCW] + (size_t)l * 4 * 1024; const float* cbp = a.in[I_SCB] + (size_t)l * 1024;
      const int c = (tid < 256) ? (grp * 256 + tid) : (tid < 384) ? (512 + grp * 128 + (tid - 256)) : (768 + grp * 128 + (tid - 384));
      const float cw0 = cwp[c], cw1 = cwp[1024 + c], cw2 = cwp[2048 + c], cw3 = cwp[3072 + c], cb = cbp[c];
      const bf16* xp = proj + row0 * NPROJ + PC_CX + c;
      float xm3 = 0.f, xm2 = 0.f, xm1 = 0.f; if (chunk > 0) { xm3 = bf2f(xp[-3 * (ptrdiff_t)NPROJ]); xm2 = bf2f(xp[-2 * (ptrdiff_t)NPROJ]); xm1 = bf2f(xp[-(ptrdiff_t)NPROJ]); }
      bf16 xr[64];
#pragma unroll
      for (int t = 0; t < 64; ++t) xr[t] = xp[(ptrdiff_t)t * NPROJ];
#pragma unroll
      for (int s8 = 0; s8 < 8; ++s8) { float v[8]; SD_CONV8(v, 8 * s8);
          if (tid < 256) *(LAS v4u*)(XT + tid * SD_TS + 8 * s8) = (v4u){pkbf(v[0], v[1]), pkbf(v[2], v[3]), pkbf(v[4], v[5]), pkbf(v[6], v[7])};
          else { LAS bf16* d = ((tid < 384) ? Brm : Crm) + (8 * s8) * SD_RS + ((tid - 256) & 127);
#pragma unroll
              for (int i = 0; i < 8; ++i) d[i * SD_RS] = (bf16)f2bf(v[i]); } } }
    __syncthreads();
    const int hh = wave >> 1, half = wave & 1, hd = 4 * grp + hh;
    bf16x8_t mf[4][2];
    { const float Dk = a.in[I_SD][l * 8 + hd];
      float acl[4], acsv[16], dts[16];
#pragma unroll
      for (int j = 0; j < 4; ++j) acl[j] = acs[(16 * j + fr) * 4 + hh];
#pragma unroll
      for (int i = 0; i < 4; ++i)
#pragma unroll
          for (int r = 0; r < 4; ++r) { acsv[4 * i + r] = acs[(16 * i + 4 * g + r) * 4 + hh]; dts[4 * i + r] = dtl[(16 * i + 4 * g + r) * 4 + hh]; }
#pragma unroll
      for (int j = 0; j < 4; ++j) { unsigned pw[4][2];
#pragma unroll
          for (int i = 0; i < 4; ++i) { pw[i][0] = 0u; pw[i][1] = 0u;
              if (i <= j) { pg8::f32x4 acc = {0.f, 0.f, 0.f, 0.f};
#pragma unroll
                  for (int ks = 0; ks < 4; ++ks) { const bf16x8_t af = *(const LAS bf16x8_t*)(Brm + (16 * i + fr) * SD_RS + 8 * g + 32 * ks), bfr = *(const LAS bf16x8_t*)(Crm + (16 * j + fr) * SD_RS + 8 * g + 32 * ks);
                      acc = __builtin_amdgcn_mfma_f32_16x16x32_bf16(af, bfr, acc, 0, 0, 0); }
                  float m[4];
#pragma unroll
                  for (int r = 0; r < 4; ++r) { const int s = 16 * i + 4 * g + r, ll = 16 * j + fr; float v = acc[r] * __expf(fminf(acl[j] - acsv[4 * i + r], 0.f)) * dts[4 * i + r]; if (s > ll) v = 0.f; if (s == ll) v += Dk; m[r] = v; }
                  pw[i][0] = pkbf(m[0], m[1]); pw[i][1] = pkbf(m[2], m[3]); } }
          mf[j][0] = __builtin_bit_cast(bf16x8_t, (v4u){pw[0][0], pw[0][1], pw[1][0], pw[1][1]}); mf[j][1] = __builtin_bit_cast(bf16x8_t, (v4u){pw[2][0], pw[2][1], pw[3][0], pw[3][1]}); } }
    pg8::f32x4 yv[2][4];
    { const bf16* pv = PREV + ((size_t)(b * 256 + chunk) * 8 + hd) * 8192;
#pragma unroll
      for (int pt = 0; pt < 2; ++pt) { const int prow = 16 * (2 * half + pt) + fr;
          bf16x8_t pf[4];
#pragma unroll
          for (int ks = 0; ks < 4; ++ks) pf[ks] = *(const bf16x8_t*)(pv + prow * 128 + 8 * g + 32 * ks);
          bf16x8_t xf[2];
#pragma unroll
          for (int ks = 0; ks < 2; ++ks) { const v2u lo = *(const LAS v2u*)(XT + (hh * 64 + prow) * SD_TS + 32 * ks + 4 * g), hi = *(const LAS v2u*)(XT + (hh * 64 + prow) * SD_TS + 32 * ks + 16 + 4 * g);
              xf[ks] = __builtin_bit_cast(bf16x8_t, (v4u){lo.x, lo.y, hi.x, hi.y}); }
#pragma unroll
          for (int j = 0; j < 4; ++j) { pg8::f32x4 off = {0.f, 0.f, 0.f, 0.f};
#pragma unroll
              for (int ks = 0; ks < 4; ++ks) { const bf16x8_t bfr = *(const LAS bf16x8_t*)(Crm + (16 * j + fr) * SD_RS + 8 * g + 32 * ks); off = __builtin_amdgcn_mfma_f32_16x16x32_bf16(pf[ks], bfr, off, 0, 0, 0); }
              const float el = __expf(acs[(16 * j + fr) * 4 + hh]);
              pg8::f32x4 acc = off * el;
              acc = __builtin_amdgcn_mfma_f32_16x16x32_bf16(xf[0], mf[j][0], acc, 0, 0, 0);
              if (j >= 2) acc = __builtin_amdgcn_mfma_f32_16x16x32_bf16(xf[1], mf[j][1], acc, 0, 0, 0);
              yv[pt][j] = acc; } } }
    const int cbase = grp * 256 + hh * 64;
#pragma unroll
    for (int j = 0; j < 4; ++j) { const int ll = 16 * j + fr; float s = 0.f;
#pragma unroll
        for (int pt = 0; pt < 2; ++pt) { const v2u zr = zrv[pt][j];
            yv[pt][j][0] *= siluf_(bflo(zr.x)); yv[pt][j][1] *= siluf_(bfhi(zr.x)); yv[pt][j][2] *= siluf_(bflo(zr.y)); yv[pt][j][3] *= siluf_(bfhi(zr.y));
            s += (yv[pt][j][0] * yv[pt][j][0] + yv[pt][j][1] * yv[pt][j][1]) + (yv[pt][j][2] * yv[pt][j][2] + yv[pt][j][3] * yv[pt][j][3]); }
        s += __shfl_xor(s, 16); s += __shfl_xor(s, 32); if (g == 0) ssq[wave * 64 + ll] = s; }
    __syncthreads();
#pragma unroll
    for (int j = 0; j < 4; ++j) { const int ll = 16 * j + fr; float s = 0.f;
#pragma unroll
        for (int w = 0; w < 8; ++w) s += ssq[w * 64 + ll];
        const float r = 1.0f / sqrtf(s * (1.0f / 256.0f) + NORM_EPS);
#pragma unroll
        for (int pt = 0; pt < 2; ++pt) { const int cc = cbase + 16 * (2 * half + pt) + 4 * g; const float* nw = a.in[I_SNORM] + l * 512 + cc;
            *(v2u*)(Y + (row0 + ll) * DM + 1024 + cc) = (v2u){pkbf(yv[pt][j][0] * r * nw[0], yv[pt][j][1] * r * nw[1]), pkbf(yv[pt][j][2] * r * nw[2], yv[pt][j][3] * r * nw[3])}; } }
    __syncthreads();
}
constexpr int LR_RS = 520;
struct LruW { bf16x8_t wa[4][2], wx[4][2]; };
__device__ __forceinline__ void lru_load_w(const Args& a, int l, int wave, int lane, LruW& W) {
    const int fr = lane & 15, g = lane >> 4; const float* wa = a.in[I_LWA] + ((size_t)l * 8 + wave) * 4096; const float* wx = a.in[I_LWX] + ((size_t)l * 8 + wave) * 4096;
#pragma unroll
    for (int nt = 0; nt < 4; ++nt)
#pragma unroll
        for (int ks = 0; ks < 2; ++ks) { unsigned pa[4], px[4];
#pragma unroll
            for (int e = 0; e < 4; ++e) { const int i0 = 32 * ks + 8 * g + 2 * e, j = 16 * nt + fr; pa[e] = pkbf(wa[i0 * 64 + j], wa[(i0 + 1) * 64 + j]); px[e] = pkbf(wx[i0 * 64 + j], wx[(i0 + 1) * 64 + j]); }
            W.wa[nt][ks] = __builtin_bit_cast(bf16x8_t, (v4u){pa[0], pa[1], pa[2], pa[3]}); W.wx[nt][ks] = __builtin_bit_cast(bf16x8_t, (v4u){px[0], px[1], px[2], px[3]}); }
}
template <bool FINAL> __device__ __forceinline__ void lru_unit(const Args& a, unsigned char* ws, int l, int unit, const LruW& W, LAS unsigned char* lds, int tid_in) {
    int tid = tid_in; asm volatile("" : "+v"(tid));
    const bf16* proj = (const bf16*)(ws + WS_HP); float* LRA = (float*)(ws + WS_LRA); float* LRH = (float*)(ws + WS_LRH); const float* LRC = (const float*)(ws + WS_LRC); bf16* Y = (bf16*)(ws + WS_Y);
    const int chunk = unit & 255, b = unit >> 8, lane = tid & 63, wave = tid >> 6, fr = lane & 15, g = lane >> 4;
    const size_t row0 = (size_t)b * SEQ + (size_t)chunk * 64;
    LAS bf16* Xrm = (LAS bf16*)lds; LAS bf16* Hrm = Xrm + 64 * LR_RS; LAS float* ssq = (LAS float*)(lds + 2 * 64 * LR_RS * 2); LAS float* rst = ssq + 512;
    { const int c = tid; const float* cwp = a.in[I_LCW] + (size_t)l * 4 * 512; const float cw0 = cwp[c], cw1 = cwp[512 + c], cw2 = cwp[1024 + c], cw3 = cwp[1536 + c], cb = a.in[I_LCB][l * 512 + c];
      const bf16* xp = proj + row0 * NPROJ + PC_DX + c;
      float xm3 = 0.f, xm2 = 0.f, xm1 = 0.f; if (chunk > 0) { xm3 = bf2f(xp[-3 * (ptrdiff_t)NPROJ]); xm2 = bf2f(xp[-2 * (ptrdiff_t)NPROJ]); xm1 = bf2f(xp[-(ptrdiff_t)NPROJ]); }
      bf16 xr[64];
#pragma unroll
      for (int t = 0; t < 64; ++t) xr[t] = xp[(ptrdiff_t)t * NPROJ];
#pragma unroll
      for (int t = 0; t < 64; ++t) { const float xn = bf2f(xr[t]); const float y = cb + cw0 * xm3 + cw1 * xm2 + cw2 * xm1 + cw3 * xn; xm3 = xm2; xm2 = xm1; xm1 = xn; Xrm[t * LR_RS + c] = (bf16)f2bf(y); } }
    __syncthreads();
    float ssp[4][4];
#pragma unroll
    for (int mt = 0; mt < 4; ++mt)
#pragma unroll
        for (int r = 0; r < 4; ++r) ssp[mt][r] = 0.f;
#pragma unroll
    for (int nt = 0; nt < 4; ++nt) {
        const int c = wave * 64 + 16 * nt + fr;
        const float ba = a.in[I_LBA][l * 512 + c], bx = a.in[I_LBX][l * 512 + c], spn = softplusf_(-a.in[I_LAP][l * 512 + c]);
        float av[4][4], bv[4][4]; const float carry0 = FINAL ? LRC[((size_t)b * 256 + chunk) * 512 + c] : 0.f;
#pragma unroll
        for (int mt = 0; mt < 4; ++mt) { pg8::f32x4 ra = {0.f, 0.f, 0.f, 0.f}, ri = {0.f, 0.f, 0.f, 0.f};
#pragma unroll
            for (int ks = 0; ks < 2; ++ks) { const bf16x8_t af = *(const LAS bf16x8_t*)(Xrm + (16 * mt + fr) * LR_RS + wave * 64 + 32 * ks + 8 * g);
                ra = __builtin_amdgcn_mfma_f32_16x16x32_bf16(af, W.wa[nt][ks], ra, 0, 0, 0); ri = __builtin_amdgcn_mfma_f32_16x16x32_bf16(af, W.wx[nt][ks], ri, 0, 0, 0); }
#pragma unroll
            for (int r = 0; r < 4; ++r) { const float rg = sigmoidf_(ra[r] + ba), ig = sigmoidf_(ri[r] + bx), la = -8.0f * rg * spn, xc = bf2f(Xrm[(16 * mt + 4 * g + r) * LR_RS + c]);
                const float x2 = 2.0f * la, em = (x2 > -0.25f) ? -x2 * (1.0f + x2 * (0.5f + x2 * (0.16666667f + x2 * (0.041666668f + x2 * 0.0083333338f)))) : 1.0f - __expf(x2);
                av[mt][r] = __expf(la); bv[mt][r] = __builtin_amdgcn_sqrtf(fmaxf(em, 0.f)) * (ig * xc); } }
        float carry = carry0, atot = 1.f;
#pragma unroll
        for (int mt = 0; mt < 4; ++mt) {
            float As = av[mt][0], Hs = bv[mt][0];
#pragma unroll
            for (int r = 1; r < 4; ++r) { Hs = av[mt][r] * Hs + bv[mt][r]; As *= av[mt][r]; }
            float Ai = As, Hi = Hs;
            { const float Ap = __shfl_up(Ai, 16), Hp = __shfl_up(Hi, 16); if (g >= 1) { Hi = Ai * Hp + Hi; Ai = Ai * Ap; } }
            { const float Ap = __shfl_up(Ai, 32), Hp = __shfl_up(Hi, 32); if (g >= 2) { Hi = Ai * Hp + Hi; Ai = Ai * Ap; } }
            float Ae = __shfl_up(Ai, 16), He = __shfl_up(Hi, 16); if (g == 0) { Ae = 1.f; He = 0.f; }
            const float At = __shfl(Ai, fr + 48), Ht = __shfl(Hi, fr + 48);
            if (FINAL) { float hc = Ae * carry + He;
#pragma unroll
                for (int r = 0; r < 4; ++r) { hc = av[mt][r] * hc + bv[mt][r]; const float gt = bf2f(proj[(row0 + 16 * mt + 4 * g + r) * NPROJ + PC_DG + c]); const float u2 = 1.5957691216057308f * (gt + 0.044715f * gt * gt * gt); const float o = hc * gt * sigmoidf_(u2);
                    Hrm[(16 * mt + 4 * g + r) * LR_RS + c] = (bf16)f2bf(o); ssp[mt][r] += o * o; } }
            carry = At * carry + Ht; atot *= At;
        }
        if (!FINAL && g == 0) { LRA[((size_t)b * 256 + chunk) * 512 + c] = atot; LRH[((size_t)b * 256 + chunk) * 512 + c] = carry; }
        asm volatile("" ::: "memory");
    }
    if (FINAL) {
#pragma unroll
        for (int mt = 0; mt < 4; ++mt)
#pragma unroll
            for (int r = 0; r < 4; ++r) { float s = ssp[mt][r]; s += __shfl_xor(s, 1); s += __shfl_xor(s, 2); s += __shfl_xor(s, 4); s += __shfl_xor(s, 8); if (fr == 0) ssq[wave * 64 + 16 * mt + 4 * g + r] = s; }
        __syncthreads();
        if (tid < 64) { float s = 0.f;
#pragma unroll
            for (int w = 0; w < 8; ++w) s += ssq[w * 64 + tid];
            rst[tid] = 1.0f / sqrtf(s * (1.0f / 512.0f) + NORM_EPS); }
        __syncthreads();
        { const float* nw = a.in[I_LNORM] + l * 512;
#pragma unroll
          for (int i = 0; i < 8; ++i) { const int item = tid + NTHR * i, t = item >> 6, cg = (item & 63) * 8; const float rs = rst[t]; const v4u hv = *(const LAS v4u*)(Hrm + t * LR_RS + cg);
              const f32x4 w0 = *(const f32x4*)(nw + cg), w1 = *(const f32x4*)(nw + cg + 4);
              v4u o; o.x = pkbf(bflo(hv.x) * rs * w0.x, bfhi(hv.x) * rs * w0.y); o.y = pkbf(bflo(hv.y) * rs * w0.z, bfhi(hv.y) * rs * w0.w); o.z = pkbf(bflo(hv.z) * rs * w1.x, bfhi(hv.z) * rs * w1.y); o.w = pkbf(bflo(hv.w) * rs * w1.z, bfhi(hv.w) * rs * w1.w);
              *(v4u*)(Y + (row0 + t) * DM + 1536 + cg) = o; } }
    }
    __syncthreads();
}
__device__ __forceinline__ void lru_p2_item(unsigned char* ws, int item, int tid) {
    const float* LRA = (const float*)(ws + WS_LRA); const float* LRH = (const float*)(ws + WS_LRH); float* LRC = (float*)(ws + WS_LRC);
    const int idx = item * NTHR + tid, b = idx >> 9, c = idx & 511; const size_t base = (size_t)b * 256 * 512 + c;
    float hh = 0.f; constexpr int U = 16;
    float ra[U], rb[U];
#pragma unroll
    for (int i = 0; i < U; ++i) { ra[i] = LRA[base + (size_t)i * 512]; rb[i] = LRH[base + (size_t)i * 512]; }
    for (int k0 = 0; k0 < 256; k0 += U) {
        float ca[U], cbv[U];
#pragma unroll
        for (int i = 0; i < U; ++i) { ca[i] = ra[i]; cbv[i] = rb[i]; }
        if (k0 + U < 256) {
#pragma unroll
            for (int i = 0; i < U; ++i) { ra[i] = LRA[base + (size_t)(k0 + U + i) * 512]; rb[i] = LRH[base + (size_t)(k0 + U + i) * 512]; } }
#pragma unroll
        for (int i = 0; i < U; ++i) { LRC[base + (size_t)(k0 + i) * 512] = hh; hh = ca[i] * hh + cbv[i]; }
    }
}
typedef short v4i16_t __attribute__((ext_vector_type(4)));
constexpr float AT_DEFER = 8.0f;
constexpr int AT_VS = 72;
template <int KIND> struct AtCfg;
template <> struct AtCfg<0> { static constexpr int NSTEP = 5; };
template <> struct AtCfg<1> { static constexpr int NSTEP = 6 + 5; };
template <int KIND> __device__ __forceinline__ void at_pat(int gs, int& dsh, int& qsh, int& kk0) {
    if (KIND == 0) { dsh = 0; qsh = 0; kk0 = 32 * gs; }
    else { const bool p2 = gs >= 6; dsh = p2 ? 4 : 2; qsh = p2 ? 0 : 2; kk0 = 32 * (p2 ? gs - 6 : gs); }
}
struct AtLoad { bf16x8_t kf[2][2]; v4u vr[4]; };
template <int KIND> __device__ __forceinline__ void at_issue(AtLoad& L, const bf16* proj, size_t rowb, int tb0, int head, int gs, int lane) {
    const int fr = lane & 15, g = lane >> 4; int dsh, qsh, kk0; at_pat<KIND>(gs, dsh, qsh, kk0);
    const char* pb = (const char*)proj; const unsigned rb = (unsigned)rowb;
#pragma unroll
    for (int t2 = 0; t2 < 2; ++t2) { int pos = tb0 + (kk0 + 16 * t2 + fr - 128) * (1 << dsh); pos = max(0, min(pos, SEQ - 1)); const unsigned off = (rb + (unsigned)pos) * (unsigned)(NPROJ * 2) + (unsigned)((PC_BK + head * 64 + 8 * g) * 2);
#pragma unroll
        for (int ks = 0; ks < 2; ++ks) L.kf[t2][ks] = *(const bf16x8_t*)(pb + off + 64 * ks); }
#pragma unroll
    for (int i = 0; i < 4; ++i) { int pos = tb0 + (kk0 + 8 * i + (lane >> 3) - 128) * (1 << dsh); pos = max(0, min(pos, SEQ - 1));
        L.vr[i] = *(const v4u*)(pb + (rb + (unsigned)pos) * (unsigned)(NPROJ * 2) + (unsigned)((PC_BV + head * 64 + 8 * (lane & 7)) * 2)); }
}
template <int KIND> struct AtHead { v4u q[2]; v2u pao[4]; f32x2_t ml; };
template <int KIND> __device__ __forceinline__ void at_unit_pos(int unit, size_t& rowb, int& tb0) { rowb = (size_t)(unit >> 10) * SEQ; tb0 = (KIND == 0) ? 16 * (unit & 1023) : ((unit >> 4) & 63) * 256 + (unit & 15); }
template <int KIND> __device__ __forceinline__ void at_head_load(AtHead<KIND>& H, unsigned char* ws, size_t rowb, int tb0, int head, int lane) {
    const bf16* proj = (const bf16*)(ws + WS_HP); const int fr = lane & 15, g = lane >> 4; const size_t qrow = rowb + tb0 + ((KIND == 0) ? fr : 16 * fr);
    const bf16* qp = proj + qrow * NPROJ + PC_BQ + head * 64 + 8 * g; H.q[0] = *(const v4u*)qp; H.q[1] = *(const v4u*)(qp + 32);
    if (KIND == 1) { const bf16* PAO = (const bf16*)(ws + WS_PAO); const float* PAM = (const float*)(ws + WS_PAM);
#pragma unroll
        for (int dt = 0; dt < 4; ++dt) H.pao[dt] = *(const v2u*)(PAO + qrow * 512 + head * 64 + 16 * dt + 4 * g);
        H.ml = *(const f32x2_t*)(PAM + (qrow * 8 + head) * 2); }
}
template <int KIND> __device__ __forceinline__ void attn_pass(const Args& a, unsigned char* ws, int l, int vcu, int G, LAS unsigned char* lds, int tid) {
    constexpr int NSTEP = AtCfg<KIND>::NSTEP, NUNIT = 2048; static_assert(NSTEP % 3 == 2, "loop shape");
    const bf16* proj = (const bf16*)(ws + WS_HP); bf16* Y = (bf16*)(ws + WS_Y); bf16* PAO = (bf16*)(ws + WS_PAO); float* PAM = (float*)(ws + WS_PAM);
    const int lane = tid & 63, head = tid >> 6, fr = lane & 15, g = lane >> 4;
    LAS bf16* Vb = (LAS bf16*)(lds + head * (32 * AT_VS * 2)); LAS float* ssq = (LAS float*)(lds + 8 * 32 * AT_VS * 2);
    int unit = vcu; if (unit >= NUNIT) return;
    size_t rowb; int tb0; at_unit_pos<KIND>(unit, rowb, tb0);
    AtHead<KIND> H; at_head_load<KIND>(H, ws, rowb, tb0, head, lane);
    AtLoad c0, c1, c2; at_issue<KIND>(c0, proj, rowb, tb0, head, 0, lane); at_issue<KIND>(c1, proj, rowb, tb0, head, 1, lane); c2 = c0;
#pragma unroll 1
    for (;;) {
        const int nunit = unit + G; const bool has_next = nunit < NUNIT; size_t rowb_n = rowb; int tb0_n = tb0; if (has_next) at_unit_pos<KIND>(nunit, rowb_n, tb0_n);
        const size_t qrow = rowb + tb0 + ((KIND == 0) ? fr : 16 * fr);
        bf16x8_t qf[2]; constexpr float QS = 0.125f * 1.4426950408889634f;
#pragma unroll
        for (int ks = 0; ks < 2; ++ks) { const v4u u = H.q[ks];
            qf[ks] = __builtin_bit_cast(bf16x8_t, (v4u){pkbf(bflo(u.x) * QS, bfhi(u.x) * QS), pkbf(bflo(u.y) * QS, bfhi(u.y) * QS), pkbf(bflo(u.z) * QS, bfhi(u.z) * QS), pkbf(bflo(u.w) * QS, bfhi(u.w) * QS)}); }
        v2u pao[4]; float pam = 0.f, pal = 0.f;
        if (KIND == 1) {
#pragma unroll
            for (int dt = 0; dt < 4; ++dt) pao[dt] = H.pao[dt];
            pam = H.ml.x; pal = H.ml.y; }
        pg8::f32x4 o[4];
#pragma unroll
        for (int dt = 0; dt < 4; ++dt) o[dt] = (pg8::f32x4){0.f, 0.f, 0.f, 0.f};
        float mrun = -1e30f, lsum = 0.f;
#define AT_STEP(gs, CUR_, TGT_) do { if ((gs) + 2 < NSTEP) at_issue<KIND>(TGT_, proj, rowb, tb0, head, (gs) + 2, lane); else if (has_next) at_issue<KIND>(TGT_, proj, rowb_n, tb0_n, head, (gs) + 2 - NSTEP, lane); \
        int dsh, qsh, kk0; at_pat<KIND>(gs, dsh, qsh, kk0); \
        const int qlo = fr << qsh, klo = max(qlo, 128 - (tb0 >> dsh)); const unsigned kspan = (unsigned)(qlo + 128 - klo); \
        _Pragma("unroll") \
        for (int i = 0; i < 4; ++i) *(LAS v4u*)(Vb + (8 * i + (lane >> 3)) * AT_VS + 8 * (lane & 7)) = CUR_.vr[i]; \
        pg8::f32x4 st[2]; \
        _Pragma("unroll") \
        for (int t2 = 0; t2 < 2; ++t2) { pg8::f32x4 acc = {0.f, 0.f, 0.f, 0.f}; acc = __builtin_amdgcn_mfma_f32_16x16x32_bf16(CUR_.kf[t2][0], qf[0], acc, 0, 0, 0); acc = __builtin_amdgcn_mfma_f32_16x16x32_bf16(CUR_.kf[t2][1], qf[1], acc, 0, 0, 0); st[t2] = acc; } \
        bool val[2][4]; float mx = -1e30f; \
        _Pragma("unroll") \
        for (int t2 = 0; t2 < 2; ++t2) \
        _Pragma("unroll") \
            for (int r = 0; r < 4; ++r) { const int kk = kk0 + 16 * t2 + 4 * g + r; val[t2][r] = (unsigned)(kk - klo) <= kspan; if (val[t2][r]) mx = fmaxf(mx, st[t2][r]); } \
        if (__builtin_amdgcn_ballot_w64(mx > mrun + AT_DEFER) != 0ull) {       \
            mx = fmaxf(mx, __shfl_xor(mx, 16)); mx = fmaxf(mx, __shfl_xor(mx, 32)); \
            const float mn_ = fmaxf(mrun, mx), corr = __builtin_amdgcn_exp2f(mrun - mn_); mrun = mn_; lsum *= corr; \
            _Pragma("unroll") \
            for (int dt = 0; dt < 4; ++dt) o[dt] = o[dt] * corr; } \
        const float mn = mrun; \
        float p[2][4], ps = 0.f; \
        _Pragma("unroll") \
        for (int t2 = 0; t2 < 2; ++t2) \
        _Pragma("unroll") \
            for (int r = 0; r < 4; ++r) { p[t2][r] = val[t2][r] ? __builtin_amdgcn_exp2f(st[t2][r] - mn) : 0.f; ps += p[t2][r]; } \
        lsum += ps; \
        const bf16x8_t pf = __builtin_bit_cast(bf16x8_t, (v4u){pkbf(p[0][0], p[0][1]), pkbf(p[0][2], p[0][3]), pkbf(p[1][0], p[1][1]), pkbf(p[1][2], p[1][3])}); \
        { const int qq = fr >> 2, pp = fr & 3; \
        _Pragma("unroll") \
          for (int dt = 0; dt < 4; ++dt) { const v4i16_t lo = __builtin_amdgcn_ds_read_tr16_b64_v4i16((LAS v4i16_t*)(Vb + (4 * g + qq) * AT_VS + 16 * dt + 4 * pp)), hi = __builtin_amdgcn_ds_read_tr16_b64_v4i16((LAS v4i16_t*)(Vb + (16 + 4 * g + qq) * AT_VS + 16 * dt + 4 * pp)); \
              const bf16x8_t vf = {lo[0], lo[1], lo[2], lo[3], hi[0], hi[1], hi[2], hi[3]}; \
              o[dt] = __builtin_amdgcn_mfma_f32_16x16x32_bf16(vf, pf, o[dt], 0, 0, 0); } } \
    } while (0)
#pragma unroll 1
        for (int gs = 0; gs + 2 < NSTEP; gs += 3) { AT_STEP((gs), c0, c2); AT_STEP((gs + 1), c1, c0); AT_STEP((gs + 2), c2, c1); }
        if (has_next) at_head_load<KIND>(H, ws, rowb_n, tb0_n, head, lane);
        AT_STEP((NSTEP - 2), c0, c2); AT_STEP((NSTEP - 1), c1, c0);
#undef AT_STEP
        lsum += __shfl_xor(lsum, 16); lsum += __shfl_xor(lsum, 32);
        if (KIND == 0) {
#pragma unroll
            for (int dt = 0; dt < 4; ++dt) *(v2u*)(PAO + qrow * 512 + head * 64 + 16 * dt + 4 * g) = (v2u){pkbf(o[dt][0], o[dt][1]), pkbf(o[dt][2], o[dt][3])};
            if (g == 0) *(f32x2_t*)(PAM + (qrow * 8 + head) * 2) = (f32x2_t){mrun, lsum};
        } else {
            const float mm = fmaxf(mrun, pam), fa = __builtin_amdgcn_exp2f(pam - mm), fb = __builtin_amdgcn_exp2f(mrun - mm), inv = 1.0f / (pal * fa + lsum * fb); float ss = 0.f;
#pragma unroll
            for (int dt = 0; dt < 4; ++dt) { const pg8::f32x4 oa = {bflo(pao[dt].x), bfhi(pao[dt].x), bflo(pao[dt].y), bfhi(pao[dt].y)}; o[dt] = (oa * fa + o[dt] * fb) * inv;
                ss += (o[dt][0] * o[dt][0] + o[dt][1] * o[dt][1]) + (o[dt][2] * o[dt][2] + o[dt][3] * o[dt][3]); }
            ss += __shfl_xor(ss, 16); ss += __shfl_xor(ss, 32);
            __syncthreads();
            if (g == 0) ssq[head * 16 + fr] = ss;
            __syncthreads();
            { float s = 0.f;
#pragma unroll
              for (int w = 0; w < 8; ++w) s += ssq[w * 16 + fr];
              const float rs = 1.0f / sqrtf(s * (1.0f / 512.0f) + NORM_EPS); const float* nw = a.in[I_ATN] + l * 512 + head * 64;
#pragma unroll
              for (int dt = 0; dt < 4; ++dt) { const int dd = 16 * dt + 4 * g;
                  *(v2u*)(Y + qrow * DM + 512 + head * 64 + dd) = (v2u){pkbf(o[dt][0] * rs * nw[dd], o[dt][1] * rs * nw[dd + 1]), pkbf(o[dt][2] * rs * nw[dd + 2], o[dt][3] * rs * nw[dd + 3])}; } }
        }
        if (!has_next) break;
        { const AtLoad t = c0; c0 = c2; c1 = t; }
        unit = nunit; rowb = rowb_n; tb0 = tb0_n;
    }
    __syncthreads();
}
__device__ __forceinline__ void m2_hgrn(const Args& a, unsigned char* ws, int l, int w, LAS unsigned char* lds, int tid) {
    const bf16* proj = (const bf16*)(ws + WS_HP); float* OA = (float*)(ws + WS_OA);
    const int b = w >> 2, h = w & 3, v = tid >> 2, kq = tid & 3;
    constexpr int TB = 16, RS = 144;
    LAS float* fs = (LAS float*)lds; LAS float* ks = fs + TB * RS; LAS float* qs = ks + TB * RS; LAS float* vs = qs + TB * RS;
    const int kl = tid & 127, ch = h * 128 + kl;
    float lb = 0.f;
    { const float* lg = a.in[I_LBL]; float mx = lg[ch]; for (int i = 1; i < DEPTH; ++i) mx = fmaxf(mx, lg[i * 512 + ch]); float den = 0.f, num = 0.f;
      for (int i = 0; i < DEPTH; ++i) { const float e = __expf(lg[i * 512 + ch] - mx); den += e; if (i >= 1 && i <= l) num += e; } lb = num / den; }
    float S[32];
#pragma unroll
    for (int j = 0; j < 32; ++j) S[j] = 0.f;
    const size_t rowb = (size_t)b * SEQ;
    bf16 rq[4], rf[4], ri[4];
#define HG_LDBATCH(t0_) do { _Pragma("unroll") for (int i = 0; i < 4; ++i) { const int s_ = (tid >> 7) + 4 * i; const bf16* p_ = proj + (rowb + (t0_) + s_) * NPROJ + ch; rq[i] = p_[PC_AQ]; rf[i] = p_[PC_AF]; ri[i] = p_[PC_AI]; } } while (0)
    HG_LDBATCH(0);
    for (int t0 = 0; t0 < SEQ; t0 += TB) {
#pragma unroll
        for (int i = 0; i < 4; ++i) { const int s = (tid >> 7) + 4 * i; const int kp = kl + 4 * (kl >> 5);
            const float sg = sigmoidf_(bf2f(rf[i])); fs[s * RS + kp] = lb + (1.0f - lb) * sg; ks[s * RS + kp] = (1.0f - lb) * (1.0f - sg); qs[s * RS + kp] = siluf_(bf2f(rq[i])); vs[s * 128 + kl] = bf2f(ri[i]); }
        __syncthreads();
        if (t0 + TB < SEQ) HG_LDBATCH(t0 + TB);
        for (int s = 0; s < TB; ++s) {
            const float vv = vs[s * 128 + v]; float part = 0.f; const int kb = 36 * kq;
#pragma unroll
            for (int j4 = 0; j4 < 8; ++j4) { const f32x4 f4 = *(const LAS f32x4*)(fs + s * RS + kb + 4 * j4), k4 = *(const LAS f32x4*)(ks + s * RS + kb + 4 * j4), q4 = *(const LAS f32x4*)(qs + s * RS + kb + 4 * j4);
#pragma unroll
                for (int jj = 0; jj < 4; ++jj) { const int j = 4 * j4 + jj; S[j] = f4[jj] * S[j] + k4[jj] * vv; part += S[j] * q4[jj]; } }
            part += __shfl_xor(part, 1); part += __shfl_xor(part, 2);
            if (kq == 0) OA[(rowb + t0 + s) * 512 + h * 128 + v] = part;
        }
        __syncthreads();
    }
}
__device__ __forceinline__ void m2_ssd(const Args& a, unsigned char* ws, int l, int w, LAS unsigned char* lds, int tid) {
    const float* xbcc = (const float*)(ws + WS_XBCC); const float* dtv = (const float*)(ws + WS_DTV); float* OC = (float*)(ws + WS_OC);
    const int b = w >> 3, h = w & 7, g = h >> 2, p = tid >> 3, ns = tid & 7;
    constexpr int TB = 16, RS = 160;
    LAS float* Bs = (LAS float*)lds; LAS float* Cs = Bs + TB * RS; LAS float* xs = Cs + TB * RS; LAS float* dts = xs + TB * 64;
    const float Aneg = -__expf(a.in[I_SALOG][l * 8 + h]), Dk = a.in[I_SD][l * 8 + h];
    float hs[16];
#pragma unroll
    for (int j = 0; j < 16; ++j) hs[j] = 0.f;
    const size_t rowb = (size_t)b * SEQ;
    float rB[4], rC[4], rx[2], rdt = 0.f;
    const int nl = tid & 127, pl = tid & 63;
#define SSD_LDBATCH(t0_) do { _Pragma("unroll") for (int i = 0; i < 4; ++i) { const int s_ = (tid >> 7) + 4 * i; const float* q_ = xbcc + (rowb + (t0_) + s_) * 1024; rB[i] = q_[512 + g * 128 + nl]; rC[i] = q_[768 + g * 128 + nl]; } \
        _Pragma("unroll") for (int i = 0; i < 2; ++i) { const int s_ = (tid >> 6) + 8 * i; rx[i] = xbcc[(rowb + (t0_) + s_) * 1024 + h * 64 + pl]; } \
        if (tid < TB) rdt = dtv[(rowb + (t0_) + tid) * 8 + h]; } while (0)
    SSD_LDBATCH(0);
    for (int t0 = 0; t0 < SEQ; t0 += TB) {
#pragma unroll
        for (int i = 0; i < 4; ++i) { const int s = (tid >> 7) + 4 * i; const int np = nl + 4 * (nl >> 4); Bs[s * RS + np] = rB[i]; Cs[s * RS + np] = rC[i]; }
#pragma unroll
        for (int i = 0; i < 2; ++i) { const int s = (tid >> 6) + 8 * i; xs[s * 64 + pl] = rx[i]; }
        if (tid < TB) dts[tid] = rdt;
        __syncthreads();
        if (t0 + TB < SEQ) SSD_LDBATCH(t0 + TB);
        for (int s = 0; s < TB; ++s) {
            const float dt = dts[s], dA = __expf(dt * Aneg), xv = xs[s * 64 + p], xdt = xv * dt; float part = 0.f; const int nb = 20 * ns;
#pragma unroll
            for (int j4 = 0; j4 < 4; ++j4) { const f32x4 b4 = *(const LAS f32x4*)(Bs + s * RS + nb + 4 * j4), c4 = *(const LAS f32x4*)(Cs + s * RS + nb + 4 * j4);
#pragma unroll
                for (int jj = 0; jj < 4; ++jj) { const int j = 4 * j4 + jj; hs[j] = dA * hs[j] + b4[jj] * xdt; part += c4[jj] * hs[j]; } }
            part += __shfl_xor(part, 1); part += __shfl_xor(part, 2); part += __shfl_xor(part, 4);
            if (ns == 0) OC[(rowb + t0 + s) * 512 + h * 64 + p] = part + Dk * xv;
        }
        __syncthreads();
    }
}
__device__ __forceinline__ void m2_lru(const Args& a, unsigned char* ws, int w, int tid) {
    const float* LA = (const float*)(ws + WS_LA); const float* LB = (const float*)(ws + WS_LB); float* OD = (float*)(ws + WS_OD);
    const int idx = w * NTHR + tid, b = idx >> 9, c = idx & 511; const size_t base = (size_t)b * SEQ * 512 + c;
    float hh = 0.f; constexpr int U = 16;
    float ra[U], rb[U];
#pragma unroll
    for (int i = 0; i < U; ++i) { ra[i] = LA[base + (size_t)i * 512]; rb[i] = LB[base + (size_t)i * 512]; }
    for (int t0 = 0; t0 < SEQ; t0 += U) {
        float ca[U], cbv[U];
#pragma unroll
        for (int i = 0; i < U; ++i) { ca[i] = ra[i]; cbv[i] = rb[i]; }
        if (t0 + U < SEQ) {
#pragma unroll
            for (int i = 0; i < U; ++i) { ra[i] = LA[base + (size_t)(t0 + U + i) * 512]; rb[i] = LB[base + (size_t)(t0 + U + i) * 512]; } }
#pragma unroll
        for (int i = 0; i < U; ++i) { hh = ca[i] * hh + cbv[i]; OD[base + (size_t)(t0 + i) * 512] = hh; }
    }
}
__device__ __forceinline__ void m2_attn(const Args& a, unsigned char* ws, int item, int tid) {
    const bf16* proj = (const bf16*)(ws + WS_HP); float* OB = (float*)(ws + WS_OB);
    const int head = item & 7, blk = item >> 3, t = blk * NTHR + tid, tb = t & (SEQ - 1); const size_t rowb = (size_t)(t - tb);
    float q[64], acc[64];
    { const v4u* qp = (const v4u*)(proj + (size_t)t * NPROJ + PC_BQ + head * 64);
#pragma unroll
      for (int i = 0; i < 8; ++i) { const v4u u = qp[i]; q[8 * i + 0] = bflo(u.x) * 0.125f; q[8 * i + 1] = bfhi(u.x) * 0.125f; q[8 * i + 2] = bflo(u.y) * 0.125f; q[8 * i + 3] = bfhi(u.y) * 0.125f;
          q[8 * i + 4] = bflo(u.z) * 0.125f; q[8 * i + 5] = bfhi(u.z) * 0.125f; q[8 * i + 6] = bflo(u.w) * 0.125f; q[8 * i + 7] = bfhi(u.w) * 0.125f; } }
#pragma unroll
    for (int d = 0; d < 64; ++d) acc[d] = 0.f;
    float mrun = -1e30f, lrun = 0.f;
    for (int pat = 0; pat < 3; ++pat) { const int dil = (pat == 0) ? 1 : (pat == 1) ? 4 : 16;
        for (int j = 0; j <= 128; ++j) { const int pos = tb - j * dil;
            if (pos >= 0) {
                const v4u* kp = (const v4u*)(proj + (rowb + pos) * NPROJ + PC_BK + head * 64); const v4u* vp = (const v4u*)(proj + (rowb + pos) * NPROJ + PC_BV + head * 64);
                float s = 0.f;
#pragma unroll
                for (int i = 0; i < 8; ++i) { const v4u u = kp[i]; s += (q[8 * i] * bflo(u.x) + q[8 * i + 1] * bfhi(u.x)) + (q[8 * i + 2] * bflo(u.y) + q[8 * i + 3] * bfhi(u.y))
                        + (q[8 * i + 4] * bflo(u.z) + q[8 * i + 5] * bfhi(u.z)) + (q[8 * i + 6] * bflo(u.w) + q[8 * i + 7] * bfhi(u.w)); }
                const float mn = fmaxf(mrun, s), corr = __expf(mrun - mn), pr = __expf(s - mn); lrun = lrun * corr + pr; mrun = mn;
#pragma unroll
                for (int i = 0; i < 8; ++i) { const v4u u = vp[i];
                    acc[8 * i + 0] = acc[8 * i + 0] * corr + pr * bflo(u.x); acc[8 * i + 1] = acc[8 * i + 1] * corr + pr * bfhi(u.x); acc[8 * i + 2] = acc[8 * i + 2] * corr + pr * bflo(u.y); acc[8 * i + 3] = acc[8 * i + 3] * corr + pr * bfhi(u.y);
                    acc[8 * i + 4] = acc[8 * i + 4] * corr + pr * bflo(u.z); acc[8 * i + 5] = acc[8 * i + 5] * corr + pr * bfhi(u.z); acc[8 * i + 6] = acc[8 * i + 6] * corr + pr * bflo(u.w); acc[8 * i + 7] = acc[8 * i + 7] * corr + pr * bfhi(u.w); }
            } } }
    const float inv = 1.0f / lrun; float* o = OB + (size_t)t * 512 + head * 64;
#pragma unroll
    for (int i = 0; i < 16; ++i) *(f32x4*)(o + 4 * i) = (f32x4){acc[4 * i] * inv, acc[4 * i + 1] * inv, acc[4 * i + 2] * inv, acc[4 * i + 3] * inv};
}
__device__ __forceinline__ void hg_p2_item4(unsigned char* ws, int item, int t) {
    const bf16* UT = (const bf16*)(ws + WS_HGU); const float* DCH = (const float*)(ws + WS_HGD); bf16* SPT = (bf16*)(ws + WS_HGS);
    const int bh = item >> 4, v = (item & 15) * 8 + (t >> 5), k = 4 * (t & 31); const size_t cb = (size_t)bh * HG_NCH;
    f32x4 s = {0.f, 0.f, 0.f, 0.f}; constexpr int U = 8; v2u ru[U]; f32x4 rd[U];
#pragma unroll
    for (int i = 0; i < U; ++i) { ru[i] = *(const v2u*)(UT + (cb + i) * 16384 + v * 128 + k); rd[i] = *(const f32x4*)(DCH + (cb + i) * 128 + k); }
    for (int c0 = 0; c0 < HG_NCH; c0 += U) {
        v2u cu[U]; f32x4 cd[U];
#pragma unroll
        for (int i = 0; i < U; ++i) { cu[i] = ru[i]; cd[i] = rd[i]; }
        if (c0 + U < HG_NCH) {
#pragma unroll
            for (int i = 0; i < U; ++i) { ru[i] = *(const v2u*)(UT + (cb + c0 + U + i) * 16384 + v * 128 + k); rd[i] = *(const f32x4*)(DCH + (cb + c0 + U + i) * 128 + k); } }
#pragma unroll
        for (int i = 0; i < U; ++i) { *(v2u*)(SPT + (cb + c0 + i) * 16384 + v * 128 + k) = (v2u){pk2(s.x, s.y), pk2(s.z, s.w)};
            s = cd[i] * s + (f32x4){bflo(cu[i].x), bfhi(cu[i].x), bflo(cu[i].y), bfhi(cu[i].y)}; }
    }
}
__device__ __forceinline__ void sd_p2_item4(unsigned char* ws, int item, int t) {
    const bf16* STATES = (const bf16*)(ws + WS_SDST); const float* CDEC = (const float*)(ws + WS_CDEC); bf16* PREV = (bf16*)(ws + WS_SDPV);
    const int bh = item >> 3, b = bh >> 3, h = bh & 7, pp = (item & 7) * 8 + (t >> 5), n = 4 * (t & 31);
    f32x4 s = {0.f, 0.f, 0.f, 0.f}; constexpr int U = 8; v2u ru[U]; float rd[U];
#define SD_IDX4(c_) (((size_t)(b * 256 + (c_)) * 8 + h) * 8192 + pp * 128 + n)
#pragma unroll
    for (int i = 0; i < U; ++i) { ru[i] = *(const v2u*)(STATES + SD_IDX4(i)); rd[i] = CDEC[(size_t)(b * 256 + i) * 8 + h]; }
    for (int c0 = 0; c0 < 256; c0 += U) {
        v2u cu[U]; float cd[U];
#pragma unroll
        for (int i = 0; i < U; ++i) { cu[i] = ru[i]; cd[i] = rd[i]; }
        if (c0 + U < 256) {
#pragma unroll
            for (int i = 0; i < U; ++i) { ru[i] = *(const v2u*)(STATES + SD_IDX4(c0 + U + i)); rd[i] = CDEC[(size_t)(b * 256 + c0 + U + i) * 8 + h]; } }
#pragma unroll
        for (int i = 0; i < U; ++i) { *(v2u*)(PREV + SD_IDX4(c0 + i)) = (v2u){pk2(s.x, s.y), pk2(s.z, s.w)};
            s = s * cd[i] + (f32x4){bflo(cu[i].x), bfhi(cu[i].x), bflo(cu[i].y), bfhi(cu[i].y)}; }
    }
#undef SD_IDX4
}
__device__ __forceinline__ void lru_p2_item4(unsigned char* ws, int item, int t) {
    const float* LRA = (const float*)(ws + WS_LRA); const float* LRH = (const float*)(ws + WS_LRH); float* LRC = (float*)(ws + WS_LRC);
    const int idx = item * 256 + t, b = idx >> 9, c = idx & 511; const size_t base = (size_t)b * 256 * 512 + c;
    float hh = 0.f; constexpr int U = 16; float ra[U], rb[U];
#pragma unroll
    for (int i = 0; i < U; ++i) { ra[i] = LRA[base + (size_t)i * 512]; rb[i] = LRH[base + (size_t)i * 512]; }
    for (int k0 = 0; k0 < 256; k0 += U) {
        float ca[U], cbv[U];
#pragma unroll
        for (int i = 0; i < U; ++i) { ca[i] = ra[i]; cbv[i] = rb[i]; }
        if (k0 + U < 256) {
#pragma unroll
            for (int i = 0; i < U; ++i) { ra[i] = LRA[base + (size_t)(k0 + U + i) * 512]; rb[i] = LRH[base + (size_t)(k0 + U + i) * 512]; } }
#pragma unroll
        for (int i = 0; i < U; ++i) { LRC[base + (size_t)(k0 + i) * 512] = hh; hh = ca[i] * hh + cbv[i]; }
    }
}
__device__ __forceinline__ void ph_m2_half(unsigned char* ws, int vcu, int G, int t) {
    constexpr int N_ITEMS = 4 + 128 + 128;
    for (int w = vcu; w < N_ITEMS; w += G) {
        if (w < 4) lru_p2_item4(ws, w, t);
        else if (w < 132) hg_p2_item4(ws, w - 4, t);
        else sd_p2_item4(ws, w - 132, t);
    }
}
__device__ __forceinline__ void ph_convert_dyn(const Args& a, unsigned char* ws, int l, int mask, LAS unsigned char* lds, int vcu, int G, int wave, int lane, LAS unsigned* ctr) {
    LAS float* scr = (LAS float*)(lds + wave * 16384);
    const int nitems = cvt_nitems(mask);
#define CV_GRAB(dst) do { unsigned j_ = 0; if (lane == 0) j_ = __hip_atomic_fetch_add(ctr, 1u, __ATOMIC_RELAXED, __HIP_MEMORY_SCOPE_WORKGROUP); dst = vcu + G * (int)__builtin_amdgcn_readfirstlane(j_); } while (0)
    int it; CV_GRAB(it); if (it >= nitems) return;
    CvtDesc d0 = cvt_decode(a, ws, l, mask, it); f32x4 v[8]; cvt_load(d0, lane, v);
    for (;;) {
        int nx; CV_GRAB(nx); CvtDesc d1 = d0; f32x4 vn[8];
        if (nx < nitems) { d1 = cvt_decode(a, ws, l, mask, nx); cvt_load(d1, lane, vn); }
        else {
#pragma unroll
            for (int i = 0; i < 8; ++i) vn[i] = v[i]; }
        cvt_store(d0, ws, lane, v, scr);
        if (nx >= nitems) break;
        d0 = d1;
#pragma unroll
        for (int i = 0; i < 8; ++i) v[i] = vn[i];
    }
#undef CV_GRAB
}
__device__ __forceinline__ void ld8(const float* p, float (&o)[8]) { const f32x4 u0 = *(const f32x4*)p, u1 = *(const f32x4*)(p + 4); o[0] = u0.x; o[1] = u0.y; o[2] = u0.z; o[3] = u0.w; o[4] = u1.x; o[5] = u1.y; o[6] = u1.z; o[7] = u1.w; }
__device__ __forceinline__ void ldb8(const bf16* p, float (&o)[8]) { const v4u u = *(const v4u*)p; o[0] = bflo(u.x); o[1] = bfhi(u.x); o[2] = bflo(u.y); o[3] = bfhi(u.y); o[4] = bflo(u.z); o[5] = bfhi(u.z); o[6] = bflo(u.w); o[7] = bfhi(u.w); }
__device__ __forceinline__ void st8(bf16* p, const float (&o)[8]) { v4u u; u.x = pk2(o[0], o[1]); u.y = pk2(o[2], o[3]); u.z = pk2(o[4], o[5]); u.w = pk2(o[6], o[7]); *(v4u*)p = u; }
__device__ __forceinline__ void ph_m3(const Args& a, unsigned char* ws, int l, int gw, int ngw, int lane) {
    const bf16* proj = (const bf16*)(ws + WS_HP); bf16* Y = (bf16*)(ws + WS_Y);
    const float* OA = (const float*)(ws + WS_OA); const float* OB = (const float*)(ws + WS_OB); const float* OC = (const float*)(ws + WS_OC); const float* OD = (const float*)(ws + WS_OD);
    const float* nA = a.in[I_HGN] + l * 512; const float* nB = a.in[I_ATN] + l * 512; const float* nC = a.in[I_SNORM] + l * 512; const float* nD = a.in[I_LNORM] + l * 512;
    const int c = lane * 8;
    for (int t = gw; t < M; t += ngw) {
        float vb[8];
        ld8(OB + (size_t)t * 512 + c, vb);
        const bf16* pr = proj + (size_t)t * NPROJ;
        { float ss = 0.f;
#pragma unroll
          for (int i = 0; i < 8; ++i) ss += vb[i] * vb[i];
          ss = wave_sum(ss); const float r = 1.0f / sqrtf(ss * (1.0f / 512.0f) + NORM_EPS); float w[8]; ld8(nB + c, w);
#pragma unroll
          for (int i = 0; i < 8; ++i) vb[i] = vb[i] * r * w[i];
          st8(Y + (size_t)t * DM + 512 + c, vb); }
    }
}
__device__ __forceinline__ void ph_final(float* out, const bf16* xh, const unsigned char* xl, const rs_t* rowss, const float* w, int vcu, int G, int tid) {
    const int lane = tid & 63, wave = tid >> 6, wr = wave >> 2, wc = wave & 3, fr = lane & 15, fq = lane >> 4;
    for (int t = vcu; t < (M / 256) * (DM / 256); t += G) { const int pm = t >> 3, pn = t & 7;
#pragma unroll
        for (int am = 0; am < 8; ++am) { const int row = pm * 256 + (am >> 2) * 128 + wr * 64 + (am & 3) * 16 + fr; const float r = 1.0f / sqrtf((float)rowss[row] * (RS_INV / DM) + NORM_EPS);
            v4u lw = {0x80808080u, 0x80808080u, 0x80808080u, 0x80808080u}; if (MK_LO) lw = *(const v4u*)(xl + pg8::lo_addr(pm, pn, am, wave, lane));
#pragma unroll
            for (int bj = 0; bj < 2; ++bj) { const int col = pn * 256 + bj * 128 + wc * 32 + 8 * fq; const size_t o2 = (size_t)row * DM + col; const v4u h = *(const v4u*)(xh + o2);
                const f32x4 w0 = *(const f32x4*)(w + col), w1 = *(const f32x4*)(w + col + 4); const unsigned l0 = lw[2 * bj], l1 = lw[2 * bj + 1];
                f32x4 v0 = {bflo(h.x) + pg8::lo_dec(h.x & 0xffffu, l0 & 0xffu), bfhi(h.x) + pg8::lo_dec(h.x >> 16, (l0 >> 8) & 0xffu), bflo(h.y) + pg8::lo_dec(h.y & 0xffffu, (l0 >> 16) & 0xffu), bfhi(h.y) + pg8::lo_dec(h.y >> 16, l0 >> 24)};
                f32x4 v1 = {bflo(h.z) + pg8::lo_dec(h.z & 0xffffu, l1 & 0xffu), bfhi(h.z) + pg8::lo_dec(h.z >> 16, (l1 >> 8) & 0xffu), bflo(h.w) + pg8::lo_dec(h.w & 0xffffu, (l1 >> 16) & 0xffu), bfhi(h.w) + pg8::lo_dec(h.w >> 16, l1 >> 24)};
                *(f32x4*)(out + o2) = v0 * r * w0; *(f32x4*)(out + o2 + 4) = v1 * r * w1; } } }
}
constexpr int NPH = 66;
__host__ __device__ inline bool phase_active(int p) {
    if (p == 0 || p == NPH - 1) return true;
    const int f = (p - 1) >> 3, k = (p - 1) & 7, second = f & 1, l = f >> 1;
    if (k == 0) return false;
    if (k == 1 || k == 2) return true;
    return !second;
}
__global__ void __launch_bounds__(NTHR, 2) fwd_kernel(Args args) {
    extern __shared__ __attribute__((aligned(16))) unsigned char lds_raw[];
    LAS unsigned char* lds = (LAS unsigned char*)lds_raw;
    volatile LAS unsigned* MISC = (volatile LAS unsigned*)(lds + MISC_OFF);
    const int tid0 = threadIdx.x;
    const int G = gridDim.x, bx = blockIdx.x, vcu = (G % 8 == 0) ? (bx % 8) * (G / 8) + bx / 8 : bx;
    const int ngw = G * NWAVES;
    unsigned* ctl = (unsigned*)(args.ws + WS_CTL);
    for (int u = tid0; u < (LDS_BYTES - LDSCTL_OFF) / 4; u += NTHR) ((LAS unsigned*)(lds + LDSCTL_OFF))[u] = 0u;
    __syncthreads();
    const int lo = args.ph_lo, hi = args.ph_hi;
    const bool multi = (hi - lo) > 1;
    XcdBarrier bar; bar.bar = ctl + CW_BAR; bar.x = 0; bar.st = nullptr;
    if (multi) bar = xcd_barrier_post(ctl + CW_BAR, MISC + 8);
#define IN(k) (lo <= (k) && (k) < hi)
#define SEAM(k) do { if ((k) + 1 < hi) xcd_barrier(bar); } while (0)

    if (IN(0)) { unsigned char* ws = args.ws; rs_t* rowss_all = (rs_t*)(ws + WS_ROWSS); const int lane = tid0 & 63, wave = __builtin_amdgcn_readfirstlane(tid0 >> 6), gw = vcu * NWAVES + wave;
        ph_prep(args.in[I_X], (bf16*)(ws + WS_XB), (unsigned char*)(ws + WS_XLO), rowss_all, vcu, G, tid0); ph_convert(args, ws, 0, CVM_F1 | CVM_IN, lds, gw, ngw, wave, lane); SEAM(0); }

    for (int f = 0; f < 2 * DEPTH; ++f) {
        const int l = f >> 1, second = f & 1, base = 1 + 8 * f;
        unsigned long long wsv_ = (unsigned long long)args.ws, outv_ = (unsigned long long)args.out; asm volatile("" : "+s"(wsv_), "+s"(outv_));
        unsigned char* ws = (unsigned char*)(GAS unsigned char*)wsv_; float* out = (float*)(GAS float*)outv_; rs_t* rowss_all = (rs_t*)(ws + WS_ROWSS);
        int tid = tid0; asm volatile("" : "+v"(tid));
        const int lane = tid & 63, wave = __builtin_amdgcn_readfirstlane(tid >> 6), gw = vcu * NWAVES + wave;
        bf16* XB = (bf16*)(ws + WS_XB); bf16* HP = (bf16*)(ws + WS_HP); bf16* Y = (bf16*)(ws + WS_Y);
        const rs_t* rs_in = rowss_all + (size_t)(3 * l + 2 * second) * M;
        rs_t* rs_out = rowss_all + (size_t)(3 * l + 1 + 2 * second) * M;
        if (IN(base + 1)) {
            pg8::Gemm g{XB, (const bf16*)(ws + (second ? WS_WGU2 : WS_WGU1)), M, NGU, DM}; pg8::StaticOrder S; S.init(M, NGU, G, bx);
            pg8::EpiSwiglu E{HP, DFF, rs_in, RS_INV / DM, NORM_EPS};
            pg8::gemm_phase<pg8::EpiSwiglu, pg8::StaticOrder, true, true>(lds, g, S, E);
            SEAM(base + 1);
        }
        if (IN(base + 2)) {
            pg8::Gemm g{HP, (const bf16*)(ws + (second ? WS_WD2 : WS_WD1)), M, DM, DFF}; pg8::StaticOrderT<4, true> S; S.init(M, DM, G, bx);
            pg8::EpiResid E{XB, (unsigned char*)(ws + WS_XLO), rs_out, DM, 0.5f};
            pg8::gemm_phase<pg8::EpiResid, pg8::StaticOrderT<4, true>, true, true>(lds, g, S, E);
            SEAM(base + 2);
        }
        if (!second) {
            if (IN(base + 3)) {
                pg8::Gemm g{XB, (const bf16*)(ws + WS_WIN), M, NPROJ, DM}; pg8::StaticOrder S; S.init(M, NPROJ, G, bx);
                pg8::EpiRowScale E{HP, NPROJ, rs_out, RS_INV / DM, NORM_EPS};
                pg8::gemm_phase<pg8::EpiRowScale, pg8::StaticOrder, true, true>(lds, g, S, E);
                SEAM(base + 3);
            }
            if (IN(base + 4)) { const bool cfirst = vcu & 1;
                if (cfirst) { ph_convert(args, ws, l, CVM_OUT, lds, gw, ngw, wave, lane); __syncthreads(); }
                { LruW W; lru_load_w(args, l, wave, lane, W); for (int u = vcu; u < 512; u += G) lru_unit<false>(args, ws, l, u, W, lds, tid); }
                for (int u = vcu; u < 512; u += G) sd_p1_unit(args, ws, l, rs_out, u, lds, tid);
                { HgRaw R; hg_load<false>(R, ws, vcu, tid); for (int u = vcu; u < 2048; u += G) hg_p1_unit(args, ws, l, u, (u + G < 2048) ? u + G : -1, R, lds, tid); }
                attn_pass<0>(args, ws, l, vcu, G, lds, tid);
                if (!cfirst) { __syncthreads(); ph_convert(args, ws, l, CVM_OUT, lds, gw, ngw, wave, lane); } SEAM(base + 4); }
            if (IN(base + 5)) {
                LAS unsigned* cctr = (LAS unsigned*)(lds + LDSCTL_OFF + 64);
                if (tid == 0) *cctr = 0u;
                __syncthreads();
                if (wave < 4) ph_m2_half(ws, vcu, G, tid);
                if (l + 1 < DEPTH) ph_convert_dyn(args, ws, l + 1, CVM_F1 | CVM_IN, lds, vcu, G, wave, lane, cctr);
                __syncthreads();
                attn_pass<1>(args, ws, l, vcu, G, lds, tid);
                SEAM(base + 5); }
            if (IN(base + 6)) { const bool cfirst = vcu & 1;
                if (cfirst) { ph_convert(args, ws, l, CVM_F2, lds, gw, ngw, wave, lane); __syncthreads(); }
                { HgRaw R; hg_load<true>(R, ws, vcu, tid); for (int u = vcu; u < 2048; u += G) hg_p3_unit(args, ws, l, u, (u + G < 2048) ? u + G : -1, R, lds, tid); } for (int u = vcu; u < 1024; u += G) sd_p3_unit(args, ws, l, u, lds, tid);
                { LruW W; lru_load_w(args, l, wave, lane, W); for (int u = vcu; u < 512; u += G) lru_unit<true>(args, ws, l, u, W, lds, tid); }
                if (!cfirst) { __syncthreads(); ph_convert(args, ws, l, CVM_F2, lds, gw, ngw, wave, lane); } SEAM(base + 6); }
            if (IN(base + 7)) {
                pg8::Gemm g{Y, (const bf16*)(ws + WS_WOUT), M, DM, DM}; pg8::StaticOrderT<4> S; S.init(M, DM, G, bx);
                pg8::EpiResid E{XB, (unsigned char*)(ws + WS_XLO), rowss_all + (size_t)(3 * l + 2) * M, DM, 1.0f};
                pg8::gemm_phase<pg8::EpiResid, pg8::StaticOrderT<4>, true, true>(lds, g, S, E);
                SEAM(base + 7);
            }
        }
    }
    if (IN(NPH - 1)) { const int lane = tid0 & 63, wave = __builtin_amdgcn_readfirstlane(tid0 >> 6), gw = vcu * NWAVES + wave; ph_final(args.out, (const bf16*)(args.ws + WS_XB), (const unsigned char*)(args.ws + WS_XLO), (const rs_t*)(args.ws + WS_ROWSS) + (size_t)12 * M, args.in[I_FINN], vcu, G, tid0); }
#undef IN
#undef SEAM
}

extern "C" void kernel_launch(void* const* d_in, const int* in_sizes, int n_in, void* d_out, int out_size, void* d_ws, size_t ws_size, hipStream_t stream) {
    static int grid = 0;
    if (grid == 0) {
        if (n_in != 30 || in_sizes[0] != M * DM || out_size != M * DM || ws_size < WS_END) { fprintf(stderr, "kernel_launch: unexpected problem shape / workspace (n_in %d, ws %zu, need %zu); nothing launched\n", n_in, ws_size, (size_t)WS_END); grid = -1; return; }
        int dev = 0, cus = 0;
        if (hipGetDevice(&dev) != hipSuccess || hipDeviceGetAttribute(&cus, hipDeviceAttributeMultiprocessorCount, dev) != hipSuccess) { grid = -1; return; }
        if (hipFuncSetAttribute((const void*)fwd_kernel, hipFuncAttributeMaxDynamicSharedMemorySize, LDS_BYTES) != hipSuccess) { fprintf(stderr, "kernel_launch: hipFuncSetAttribute failed\n"); grid = -1; return; }
        int per_cu = 0;
        if (hipOccupancyMaxActiveBlocksPerMultiprocessor(&per_cu, (const void*)fwd_kernel, NTHR, LDS_BYTES) != hipSuccess || per_cu < 1) { fprintf(stderr, "kernel_launch: occupancy query says %d; nothing launched\n", per_cu); (void)hipGetLastError(); grid = -1; return; }
        grid = cus;
    }
    if (grid < 0) return;
    if (hipMemsetAsync((char*)d_ws + WS_CTL, 0, CTL_ZERO_BYTES, stream) != hipSuccess) return;
    Args a{};
    for (int i = 0; i < 30; ++i) a.in[i] = (const float*)d_in[i];
    a.out = (float*)d_out; a.ws = (unsigned char*)d_ws;
#if MK_ONE_LAUNCH
    a.ph_lo = 0; a.ph_hi = NPH;
    hipLaunchKernelGGL(fwd_kernel, dim3(grid), dim3(NTHR), LDS_BYTES, stream, a);
#else
    for (int p = 0; p < NPH; ++p) { if (!phase_active(p)) continue; a.ph_lo = p; a.ph_hi = p + 1; hipLaunchKernelGGL(fwd_kernel, dim3(grid), dim3(NTHR), LDS_BYTES, stream, a); }
#endif
}
```

```cpp
#include <hip/hip_runtime.h>
#include <cstdio>
#include <cstdint>
namespace pg8 {
#define PG8_LAS __attribute__((address_space(3)))
typedef unsigned short bf16_t;
typedef short bf16x8 __attribute__((ext_vector_type(8)));
typedef float f32x4 __attribute__((ext_vector_type(4)));
typedef unsigned u32x4 __attribute__((ext_vector_type(4)));
constexpr int BM = 256, BK = 64, HALF = 128, HTB = HALF * BK * 2  , STAGE_BYTES = 8 * HTB, NXCD = 8, WGM = 8;

__host__ __device__ __forceinline__ int lds_byte(int r, int c) { const int st = (r >> 4) * 2 + (c >> 5), rr = r & 15, cc = c & 31, ob = rr * 64 + cc * 2; return st * 1024 + (ob ^ (((ob >> 9) & 1) << 5)); }
__host__ __device__ __forceinline__ void stage_rc(int b, int& R, int& C) { const int st = b / 1024, sb = b % 1024, swz = sb ^ (((sb >> 9) & 1) << 5); R = (st >> 1) * 16 + swz / 64; C = (st & 1) * 32 + (swz % 64) / 2; }
__host__ __device__ __forceinline__ int perm32(int rho) { const int n = rho >> 4, i = rho & 15; return 8 * (i >> 2) + 4 * n + (i & 3); }

struct Unit { int pm, pn; };
struct Gemm { const bf16_t* A; const bf16_t* Bt; int M, N, K; };

template <int GH, bool REV = false> struct StaticOrderT {
    int nM, nN, nwg, G, c;
    __host__ __device__ void init(int M, int N, int G_, int c_) { nM = M / BM; nN = N / BM; nwg = nM * nN; G = G_; c = c_; }
    __host__ __device__ bool next(int i, Unit& u) const {
        if ((long)i * G + c >= nwg) return false;
        const long L = (long)((REV && nwg % G == 0) ? nwg / G - 1 - i : i) * G + c;
        int wgid = (int)L; { const int q = nwg / NXCD, r = nwg % NXCD, xcd = wgid % NXCD, off = wgid / NXCD; wgid = (xcd < r ? xcd * (q + 1) : r * (q + 1) + (xcd - r) * q) + off; }
        const int nig = GH * nN, gid = wgid / nig, fm = gid * GH, gsz = (nM % GH == 0) ? GH : ((nM - fm) < GH ? (nM - fm) : GH);
        u.pm = fm + ((wgid % nig) % gsz); u.pn = (wgid % nig) / gsz; return true;
    }
    __device__ __forceinline__ void a_ready(const Unit&) const {}
    __device__ __forceinline__ void done(const Unit&) const {}
};
typedef StaticOrderT<WGM> StaticOrder;

__device__ __forceinline__ unsigned cvt_pk_bf16(float lo, float hi) { unsigned r; asm volatile("v_cvt_pk_bf16_f32 %0, %1, %2" : "=v"(r) : "v"(lo), "v"(hi)); return r; }
__device__ __forceinline__ float fast_sigmoid(float v) { return __builtin_amdgcn_rcpf(1.0f + __expf(-v)); }
struct EpiSwiglu {
    static constexpr bool PERM = true, AFTER_DRAIN = false;
    bf16_t* H; int ldh; const unsigned* rowss; float inv_d, eps;
    struct Pre { const PG8_LAS unsigned* rs; };
    __device__ __forceinline__ void prefetch(Pre& p, const Unit& u, int wr, int fr, PG8_LAS unsigned char* lds, int ui, int wid, int lane) const {
        PG8_LAS unsigned* area = (PG8_LAS unsigned*)(lds + STAGE_BYTES + (ui & 1) * 1024);
        if (wid < 4) __builtin_amdgcn_global_load_lds((const unsigned*)(rowss + u.pm * BM + wid * 64 + lane), area + wid * 64, 4, 0, 0);
        p.rs = area; }
    __device__ __forceinline__ void operator()(const f32x4 (&acc)[2][2][4][2], const Unit& u, int wr, int wc, int fr, int fq, const Pre& pre) const {
        const int row0 = u.pm * BM + wr * 64 + fr, col0 = u.pn * HALF + wc * 32 + 8 * fq;
        unsigned rsv[2][4];
#pragma unroll
        for (int ai = 0; ai < 2; ++ai)
#pragma unroll
            for (int m = 0; m < 4; ++m) rsv[ai][m] = pre.rs[wr * 64 + fr + ai * HALF + m * 16];
        __builtin_amdgcn_sched_barrier(0);
        float msr[8], rlr[8];
#pragma unroll
        for (int r = 0; r < 8; ++r) { msr[r] = (float)rsv[r >> 2][r & 3] * inv_d + eps; rlr[r] = __builtin_amdgcn_rsqf(msr[r]) * -1.4426950408889634f; }
        float av[64], pv[64];
#define SW_G(e) acc[(e) >> 5][0][((e) >> 3) & 3][((e) >> 2) & 1][(e) & 3]
#define SW_U(e) acc[(e) >> 5][1][((e) >> 3) & 3][((e) >> 2) & 1][(e) & 3]
#pragma unroll
        for (int s = 0; s < 64 + 4; ++s) {
            if (s >= 1 && s - 1 < 64) av[s - 1] = __builtin_amdgcn_exp2f(av[s - 1]);
            if (s < 64) { const float g = SW_G(s); av[s] = g * rlr[s >> 3]; pv[s] = g * SW_U(s); }
            if (s >= 3 && s - 3 < 64) av[s - 3] = __builtin_amdgcn_rcpf(av[s - 3]);
            if (s >= 2 && s - 2 < 64) av[s - 2] = __builtin_fmaf(av[s - 2], msr[(s - 2) >> 3], msr[(s - 2) >> 3]);
            if (s >= 4) { const int e = s - 4; pv[e] *= av[e];
                if ((e & 7) == 7) { const int r = e >> 3, row = row0 + (r >> 2) * HALF + (r & 3) * 16;
                    u32x4 w; w.x = cvt_pk_bf16(pv[e - 7], pv[e - 6]); w.y = cvt_pk_bf16(pv[e - 5], pv[e - 4]); w.z = cvt_pk_bf16(pv[e - 3], pv[e - 2]); w.w = cvt_pk_bf16(pv[e - 1], pv[e]);
                    *(u32x4*)(H + (size_t)row * ldh + col0) = w; } }
            __builtin_amdgcn_sched_barrier(0);
        }
#undef SW_G
#undef SW_U
    }
};
struct EpiRowScale {
    static constexpr bool PERM = true, AFTER_DRAIN = false;
    bf16_t* O; int ldc; const unsigned* rowss; float inv_d, eps;
    struct Pre { const PG8_LAS unsigned* rs; };
    __device__ __forceinline__ void prefetch(Pre& p, const Unit& u, int wr, int fr, PG8_LAS unsigned char* lds, int ui, int wid, int lane) const {
        PG8_LAS unsigned* area = (PG8_LAS unsigned*)(lds + STAGE_BYTES + (ui & 1) * 1024);
        if (wid < 4) __builtin_amdgcn_global_load_lds((const unsigned*)(rowss + u.pm * BM + wid * 64 + lane), area + wid * 64, 4, 0, 0);
        p.rs = area; }
    __device__ __forceinline__ void operator()(const f32x4 (&acc)[2][2][4][2], const Unit& u, int wr, int wc, int fr, int fq, const Pre& pre) const {
        const int row0 = u.pm * BM + wr * 64 + fr, col0 = u.pn * BM + wc * 32 + 8 * fq;
        unsigned rsv[2][4];
#pragma unroll
        for (int ai = 0; ai < 2; ++ai)
#pragma unroll
            for (int m = 0; m < 4; ++m) rsv[ai][m] = pre.rs[wr * 64 + fr + ai * HALF + m * 16];
        __builtin_amdgcn_sched_barrier(0);
#pragma unroll
        for (int ai = 0; ai < 2; ++ai)
#pragma unroll
            for (int m = 0; m < 4; ++m) { const int row = row0 + ai * HALF + m * 16; const float r = __builtin_amdgcn_rsqf((float)rsv[ai][m] * inv_d + eps);
                bf16_t* rowp = O + (size_t)row * ldc + col0;
#pragma unroll
                for (int bj = 0; bj < 2; ++bj) { const f32x4 v0 = acc[ai][bj][m][0] * r, v1 = acc[ai][bj][m][1] * r;
                    u32x4 w; w.x = cvt_pk_bf16(v0[0], v0[1]); w.y = cvt_pk_bf16(v0[2], v0[3]); w.z = cvt_pk_bf16(v1[0], v1[1]); w.w = cvt_pk_bf16(v1[2], v1[3]);
                    *(u32x4*)(rowp + bj * HALF) = w; } }
    }
};
__device__ __forceinline__ float lo_scale(unsigned hb) { int se = (int)((hb >> 7) & 0xffu) - 15; se = se < 0 ? 0 : se; return __builtin_bit_cast(float, (unsigned)se << 23); }
__device__ __forceinline__ float lo_inv(unsigned hb) { int ie = 269 - (int)((hb >> 7) & 0xffu); ie = ie > 254 ? 254 : ie; return __builtin_bit_cast(float, (unsigned)ie << 23); }
__device__ __forceinline__ float lo_dec(unsigned hb, unsigned byte) { return ((float)byte - 128.0f) * lo_scale(hb); }
__device__ __forceinline__ unsigned lo_enc(float x, unsigned hb) { const float hf = __builtin_bit_cast(float, hb << 16); float t = (x - hf) * lo_inv(hb) + 128.0f; t = fminf(fmaxf(t, 1.0f), 255.0f); return (unsigned)__builtin_rintf(t); }
#ifndef MK_LO
#define MK_LO 0
#endif
__device__ __forceinline__ size_t lo_addr(int pm, int pn, int am, int wave, int lane) { return ((((size_t)(pm * 8 + pn) * 8 + am) * 8 + wave) * 64 + lane) * 16; }
struct EpiResid {
    static constexpr bool PERM = true, AFTER_DRAIN = false;
    bf16_t* xh; unsigned char* xl; unsigned* rowss_out; int ldc; float scale;
    struct Pre {}; __device__ __forceinline__ void prefetch(Pre&, const Unit&, int, int, PG8_LAS unsigned char*, int, int, int) const {}
    __device__ __forceinline__ void operator()(const f32x4 (&acc)[2][2][4][2], const Unit& u, int wr, int wc, int fr, int fq, const Pre&) const {
        const int row0 = u.pm * BM + wr * 64 + fr, col0 = u.pn * BM + wc * 32 + 8 * fq, wave = wr * 4 + wc, lane = fq * 16 + fr;
        constexpr int NB = MK_LO ? 2 : 4;
#pragma unroll
        for (int ab = 0; ab < 8 / NB; ++ab) {
            u32x4 hi[NB][2], lo[NB];
#pragma unroll
            for (int mm = 0; mm < NB; ++mm) { const int am = NB * ab + mm, ai = am >> 2, m = am & 3; if (MK_LO) lo[mm] = *(const u32x4*)(xl + lo_addr(u.pm, u.pn, am, wave, lane)); else lo[mm] = (u32x4){0x80808080u, 0x80808080u, 0x80808080u, 0x80808080u};
#pragma unroll
                for (int bj = 0; bj < 2; ++bj) hi[mm][bj] = *(const u32x4*)(xh + (size_t)(row0 + ai * HALF + m * 16) * ldc + col0 + bj * HALF); }
#pragma unroll
            for (int mm = 0; mm < NB; ++mm) { const int am = NB * ab + mm, ai = am >> 2, m = am & 3; const int row = row0 + ai * HALF + m * 16; float ss = 0.f; u32x4 wl = {0u, 0u, 0u, 0u};
#pragma unroll
                for (int bj = 0; bj < 2; ++bj) { const size_t o2 = (size_t)row * ldc + col0 + bj * HALF; u32x4 wh;
#pragma unroll
                    for (int q = 0; q < 4; ++q) { const unsigned h = hi[mm][bj][q], lw = lo[mm][2 * bj + (q >> 1)] >> (16 * (q & 1));
                        float x0 = __builtin_bit_cast(float, h << 16), x1 = __builtin_bit_cast(float, h & 0xffff0000u); if (MK_LO) { x0 += lo_dec(h & 0xffffu, lw & 0xffu); x1 += lo_dec(h >> 16, (lw >> 8) & 0xffu); }
                        x0 += acc[ai][bj][m][q >> 1][2 * (q & 1)] * scale; x1 += acc[ai][bj][m][q >> 1][2 * (q & 1) + 1] * scale;
                        ss += x0 * x0 + x1 * x1;
                        const unsigned nh = cvt_pk_bf16(x0, x1); wh[q] = nh;
                        if (MK_LO) wl[2 * bj + (q >> 1)] |= (lo_enc(x0, nh & 0xffffu) | (lo_enc(x1, nh >> 16) << 8)) << (16 * (q & 1)); }
                    *(u32x4*)(xh + o2) = wh; }
                if (MK_LO) *(u32x4*)(xl + lo_addr(u.pm, u.pn, am, wave, lane)) = wl;
                ss += __shfl_xor(ss, 16); ss += __shfl_xor(ss, 32);
                if (fq == 0) atomicAdd(rowss_out + row, (unsigned)(ss * 1024.0f + 0.5f)); } }
    }
};
struct EpiNull {
    static constexpr bool PERM = true, AFTER_DRAIN = false;
    float* sink;
    struct Pre {}; __device__ __forceinline__ void prefetch(Pre&, const Unit&, int, int, PG8_LAS unsigned char*, int, int, int) const {}
    __device__ __forceinline__ void operator()(const f32x4 (&acc)[2][2][4][2], const Unit& u, int wr, int wc, int fr, int fq, const Pre&) const {
        float s = 0.f;
#pragma unroll
        for (int ai = 0; ai < 2; ++ai)
#pragma unroll
            for (int bj = 0; bj < 2; ++bj)
#pragma unroll
                for (int m = 0; m < 4; ++m)
#pragma unroll
                    for (int n = 0; n < 2; ++n) s += (acc[ai][bj][m][n][0] + acc[ai][bj][m][n][1]) + (acc[ai][bj][m][n][2] + acc[ai][bj][m][n][3]);
        if (s == 1234567.125f) sink[0] = s;
    }
};
template <class Epi, class Sched, bool ALIGN_EPI = false, bool SP2 = false>
__device__ __forceinline__ void gemm_phase(PG8_LAS unsigned char* lds, const Gemm g, const Sched& S, const Epi& E) {
    int tid_ = threadIdx.x; asm volatile("" : "+v"(tid_));
    const int tid = tid_, wid = __builtin_amdgcn_readfirstlane(tid >> 6), lane = tid & 63, wr = wid >> 2, wc = wid & 3, fr = lane & 15, fq = lane >> 4;
    const int K = g.K, nt = K / BK;
    unsigned voffA[2], voffB[2];
#pragma unroll
    for (int i = 0; i < 2; ++i) { int R, C; stage_rc(tid * 16 + i * 8192, R, C); const int Rb = Epi::PERM ? ((R & ~31) + perm32(R & 31)) : R;
        voffA[i] = (unsigned)(R * K + C) * 2u; voffB[i] = (unsigned)(Rb * K + C) * 2u; }
    const size_t kstep = (size_t)(BK * 2);
    const size_t hstep = (size_t)HALF * K * 2;
    const size_t tstep = 2 * hstep;
    const unsigned ldsw = (unsigned)wid * 1024u;
    const int aoff = lds_byte(wr * 64 + fr, fq * 8), boff = lds_byte(wc * 32 + fr, fq * 8);
#define PG8_SA(b, h) (((b) * 2 + (h)) * HTB)
#define PG8_SB(b, h) ((4 + (b) * 2 + (h)) * HTB)
#define PG8_STAGE(bufoff, gbase, voff) do { _Pragma("unroll") for (int _i = 0; _i < 2; ++_i) \
        __builtin_amdgcn_global_load_lds((const unsigned*)((const char*)(gbase) + (voff)[_i]), (PG8_LAS unsigned*)(lds + (bufoff) + ldsw + _i * 8192), 16, 0, 0); } while (0)
#define PG8_LDA(dst, b, h) do { _Pragma("unroll") for (int m = 0; m < 4; ++m) _Pragma("unroll") for (int k = 0; k < 2; ++k) dst[m][k] = *(const PG8_LAS bf16x8*)(lds + PG8_SA(b, h) + aoff + m * 2048 + k * 1024); } while (0)
#define PG8_LDB(dst, b, h) do { _Pragma("unroll") for (int n = 0; n < 2; ++n) _Pragma("unroll") for (int k = 0; k < 2; ++k) dst[n][k] = *(const PG8_LAS bf16x8*)(lds + PG8_SB(b, h) + boff + n * 2048 + k * 1024); } while (0)
#define PG8_MMA(ai, bj, At, Bt) do { __builtin_amdgcn_s_setprio(1); _Pragma("unroll") for (int m = 0; m < 4; ++m) _Pragma("unroll") for (int n = 0; n < 2; ++n) _Pragma("unroll") for (int k = 0; k < 2; ++k) \
        acc[ai][bj][m][n] = __builtin_amdgcn_mfma_f32_16x16x32_bf16(Bt[n][k], At[m][k], acc[ai][bj][m][n], 0, 0, 0); __builtin_amdgcn_s_setprio(0); } while (0)
#define PG8_WAIT_V(n) asm volatile("s_waitcnt vmcnt(" #n ")" ::: "memory")
#define PG8_WAIT_L(n) asm volatile("s_waitcnt lgkmcnt(" #n ")" ::: "memory")
#define PG8_BAR __builtin_amdgcn_s_barrier()
#define PG8_SCHED __builtin_amdgcn_sched_barrier(0)
    Unit cur, nxt; int ui = 0;
    if (!S.next(0, cur)) return;
    f32x4 acc[2][2][4][2];
#define PG8_ZERO_ACC() do { _Pragma("unroll") for (int a = 0; a < 2; ++a) _Pragma("unroll") for (int b = 0; b < 2; ++b) _Pragma("unroll") for (int m = 0; m < 4; ++m) _Pragma("unroll") for (int n = 0; n < 2; ++n) { \
        typedef unsigned long long u64x2_ __attribute__((ext_vector_type(2))); unsigned long long z0_, z1_; asm volatile("v_mov_b64 %0, 0\n\tv_mov_b64 %1, 0" : "=v"(z0_), "=v"(z1_)); \
        acc[a][b][m][n] = __builtin_bit_cast(f32x4, (u64x2_){z0_, z1_}); } } while (0)
    PG8_ZERO_ACC();
    bf16x8 At[4][2], B0[2][2], B1[2][2];
    const char* cA = (const char*)g.A + (size_t)cur.pm * tstep; const char* cB = (const char*)g.Bt + (size_t)cur.pn * tstep;
    S.a_ready(cur);
    if constexpr (SP2) {
        PG8_STAGE(PG8_SB(0, 0), cB, voffB); PG8_STAGE(PG8_SB(0, 1), cB + hstep, voffB); PG8_STAGE(PG8_SA(0, 0), cA, voffA); PG8_STAGE(PG8_SA(0, 1), cA + hstep, voffA);
        if (wr == 1) PG8_BAR;
        PG8_WAIT_V(2); PG8_BAR;
        PG8_STAGE(PG8_SB(1, 0), cB + kstep, voffB); PG8_STAGE(PG8_SA(1, 0), cA + kstep, voffA); PG8_STAGE(PG8_SB(1, 1), cB + hstep + kstep, voffB);
        PG8_WAIT_V(6); PG8_BAR;
    } else {
        PG8_STAGE(PG8_SB(0, 0), cB, voffB); PG8_STAGE(PG8_SA(0, 0), cA, voffA); PG8_STAGE(PG8_SB(0, 1), cB + hstep, voffB); PG8_STAGE(PG8_SA(0, 1), cA + hstep, voffA);
        if (wr == 1) PG8_BAR;
        PG8_WAIT_V(4); PG8_BAR;
        PG8_STAGE(PG8_SB(1, 0), cB + kstep, voffB); PG8_STAGE(PG8_SA(1, 0), cA + kstep, voffA); PG8_STAGE(PG8_SB(1, 1), cB + hstep + kstep, voffB);
        PG8_WAIT_V(6); PG8_BAR;
    }
    for (;;) {
        const bool has_next = S.next(ui + 1, nxt);
        typename Epi::Pre pre; E.prefetch(pre, cur, wr, fr, lds, ui, wid, lane);
        const char* nA = has_next ? (const char*)g.A + (size_t)nxt.pm * tstep : cA; const char* nB = has_next ? (const char*)g.Bt + (size_t)nxt.pn * tstep : cB;
        for (int t = 0; t < nt; t += 2) {
            const bool last = (t == nt - 2);
            const char* a1 = cA + (size_t)(t + 1) * kstep;
            const char* a2 = last ? nA : cA + (size_t)(t + 2) * kstep; const char* b2 = last ? nB : cB + (size_t)(t + 2) * kstep;
            const char* a3 = a2 + kstep; const char* b3 = b2 + kstep;
            if (last && has_next) S.a_ready(nxt);
            if constexpr (SP2) {
            PG8_LDB(B0, 0, 0); PG8_LDB(B1, 0, 1); PG8_SCHED; PG8_LDA(At, 0, 0); PG8_STAGE(PG8_SA(1, 1), a1 + hstep, voffA);
            PG8_WAIT_V(8); PG8_WAIT_L(0); PG8_BAR; PG8_MMA(0, 0, At, B0); PG8_MMA(0, 1, At, B1); PG8_BAR; PG8_SCHED;
            PG8_LDA(At, 0, 1); PG8_STAGE(PG8_SB(0, 0), b2, voffB); PG8_STAGE(PG8_SB(0, 1), b2 + hstep, voffB); PG8_STAGE(PG8_SA(0, 0), a2, voffA);
            PG8_WAIT_V(8); PG8_WAIT_L(0); PG8_BAR; PG8_MMA(1, 0, At, B0); PG8_MMA(1, 1, At, B1); PG8_BAR; PG8_SCHED;
            PG8_LDB(B0, 1, 0); PG8_LDB(B1, 1, 1); PG8_SCHED; PG8_LDA(At, 1, 0); PG8_STAGE(PG8_SA(0, 1), a2 + hstep, voffA);
            PG8_WAIT_V(8); PG8_WAIT_L(0); PG8_BAR; PG8_MMA(0, 0, At, B0); PG8_MMA(0, 1, At, B1); PG8_BAR; PG8_SCHED;
            PG8_LDA(At, 1, 1); PG8_STAGE(PG8_SB(1, 0), b3, voffB); PG8_STAGE(PG8_SB(1, 1), b3 + hstep, voffB); PG8_STAGE(PG8_SA(1, 0), a3, voffA);
            PG8_WAIT_V(8); PG8_WAIT_L(0); PG8_BAR; PG8_MMA(1, 0, At, B0); PG8_MMA(1, 1, At, B1); PG8_BAR; PG8_SCHED;
            } else {
            PG8_LDB(B0, 0, 0); PG8_SCHED; PG8_LDA(At, 0, 0); PG8_STAGE(PG8_SA(1, 1), a1 + hstep, voffA);
            PG8_WAIT_L(8); PG8_BAR; PG8_WAIT_L(0); PG8_MMA(0, 0, At, B0); PG8_BAR; PG8_SCHED;
            PG8_LDB(B1, 0, 1); PG8_STAGE(PG8_SB(0, 0), b2, voffB);
            PG8_BAR; PG8_WAIT_L(0); PG8_MMA(0, 1, At, B1); PG8_BAR;
            PG8_LDA(At, 0, 1); PG8_STAGE(PG8_SA(0, 0), a2, voffA);
            PG8_BAR; PG8_WAIT_L(0); PG8_MMA(1, 0, At, B0); PG8_BAR; PG8_SCHED;
            PG8_STAGE(PG8_SB(0, 1), b2 + hstep, voffB);
            PG8_WAIT_V(6); PG8_BAR; PG8_MMA(1, 1, At, B1); PG8_BAR;
            PG8_LDB(B0, 1, 0); PG8_SCHED; PG8_LDA(At, 1, 0); PG8_STAGE(PG8_SA(0, 1), a2 + hstep, voffA);
            PG8_WAIT_L(8); PG8_BAR; PG8_WAIT_L(0); PG8_MMA(0, 0, At, B0); PG8_BAR; PG8_SCHED;
            PG8_LDB(B1, 1, 1); PG8_STAGE(PG8_SB(1, 0), b3, voffB);
            PG8_BAR; PG8_WAIT_L(0); PG8_MMA(0, 1, At, B1); PG8_BAR;
            PG8_LDA(At, 1, 1); PG8_STAGE(PG8_SA(1, 0), a3, voffA);
            PG8_BAR; PG8_WAIT_L(0); PG8_MMA(1, 0, At, B0); PG8_BAR; PG8_SCHED;
            PG8_STAGE(PG8_SB(1, 1), b3 + hstep, voffB);
            PG8_WAIT_V(6); PG8_BAR; PG8_MMA(1, 1, At, B1); PG8_BAR;
            }
        }
        if constexpr (ALIGN_EPI) { if (wr == 0) PG8_BAR; }
        if constexpr (!Epi::AFTER_DRAIN) { E(acc, cur, wr, wc, fr, fq, pre); S.done(cur); }
        if (!has_next) break;
        PG8_ZERO_ACC();
        cur = nxt; cA = nA; cB = nB; ++ui;
        if constexpr (ALIGN_EPI) { if (wr == 1) PG8_BAR; }
    }
    PG8_WAIT_V(0);
    if constexpr (!ALIGN_EPI) { if (wr == 0) PG8_BAR; }
    PG8_BAR;
    if constexpr (Epi::AFTER_DRAIN) { E.fused(acc, cur, wr, wc, fr, fq, lds, wid, lane); S.done(cur); }
#undef PG8_SA
#undef PG8_SB
#undef PG8_STAGE
#undef PG8_LDA
#undef PG8_LDB
#undef PG8_MMA
#undef PG8_WAIT_V
#undef PG8_WAIT_L
#undef PG8_BAR
#undef PG8_SCHED
}
}
constexpr int BATCH = 2, SEQ = 16384, DM = 2048, M = BATCH * SEQ, DFF = 5632, NGU = 2 * DFF, NIN = 6152, NPROJ = 6144, DEPTH = 4, GW = 512;
constexpr float NORM_EPS = 1e-6f;
constexpr int PC_AQ = 0, PC_AF = 512, PC_AI = 1024, PC_AG = 1536, PC_BQ = 2048, PC_BK = 2560, PC_BV = 3072, PC_CZ = 3584, PC_CX = 4096, PC_DX = 5120, PC_DG = 5632;
constexpr int NWAVES = 8, NTHR = 512;
#ifndef MK_ONE_LAUNCH
#define MK_ONE_LAUNCH 1
#endif
constexpr size_t MiB = 1u << 20;
constexpr size_t WS_CTL = 0, CTL_ZERO_BYTES = 4 * MiB;
constexpr size_t WS_ROWSS = 64 * 1024;
typedef unsigned rs_t;
constexpr float RS_SCALE = 1024.0f, RS_INV = 1.0f / 1024.0f;
constexpr size_t WS_WGU1 = 4 * MiB, WS_WD1 = 48 * MiB, WS_WGU2 = 70 * MiB, WS_WD2 = 114 * MiB, WS_WIN = 136 * MiB, WS_WOUT = 160 * MiB, WS_WDT = 168 * MiB;
constexpr size_t WS_XB = 170 * MiB;
constexpr size_t WS_HP = 298 * MiB;
constexpr size_t WS_Y = 682 * MiB;
constexpr size_t WS_XBCC = 810 * MiB;
constexpr size_t WS_DTV = 938 * MiB;
constexpr size_t WS_LA = 939 * MiB, WS_LB = 1003 * MiB;
constexpr size_t WS_OA = 1067 * MiB, WS_OB = 1131 * MiB, WS_OC = 1195 * MiB, WS_OD = 1259 * MiB;
constexpr size_t WS_HGU = 1323 * MiB, WS_HGD = 1451 * MiB, WS_HGS = 1452 * MiB;
constexpr size_t WS_WDTB = WS_WDT + 65536, WS_CDEC = WS_WDT + 131072;
constexpr size_t WS_SDST = WS_XBCC, WS_SDPV = WS_OA;
constexpr size_t WS_LRA = WS_LA, WS_LRH = WS_LA + MiB, WS_LRC = WS_LA + 2 * MiB;
constexpr size_t WS_XLO = WS_OB;
constexpr size_t WS_PAO = WS_OC, WS_PAM = WS_OC + 32 * MiB;
constexpr size_t WS_END = 1516 * MiB;
static_assert(WS_ROWSS + 13 * (size_t)M * 8 <= CTL_ZERO_BYTES, "ctl");
static_assert(WS_WGU1 + (size_t)NGU * DM * 2 <= WS_WD1 && WS_WD1 + (size_t)DM * DFF * 2 <= WS_WGU2 && WS_WGU2 + (size_t)NGU * DM * 2 <= WS_WD2 && WS_WD2 + (size_t)DM * DFF * 2 <= WS_WIN &&
              WS_WIN + (size_t)NPROJ * DM * 2 <= WS_WOUT && WS_WOUT + (size_t)DM * DM * 2 <= WS_WDT && WS_WDT + 8 * DM * 4 <= WS_XB && WS_XB + (size_t)M * DM * 2 <= WS_HP &&
              WS_HP + (size_t)M * NPROJ * 2 <= WS_Y && WS_Y + (size_t)M * DM * 2 <= WS_XBCC && WS_XBCC + (size_t)M * 1024 * 4 <= WS_DTV && WS_DTV + (size_t)M * 8 * 4 <= WS_LA &&
              WS_LA + (size_t)M * 512 * 4 <= WS_LB && WS_LB + (size_t)M * 512 * 4 <= WS_OA && WS_OD + (size_t)M * 512 * 4 <= WS_END, "d_ws map");
constexpr int CW_BAR = 1024;
constexpr int RING_BYTES = 131072, LDSCTL_OFF = 143360, MISC_OFF = LDSCTL_OFF + 320, LDS_BYTES = 147456;

#define GAS __attribute__((address_space(1)))
#define LAS __attribute__((address_space(3)))
typedef unsigned short bf16;
typedef unsigned v4u __attribute__((ext_vector_type(4)));
typedef unsigned v2u __attribute__((ext_vector_type(2)));
typedef float f32x4 __attribute__((ext_vector_type(4)));
#define LDS_WAIT() asm volatile("s_waitcnt lgkmcnt(0)" ::: "memory")
typedef float f32x2_t __attribute__((ext_vector_type(2)));
typedef __bf16 bf16x2_t __attribute__((ext_vector_type(2)));
__device__ __forceinline__ unsigned pk2(float lo, float hi) { const f32x2_t v = {lo, hi}; return __builtin_bit_cast(unsigned, __builtin_convertvector(v, bf16x2_t)); }
__device__ __forceinline__ unsigned f2bf(float f) { return pk2(f, f) & 0xffffu; }
__device__ __forceinline__ float bf2f(unsigned b) { return __builtin_bit_cast(float, b << 16); }
__device__ __forceinline__ float bflo(unsigned w) { return __builtin_bit_cast(float, w << 16); }
__device__ __forceinline__ float bfhi(unsigned w) { return __builtin_bit_cast(float, w & 0xffff0000u); }
__device__ __forceinline__ float wave_sum(float v) {
#pragma unroll
    for (int o = 1; o < 64; o <<= 1) v += __shfl_xor(v, o);
    return v;
}
__device__ __forceinline__ float sigmoidf_(float v) { return __builtin_amdgcn_rcpf(1.0f + __builtin_amdgcn_exp2f(v * -1.4426950408889634f)); }
__device__ __forceinline__ float siluf_(float v) { return v * __builtin_amdgcn_rcpf(1.0f + __builtin_amdgcn_exp2f(v * -1.4426950408889634f)); }
__device__ __forceinline__ float softplusf_(float v) { return v > 20.f ? v : log1pf(__expf(v)); }
__device__ __forceinline__ float geluf_(float v) { const float u = 0.7978845608028654f * (v + 0.044715f * v * v * v); return 0.5f * v * (1.0f + tanhf(u)); }
#define XB_TMO      128
#define XB_XCNT(j)  (256  + 64 * (j))
#define XB_XSUB(j)  (1280 + 64 * (j))
#define XB_XGEN(j)  (2304 + 64 * (j))
#define XB_TOP      3328
#define XB_TOPGEN   3392
#define XCD_BAR_WORDS 3456
#define XB_SPIN_CAP (1u << 18)

__device__ __forceinline__ unsigned xb_ld(unsigned* p)              { return __hip_atomic_load(p, __ATOMIC_RELAXED, __HIP_MEMORY_SCOPE_AGENT); }
__device__ __forceinline__ unsigned xb_add(unsigned* p, unsigned v) { return __hip_atomic_fetch_add(p, v, __ATOMIC_RELAXED, __HIP_MEMORY_SCOPE_AGENT); }
__device__ __forceinline__ unsigned xb_xcc_id() { return (unsigned)__builtin_amdgcn_s_getreg((3 << 11) | 20) & 0xFu; }
#define XB_SPIN(cond, bar) do { unsigned _sp = 0; while (cond) { __builtin_amdgcn_s_sleep(1); \
    if ((++_sp & 255u) == 0u) { if (xb_ld(&(bar)[XB_TMO])) break; if (_sp > XB_SPIN_CAP) { atomicAdd(&(bar)[XB_TMO], 1u); break; } } } } while (0)

struct XcdBarrier {
    unsigned* bar; unsigned x;
    volatile LAS unsigned* st;
};

__device__ __forceinline__ XcdBarrier xcd_barrier_post(unsigned* bar, volatile LAS unsigned* st) {
    XcdBarrier b; b.bar = bar; b.x = xb_xcc_id(); b.st = st;
    if (threadIdx.x == 0) (void)xb_add(&bar[XB_XCNT(b.x)], 1u);
    return b;
}
__device__ __forceinline__ void xcd_barrier_complete(unsigned* bar, unsigned x, unsigned& nloc, unsigned& nx) {
    const unsigned G = gridDim.x * gridDim.y * gridDim.z;
    unsigned sum, cnt, mine, sp = 0u;
    for (;;) {
        sum = 0u; cnt = 0u; mine = 0u;
#pragma unroll
        for (unsigned j = 0; j < 16; ++j) { const unsigned c = xb_ld(&bar[XB_XCNT(j)]); sum += c; cnt += (c > 0u) ? 1u : 0u; mine = (j == x) ? c : mine; }
        if (sum == G) break;
        __builtin_amdgcn_s_sleep(1);
        if ((++sp & 255u) == 0u) { if (xb_ld(&bar[XB_TMO])) break; if (sp > XB_SPIN_CAP) { atomicAdd(&bar[XB_TMO], 1u); break; } }
    }
    nloc = mine > 0u ? mine : 1u; nx = cnt > 0u ? cnt : 1u;
}

__device__ __forceinline__ void xcd_barrier(const XcdBarrier& b) {
    asm volatile("s_waitcnt vmcnt(0)" ::: "memory");
    __syncthreads();
    if (threadIdx.x == 0) {
        unsigned* bar = b.bar;
        __builtin_amdgcn_s_waitcnt(0);
        unsigned nloc = b.st[0], nx = b.st[1];
        if (nloc == 0u) { xcd_barrier_complete(bar, b.x, nloc, nx); b.st[0] = nloc; b.st[1] = nx; }
        const unsigned old = xb_add(&bar[XB_XSUB(b.x)], 1u);
        const unsigned gen = old / nloc;
        if (old + 1u == (gen + 1u) * nloc) {
            __builtin_amdgcn_fence(__ATOMIC_RELEASE, "agent");
            asm volatile("s_waitcnt vmcnt(0)" ::: "memory");
            const unsigned og = xb_add(&bar[XB_TOP], 1u);
            const unsigned tg = og / nx;
            if (og + 1u == (tg + 1u) * nx) xb_add(&bar[XB_TOPGEN], 1u);
            else XB_SPIN(xb_ld(&bar[XB_TOPGEN]) == tg, bar);
            __builtin_amdgcn_fence(__ATOMIC_ACQUIRE, "agent");
            xb_add(&bar[XB_XGEN(b.x)], 1u);
            asm volatile("s_waitcnt vmcnt(0)" ::: "memory");
        } else {
            XB_SPIN(xb_ld(&bar[XB_XGEN(b.x)]) == gen, bar);
            __builtin_amdgcn_fence(__ATOMIC_ACQUIRE, "agent");
            asm volatile("s_waitcnt vmcnt(0)" ::: "memory");
        }
    }
    __syncthreads();
}

struct Args {
    const float* in[30];
    float* out; unsigned char* ws; int ph_lo, ph_hi;
};
enum { I_X = 0, I_F1N, I_F1G, I_F1U, I_F1D, I_MIXN, I_WIN, I_WOUT, I_LBL, I_HGN, I_ATN, I_SCW, I_SCB, I_SDTB, I_SALOG, I_SD, I_SNORM, I_LCW, I_LCB, I_LWA, I_LBA, I_LWX, I_LBX, I_LAP, I_LNORM,
       I_F2N, I_F2G, I_F2U, I_F2D, I_FINN };

__device__ __forceinline__ void ph_prep(const float* x, bf16* xb, unsigned char* xlo, rs_t* rowss, int vcu, int G, int tid) {
    const int lane = tid & 63, wave = tid >> 6, wr = wave >> 2, wc = wave & 3, fr = lane & 15, fq = lane >> 4;
    for (int t = vcu; t < (M / 256) * (DM / 256); t += G) { const int pm = t >> 3, pn = t & 7;
#pragma unroll
        for (int am = 0; am < 8; ++am) { const int row = pm * 256 + (am >> 2) * 128 + wr * 64 + (am & 3) * 16 + fr; float ss = 0.f; v4u wl = {0u, 0u, 0u, 0u};
#pragma unroll
            for (int bj = 0; bj < 2; ++bj) { const size_t o2 = (size_t)row * DM + pn * 256 + bj * 128 + wc * 32 + 8 * fq; const f32x4 v0 = *(const f32x4*)(x + o2), v1 = *(const f32x4*)(x + o2 + 4);
                ss += (v0.x * v0.x + v0.y * v0.y) + (v0.z * v0.z + v0.w * v0.w) + (v1.x * v1.x + v1.y * v1.y) + (v1.z * v1.z + v1.w * v1.w);
                v4u w; w.x = pk2(v0.x, v0.y); w.y = pk2(v0.z, v0.w); w.z = pk2(v1.x, v1.y); w.w = pk2(v1.z, v1.w); *(v4u*)(xb + o2) = w;
                if (MK_LO) { wl[2 * bj] = pg8::lo_enc(v0.x, w.x & 0xffffu) | (pg8::lo_enc(v0.y, w.x >> 16) << 8) | (pg8::lo_enc(v0.z, w.y & 0xffffu) << 16) | (pg8::lo_enc(v0.w, w.y >> 16) << 24);
                wl[2 * bj + 1] = pg8::lo_enc(v1.x, w.z & 0xffffu) | (pg8::lo_enc(v1.y, w.z >> 16) << 8) | (pg8::lo_enc(v1.z, w.w & 0xffffu) << 16) | (pg8::lo_enc(v1.w, w.w >> 16) << 24); } }
            if (MK_LO) *(v4u*)(xlo + pg8::lo_addr(pm, pn, am, wave, lane)) = wl;
            ss += __shfl_xor(ss, 16); ss += __shfl_xor(ss, 32);
            if (fq == 0) atomicAdd(rowss + row, (rs_t)(ss * RS_SCALE + 0.5f)); } }
}
struct CvtDesc { const float* W; const float* kscale; bf16* WT; int K, N, mode, r; };
constexpr int CV_G = (DM / 64) * (DFF / 32), CV_IN = (DM / 64) * ((NIN + 31) / 32), CV_OUT = (DM / 64) * (DM / 32);
static_assert((DFF / 64) * (DM / 32) == CV_G, "items");
constexpr int CVM_F1 = 1, CVM_F2 = 2, CVM_IN = 4, CVM_OUT = 8;
__host__ __device__ constexpr int cvt_nitems(int mask) { return ((mask & CVM_F1) ? 3 * CV_G : 0) + ((mask & CVM_F2) ? 3 * CV_G : 0) + ((mask & CVM_IN) ? CV_IN : 0) + ((mask & CVM_OUT) ? CV_OUT : 0); }
__device__ __forceinline__ CvtDesc cvt_decode(const Args& a, unsigned char* ws, int l, int mask, int it) {
    const size_t oF = (size_t)l * DM * DFF, oN = (size_t)l * DM; int r = it; CvtDesc d;
    if (mask & CVM_F1) {
        if (r < CV_G) { d = CvtDesc{a.in[I_F1G] + oF, a.in[I_F1N] + oN, (bf16*)(ws + WS_WGU1), DM, DFF, 1, r}; return d; } r -= CV_G;
        if (r < CV_G) { d = CvtDesc{a.in[I_F1U] + oF, a.in[I_F1N] + oN, (bf16*)(ws + WS_WGU1), DM, DFF, 2, r}; return d; } r -= CV_G;
        if (r < CV_G) { d = CvtDesc{a.in[I_F1D] + oF, nullptr, (bf16*)(ws + WS_WD1), DFF, DM, 0, r}; return d; } r -= CV_G; }
    if (mask & CVM_F2) {
        if (r < CV_G) { d = CvtDesc{a.in[I_F2G] + oF, a.in[I_F2N] + oN, (bf16*)(ws + WS_WGU2), DM, DFF, 1, r}; return d; } r -= CV_G;
        if (r < CV_G) { d = CvtDesc{a.in[I_F2U] + oF, a.in[I_F2N] + oN, (bf16*)(ws + WS_WGU2), DM, DFF, 2, r}; return d; } r -= CV_G;
        if (r < CV_G) { d = CvtDesc{a.in[I_F2D] + oF, nullptr, (bf16*)(ws + WS_WD2), DFF, DM, 0, r}; return d; } r -= CV_G; }
    if (mask & CVM_IN) { if (r < CV_IN) { d = CvtDesc{a.in[I_WIN] + (size_t)l * DM * NIN, a.in[I_MIXN] + oN, (bf16*)(ws + WS_WIN), DM, NIN, 3, r}; return d; } r -= CV_IN; }
    d = CvtDesc{a.in[I_WOUT] + (size_t)l * DM * DM, nullptr, (bf16*)(ws + WS_WOUT), DM, DM, 0, r}; return d;
}
__device__ __forceinline__ void cvt_load(const CvtDesc& d, int lane, f32x4 (&v)[8]) {
    const int nblk = (d.N + 31) / 32, kb = d.r / nblk, nb = d.r % nblk, k0 = 64 * kb, n = 32 * nb + (lane & 7) * 4, kr = lane >> 3;
#pragma unroll
    for (int i = 0; i < 8; ++i) v[i] = (n < d.N) ? *(const f32x4*)(d.W + (size_t)(k0 + kr + 8 * i) * d.N + n) : (f32x4){0.f, 0.f, 0.f, 0.f};
}
__device__ __forceinline__ void cvt_store(const CvtDesc& d, unsigned char* ws, int lane, const f32x4 (&v)[8], LAS float* scr) {
    const int nblk = (d.N + 31) / 32, kb = d.r / nblk, nb = d.r % nblk, k0 = 64 * kb, n0 = 32 * nb, kr = lane >> 3, n4 = (lane & 7) * 4, K = d.K;
#pragma unroll
    for (int i = 0; i < 8; ++i) { const int kk = kr + 8 * i; const float sc = d.kscale ? d.kscale[k0 + kk] : 1.0f; LAS float* s = scr + kk * 33 + n4; s[0] = v[i][0] * sc; s[1] = v[i][1] * sc; s[2] = v[i][2] * sc; s[3] = v[i][3] * sc; }
    LDS_WAIT(); asm volatile("" ::: "memory");
    const int c = lane & 7;
#pragma unroll
    for (int j = 0; j < 4; ++j) { const int nl = (lane >> 3) + 8 * j, n = n0 + nl; const LAS float* s = scr + (8 * c) * 33 + nl;
        const float a0 = s[0 * 33], a1 = s[1 * 33], a2 = s[2 * 33], a3 = s[3 * 33], a4 = s[4 * 33], a5 = s[5 * 33], a6 = s[6 * 33], a7 = s[7 * 33];
        if (n < d.N) {
            int dr = n; bool special = false;
            if (d.mode == 1) dr = 256 * (n >> 7) + (n & 127);
            if (d.mode == 2) dr = 256 * (n >> 7) + 128 + (n & 127);
            if (d.mode == 3) { if (n >= 5128) dr = n - 8; else if (n >= 5120) special = true; }
            v4u o; o.x = pk2(a0, a1); o.y = pk2(a2, a3); o.z = pk2(a4, a5); o.w = pk2(a6, a7);
            if (special) { float* f = (float*)(ws + WS_WDT) + (size_t)(n - 5120) * K + k0 + 8 * c; *(f32x4*)f = (f32x4){a0, a1, a2, a3}; *(f32x4*)(f + 4) = (f32x4){a4, a5, a6, a7};
                *(v4u*)((bf16*)(ws + WS_WDTB) + (size_t)(n - 5120) * K + k0 + 8 * c) = o; }
            else *(v4u*)(d.WT + (size_t)dr * K + k0 + 8 * c) = o;
        } }
    LDS_WAIT(); asm volatile("" ::: "memory");
}
__device__ __forceinline__ void ph_convert(const Args& a, unsigned char* ws, int l, int mask, LAS unsigned char* lds, int gw, int ngw, int wave, int lane) {
    LAS float* scr = (LAS float*)(lds + wave * 16384);
    const int nitems = cvt_nitems(mask);
    int it = gw; if (it >= nitems) return;
    CvtDesc d0 = cvt_decode(a, ws, l, mask, it); f32x4 v[8]; cvt_load(d0, lane, v);
    for (; it < nitems; it += ngw) {
        const int nx = it + ngw; CvtDesc d1 = d0; f32x4 vn[8];
        if (nx < nitems) { d1 = cvt_decode(a, ws, l, mask, nx); cvt_load(d1, lane, vn); }
        else {
#pragma unroll
            for (int i = 0; i < 8; ++i) vn[i] = v[i]; }
        cvt_store(d0, ws, lane, v, scr);
        d0 = d1;
#pragma unroll
        for (int i = 0; i < 8; ++i) v[i] = vn[i];
    }
}
typedef short bf16x8_t __attribute__((ext_vector_type(8)));
typedef short s16x4_t __attribute__((ext_vector_type(4)));
constexpr int HG_NCH = SEQ / 64;
constexpr int HG_TS = 72;
constexpr int HG_RS = 136;
__device__ __forceinline__ float hg_lb(const float* lg, int l, int ch) {
    float mx = lg[ch];
#pragma unroll
    for (int i = 1; i < DEPTH; ++i) mx = fmaxf(mx, lg[i * 512 + ch]);
    float den = 0.f, num = 0.f;
#pragma unroll
    for (int i = 0; i < DEPTH; ++i) { const float e = __expf(lg[i * 512 + ch] - mx); den += e; if (i >= 1 && i <= l) num += e; }
    return num / den;
}
__device__ __forceinline__ unsigned pkbf(float a, float b) { return pk2(a, b); }
struct HgRaw { bf16 z[16], v[16], q[16]; };
template <bool WITHQ> __device__ __forceinline__ void hg_load(HgRaw& R, unsigned char* ws, int unit, int tid) {
    const bf16* proj = (const bf16*)(ws + WS_HP);
    const int h = unit & 3, chunk = (unit >> 2) & (HG_NCH - 1), b = unit >> 10, qt = tid >> 7, col = tid & 127, ch = h * 128 + col;
    const size_t row0 = (size_t)b * SEQ + (size_t)chunk * 64 + 16 * qt;
#pragma unroll
    for (int i = 0; i < 16; ++i) { const bf16* p = proj + (row0 + i) * NPROJ + ch; R.z[i] = p[PC_AF]; R.v[i] = p[PC_AI]; if (WITHQ) R.q[i] = p[PC_AQ]; }
}
__device__ __forceinline__ void hg_p1_unit(const Args& a, unsigned char* ws, int l, int unit, int next, HgRaw& R, LAS unsigned char* lds, int tid_in) {
    int tid = tid_in; asm volatile("" : "+v"(tid));
    const bf16* proj = (const bf16*)(ws + WS_HP); bf16* UT = (bf16*)(ws + WS_HGU); float* DCH = (float*)(ws + WS_HGD);
    const int h = unit & 3, chunk = (unit >> 2) & (HG_NCH - 1), b = unit >> 10;
    const int qt = tid >> 7, col = tid & 127, ch = h * 128 + col, lane = tid & 63, wave = tid >> 6;
    LAS bf16* kT = (LAS bf16*)lds; LAS bf16* vT = kT + 128 * HG_TS; LAS float* tots = (LAS float*)(vT + 128 * HG_TS);
    const float lb = hg_lb(a.in[I_LBL], l, ch);
    const size_t row0 = (size_t)b * SEQ + (size_t)chunk * 64 + 16 * qt;
    float suf[16], kk[16], vv[16];
    { float ff[16];
#pragma unroll
      for (int i = 0; i < 16; ++i) { const float z = bf2f(R.z[i]); vv[i] = bf2f(R.v[i]);
          const float sg = sigmoidf_(z); ff[i] = lb + (1.0f - lb) * sg; kk[i] = (1.0f - lb) * (1.0f - sg); }
      float run = 1.0f;
#pragma unroll
      for (int i = 15; i >= 0; --i) { suf[i] = run; run *= ff[i]; }
      tots[qt * 128 + col] = run; }
    if (next >= 0) hg_load<false>(R, ws, next, tid);
    __syncthreads();
    float post = 1.0f, total = 1.0f;
#pragma unroll
    for (int q = 0; q < 4; ++q) { const float t = tots[q * 128 + col]; total *= t; if (q > qt) post *= t; }
    { unsigned wk[8], wv[8];
#pragma unroll
      for (int i = 0; i < 8; ++i) { const float e0 = kk[2 * i] * (suf[2 * i] * post), e1 = kk[2 * i + 1] * (suf[2 * i + 1] * post); wk[i] = pkbf(e0, e1); wv[i] = pkbf(vv[2 * i], vv[2 * i + 1]); }
      LAS v4u* pk = (LAS v4u*)(kT + col * HG_TS + 16 * qt); LAS v4u* pv = (LAS v4u*)(vT + col * HG_TS + 16 * qt);
      pk[0] = (v4u){wk[0], wk[1], wk[2], wk[3]}; pk[1] = (v4u){wk[4], wk[5], wk[6], wk[7]}; pv[0] = (v4u){wv[0], wv[1], wv[2], wv[3]}; pv[1] = (v4u){wv[4], wv[5], wv[6], wv[7]}; }
    const size_t ubase = ((size_t)(b * 4 + h) * HG_NCH + chunk);
    if (qt == 0) DCH[ubase * 128 + col] = total;
    __syncthreads();
    { const int fr = lane & 15, g = lane >> 4;
      bf16x8_t af[2];
#pragma unroll
      for (int ks = 0; ks < 2; ++ks) af[ks] = *(const LAS bf16x8_t*)(kT + (16 * wave + fr) * HG_TS + 8 * g + 32 * ks);
      bf16* up = UT + ubase * 16384 + (size_t)fr * 128 + 16 * wave + 4 * g;
#pragma unroll
      for (int n = 0; n < 8; ++n) { pg8::f32x4 acc = {0.f, 0.f, 0.f, 0.f};
#pragma unroll
          for (int ks = 0; ks < 2; ++ks) { const bf16x8_t bfr = *(const LAS bf16x8_t*)(vT + (16 * n + fr) * HG_TS + 8 * g + 32 * ks); acc = __builtin_amdgcn_mfma_f32_16x16x32_bf16(af[ks], bfr, acc, 0, 0, 0); }
          *(v2u*)(up + (size_t)(16 * n) * 128) = (v2u){pkbf(acc[0], acc[1]), pkbf(acc[2], acc[3])}; } }
    __syncthreads();
}
__device__ __forceinline__ void hg_p2_item(unsigned char* ws, int item, int tid) {
    const bf16* UT = (const bf16*)(ws + WS_HGU); const float* DCH = (const float*)(ws + WS_HGD); bf16* SPT = (bf16*)(ws + WS_HGS);
    const int bh = item >> 4, v = (item & 15) * 8 + (tid >> 6), k = 2 * (tid & 63);
    typedef float f32x2 __attribute__((ext_vector_type(2)));
    const size_t cb = (size_t)bh * HG_NCH;
    float s0 = 0.f, s1 = 0.f; constexpr int U = 8;
    unsigned ru[U]; f32x2 rd[U];
#pragma unroll
    for (int i = 0; i < U; ++i) { ru[i] = *(const unsigned*)(UT + (cb + i) * 16384 + v * 128 + k); rd[i] = *(const f32x2*)(DCH + (cb + i) * 128 + k); }
    for (int c0 = 0; c0 < HG_NCH; c0 += U) {
        unsigned cu[U]; f32x2 cd[U];
#pragma unroll
        for (int i = 0; i < U; ++i) { cu[i] = ru[i]; cd[i] = rd[i]; }
        if (c0 + U < HG_NCH) {
#pragma unroll
            for (int i = 0; i < U; ++i) { ru[i] = *(const unsigned*)(UT + (cb + c0 + U + i) * 16384 + v * 128 + k); rd[i] = *(const f32x2*)(DCH + (cb + c0 + U + i) * 128 + k); } }
#pragma unroll
        for (int i = 0; i < U; ++i) { *(unsigned*)(SPT + (cb + c0 + i) * 16384 + v * 128 + k) = pkbf(s0, s1); s0 = cd[i].x * s0 + bflo(cu[i]); s1 = cd[i].y * s1 + bfhi(cu[i]); }
    }
}
__device__ __forceinline__ void hg_p3_unit(const Args& a, unsigned char* ws, int l, int unit, int next, HgRaw& R, LAS unsigned char* lds, int tid_in) {
    int tid = tid_in; asm volatile("" : "+v"(tid));
    const bf16* proj = (const bf16*)(ws + WS_HP); const bf16* SPT = (const bf16*)(ws + WS_HGS); bf16* Y = (bf16*)(ws + WS_Y);
    const int h = unit & 3, chunk = (unit >> 2) & (HG_NCH - 1), b = unit >> 10;
    const int qt = tid >> 7, col = tid & 127, ch = h * 128 + col, lane = tid & 63, wave = tid >> 6, fr = lane & 15, g = lane >> 4;
    LAS bf16* Qm = (LAS bf16*)lds; LAS bf16* Qs = Qm + 64 * HG_RS; LAS bf16* Km = Qs + 64 * HG_RS; LAS bf16* vT = Km + 64 * HG_RS; LAS bf16* PT = vT + 128 * HG_TS;
    LAS float* tots = (LAS float*)(PT + 64 * HG_TS); LAS float* ssq = tots + 512;
    const float lb = hg_lb(a.in[I_LBL], l, ch);
    const size_t rowc = (size_t)b * SEQ + (size_t)chunk * 64, row0 = rowc + 16 * qt;
    bf16x8_t sf[4]; v2u grv[4];
    { const size_t sbase = ((size_t)(b * 4 + h) * HG_NCH + chunk) * 16384 + (size_t)(16 * wave + fr) * 128 + 8 * g;
#pragma unroll
      for (int ks = 0; ks < 4; ++ks) sf[ks] = *(const bf16x8_t*)(SPT + sbase + 32 * ks);
#pragma unroll
      for (int j = 0; j < 4; ++j) grv[j] = *(const v2u*)(proj + (rowc + 16 * j + fr) * NPROJ + PC_AG + h * 128 + 16 * wave + 4 * g); }
    float rr[16], kk[16], qq[16], vv[16];
    { float ff[16];
#pragma unroll
      for (int i = 0; i < 16; ++i) { const float z = bf2f(R.z[i]); vv[i] = bf2f(R.v[i]); qq[i] = siluf_(bf2f(R.q[i]));
          const float sg = sigmoidf_(z); ff[i] = lb + (1.0f - lb) * sg; kk[i] = (1.0f - lb) * (1.0f - sg); }
      float run = 1.0f;
      if (qt < 2) {
#pragma unroll
          for (int i = 15; i >= 0; --i) { rr[i] = run; run *= ff[i]; }
      } else {
#pragma unroll
          for (int i = 0; i < 16; ++i) { run *= ff[i]; rr[i] = run; } }
      tots[qt * 128 + col] = run; }
    if (next >= 0) hg_load<true>(R, ws, next, tid);
    if (tid < 128) { const int which = tid >> 6, t = (which ? 32 : 0) + ((tid & 63) >> 2), sq = (which ? 48 : 16) + 4 * (tid & 3); unsigned z0 = 0u; asm volatile("" : "+v"(z0));     *(LAS v2u*)(PT + t * HG_TS + sq) = (v2u){z0, z0}; }
    __syncthreads();
    const float t0_ = tots[col], t1_ = tots[128 + col], t2_ = tots[256 + col];
    const float em = t0_ * t1_, xq = (qt == 0) ? t1_ : (qt == 3) ? t2_ : 1.0f;
    { unsigned wv[8];
#pragma unroll
      for (int i = 0; i < 16; ++i) { const float rv = fmaxf(rr[i] * xq, 1e-30f), ri = __builtin_amdgcn_rcpf(rv); const int t = 16 * qt + i;
          const float ea = (qt < 2) ? ri : rv, eb = (qt < 2) ? rv : ri;
          Qm[t * HG_RS + col] = (bf16)f2bf(qq[i] * ea); Qs[t * HG_RS + col] = (bf16)f2bf(qq[i] * (em * ea)); Km[t * HG_RS + col] = (bf16)f2bf(kk[i] * eb); }
#pragma unroll
      for (int i = 0; i < 8; ++i) wv[i] = pkbf(vv[2 * i], vv[2 * i + 1]);
      LAS v4u* pv = (LAS v4u*)(vT + col * HG_TS + 16 * qt); pv[0] = (v4u){wv[0], wv[1], wv[2], wv[3]}; pv[1] = (v4u){wv[4], wv[5], wv[6], wv[7]}; }
    __syncthreads();
    for (int tt = wave; tt < 10; tt += 8) {
        int ti, tj; { const int ii[10] = {0, 0, 0, 0, 1, 1, 1, 2, 2, 3}, jj[10] = {0, 1, 2, 3, 1, 2, 3, 2, 3, 3}; ti = ii[0]; tj = jj[0];
#pragma unroll
          for (int q = 1; q < 10; ++q) if (tt == q) { ti = ii[q]; tj = jj[q]; } }
        pg8::f32x4 acc = {0.f, 0.f, 0.f, 0.f};
#pragma unroll
        for (int ks = 0; ks < 4; ++ks) { const bf16x8_t af = *(const LAS bf16x8_t*)(Km + (16 * ti + fr) * HG_RS + 8 * g + 32 * ks), bfr = *(const LAS bf16x8_t*)(Qm + (16 * tj + fr) * HG_RS + 8 * g + 32 * ks);
            acc = __builtin_amdgcn_mfma_f32_16x16x32_bf16(af, bfr, acc, 0, 0, 0); }
        const int t = 16 * tj + fr, s0 = 16 * ti + 4 * g;
#pragma unroll
        for (int r = 0; r < 4; ++r) if (s0 + r > t) acc[r] = 0.f;
        *(LAS v2u*)(PT + t * HG_TS + s0) = (v2u){pkbf(acc[0], acc[1]), pkbf(acc[2], acc[3])};
    }
    __syncthreads();
    pg8::f32x4 o[4];
    { bf16x8_t vf[2];
#pragma unroll
      for (int ks = 0; ks < 2; ++ks) vf[ks] = *(const LAS bf16x8_t*)(vT + (16 * wave + fr) * HG_TS + 8 * g + 32 * ks);
#pragma unroll
      for (int j = 0; j < 4; ++j) { pg8::f32x4 acc = {0.f, 0.f, 0.f, 0.f};
#pragma unroll
          for (int ks = 0; ks < 4; ++ks) { const bf16x8_t bfr = *(const LAS bf16x8_t*)(Qs + (16 * j + fr) * HG_RS + 8 * g + 32 * ks); acc = __builtin_amdgcn_mfma_f32_16x16x32_bf16(sf[ks], bfr, acc, 0, 0, 0); }
#pragma unroll
          for (int ks = 0; ks < 2; ++ks) if (ks == 0 || j >= 2) { const bf16x8_t bfr = *(const LAS bf16x8_t*)(PT + (16 * j + fr) * HG_TS + 8 * g + 32 * ks); acc = __builtin_amdgcn_mfma_f32_16x16x32_bf16(vf[ks], bfr, acc, 0, 0, 0); }
          o[j] = acc; } }
#pragma unroll
    for (int j = 0; j < 4; ++j) { float s = (o[j][0] * o[j][0] + o[j][1] * o[j][1]) + (o[j][2] * o[j][2] + o[j][3] * o[j][3]); s += __shfl_xor(s, 16); s += __shfl_xor(s, 32); if (g == 0) ssq[wave * 64 + 16 * j + fr] = s; }
    __syncthreads();
    { const float* nw = a.in[I_HGN] + l * 512 + h * 128 + 16 * wave + 4 * g; const float w0 = nw[0], w1 = nw[1], w2 = nw[2], w3 = nw[3];
#pragma unroll
      for (int j = 0; j < 4; ++j) { const int t = 16 * j + fr; float s = 0.f;
#pragma unroll
          for (int w = 0; w < 8; ++w) s += ssq[w * 64 + t];
          const float r = 1.0f / sqrtf(s * (1.0f / 128.0f) + NORM_EPS);
          const v2u gr = grv[j];
          const float y0 = o[j][0] * r * w0 * siluf_(bflo(gr.x)), y1 = o[j][1] * r * w1 * siluf_(bfhi(gr.x)), y2 = o[j][2] * r * w2 * siluf_(bflo(gr.y)), y3 = o[j][3] * r * w3 * siluf_(bfhi(gr.y));
          *(v2u*)(Y + (rowc + t) * DM + h * 128 + 16 * wave + 4 * g) = (v2u){pkbf(y0, y1), pkbf(y2, y3)}; } }
    __syncthreads();
}
constexpr int SD_TS = 72, SD_RS = 136;
#define SD_CONV8(dst, tok0) do { _Pragma("unroll") for (int i_ = 0; i_ < 8; ++i_) { const float xn_ = bf2f(xr[(tok0) + i_]); \
        const float y_ = cb + cw0 * xm3 + cw1 * xm2 + cw2 * xm1 + cw3 * xn_; xm3 = xm2; xm2 = xm1; xm1 = xn_; dst[i_] = siluf_(y_); } } while (0)
__device__ __forceinline__ void sd_p1_unit(const Args& a, unsigned char* ws, int l, const rs_t* rowss, int unit, LAS unsigned char* lds, int tid_in) {
    int tid = tid_in; asm volatile("" : "+v"(tid));
    const bf16* proj = (const bf16*)(ws + WS_HP); const bf16* xb = (const bf16*)(ws + WS_XB); const bf16* wdtb = (const bf16*)(ws + WS_WDTB);
    bf16* STATES = (bf16*)(ws + WS_SDST); float* CDEC = (float*)(ws + WS_CDEC); float* DTV = (float*)(ws + WS_DTV);
    const int chunk = unit & 255, b = unit >> 8, lane = tid & 63, wave = tid >> 6, fr = lane & 15, g = lane >> 4;
    const size_t row0 = (size_t)b * SEQ + (size_t)chunk * 64;
    LAS float* dtl = (LAS float*)lds; LAS float* acs = dtl + 512;
    LAS float* part = (LAS float*)(lds + 4096);
    LAS bf16* XT = (LAS bf16*)(lds + 4096); LAS bf16* BT = XT + 512 * SD_TS;
    { pg8::f32x4 acc[4];
#pragma unroll
      for (int tt = 0; tt < 4; ++tt) acc[tt] = (pg8::f32x4){0.f, 0.f, 0.f, 0.f};
#pragma unroll 4
      for (int ks = 0; ks < 8; ++ks) { const int k = 256 * wave + 32 * ks + 8 * g;
          bf16x8_t bfr = {0, 0, 0, 0, 0, 0, 0, 0}; if (fr < 8) bfr = *(const bf16x8_t*)(wdtb + fr * DM + k);
#pragma unroll
          for (int tt = 0; tt < 4; ++tt) { const bf16x8_t af = *(const bf16x8_t*)(xb + (row0 + 16 * tt + fr) * DM + k); acc[tt] = __builtin_amdgcn_mfma_f32_16x16x32_bf16(af, bfr, acc[tt], 0, 0, 0); } }
      if (fr < 8) {
#pragma unroll
          for (int tt = 0; tt < 4; ++tt)
#pragma unroll
              for (int r = 0; r < 4; ++r) part[(wave * 64 + 16 * tt + 4 * g + r) * 8 + fr] = acc[tt][r]; } }
    __syncthreads();
    { const int t = tid >> 3, h = tid & 7; float s = 0.f;
#pragma unroll
      for (int w = 0; w < 8; ++w) s += part[(w * 64 + t) * 8 + h];
      const float r = 1.0f / sqrtf((float)rowss[row0 + t] * (RS_INV / DM) + NORM_EPS);
      const float dt = softplusf_(s * r + a.in[I_SDTB][l * 8 + h]); dtl[t * 8 + h] = dt; DTV[(row0 + t) * 8 + h] = dt; }
    __syncthreads();
    if (tid < 8) { const float An = -__expf(a.in[I_SALOG][l * 8 + tid]); float run = 0.f; for (int t = 0; t < 64; ++t) { run += dtl[t * 8 + tid] * An; acs[t * 8 + tid] = run; }
        CDEC[(size_t)(b * 256 + chunk) * 8 + tid] = __expf(run); }
    __syncthreads();
    { const float* cwp = a.in[I_SCW] + (size_t)l * 4 * 1024; const float* cbp = a.in[I_SCB] + (size_t)l * 1024;
#pragma unroll
      for (int pass = 0; pass < 2; ++pass) { if (pass == 1 && tid >= 256) break;
          const int c = pass * 512 + tid; const float cw0 = cwp[c], cw1 = cwp[1024 + c], cw2 = cwp[2048 + c], cw3 = cwp[3072 + c], cb = cbp[c];
          const bf16* xp = proj + row0 * NPROJ + PC_CX + c;
          float xm3 = 0.f, xm2 = 0.f, xm1 = 0.f; if (chunk > 0) { xm3 = bf2f(xp[-3 * (ptrdiff_t)NPROJ]); xm2 = bf2f(xp[-2 * (ptrdiff_t)NPROJ]); xm1 = bf2f(xp[-(ptrdiff_t)NPROJ]); }
          const int h = tid >> 6; const float al = acs[63 * 8 + h];
          LAS bf16* dst = (pass == 0) ? (XT + tid * SD_TS) : (BT + tid * SD_TS);
          bf16 xr[64];
#pragma unroll
          for (int t = 0; t < 64; ++t) xr[t] = xp[(ptrdiff_t)t * NPROJ];
#pragma unroll
          for (int s8 = 0; s8 < 8; ++s8) { float v[8]; SD_CONV8(v, 8 * s8);
              if (pass == 0) {
#pragma unroll
                  for (int i = 0; i < 8; ++i) { const int s = 8 * s8 + i; v[i] *= dtl[s * 8 + h] * __expf(al - acs[s * 8 + h]); } }
              *(LAS v4u*)(dst + 8 * s8) = (v4u){pkbf(v[0], v[1]), pkbf(v[2], v[3]), pkbf(v[4], v[5]), pkbf(v[6], v[7])}; } } }
    __syncthreads();
    { const int grp = wave >> 2; bf16* sp = STATES + ((size_t)(b * 256 + chunk) * 8 + wave) * 8192;
#pragma unroll 1
      for (int mt = 0; mt < 4; ++mt) { bf16x8_t bfx[2];
#pragma unroll
          for (int ks = 0; ks < 2; ++ks) bfx[ks] = *(const LAS bf16x8_t*)(XT + (wave * 64 + 16 * mt + fr) * SD_TS + 8 * g + 32 * ks);
#pragma unroll
          for (int nt = 0; nt < 8; ++nt) { pg8::f32x4 acc = {0.f, 0.f, 0.f, 0.f};
#pragma unroll
              for (int ks = 0; ks < 2; ++ks) { const bf16x8_t afn = *(const LAS bf16x8_t*)(BT + (grp * 128 + 16 * nt + fr) * SD_TS + 8 * g + 32 * ks); acc = __builtin_amdgcn_mfma_f32_16x16x32_bf16(afn, bfx[ks], acc, 0, 0, 0); }
              *(v2u*)(sp + (16 * mt + fr) * 128 + 16 * nt + 4 * g) = (v2u){pkbf(acc[0], acc[1]), pkbf(acc[2], acc[3])}; } } }
    __syncthreads();
}
__device__ __forceinline__ void sd_p2_item(unsigned char* ws, int item, int tid) {
    const bf16* STATES = (const bf16*)(ws + WS_SDST); const float* CDEC = (const float*)(ws + WS_CDEC); bf16* PREV = (bf16*)(ws + WS_SDPV);
    const int bh = item >> 3, b = bh >> 3, h = bh & 7, p = (item & 7) * 8 + (tid >> 6), n = 2 * (tid & 63);
    typedef float f32x2 __attribute__((ext_vector_type(2)));
    float s0 = 0.f, s1 = 0.f; constexpr int U = 8;
    unsigned ru[U]; float rd[U];
#define SD_IDX(c_) (((size_t)(b * 256 + (c_)) * 8 + h) * 8192 + p * 128 + n)
#pragma unroll
    for (int i = 0; i < U; ++i) { ru[i] = *(const unsigned*)(STATES + SD_IDX(i)); rd[i] = CDEC[(size_t)(b * 256 + i) * 8 + h]; }
    for (int c0 = 0; c0 < 256; c0 += U) {
        unsigned cu[U]; float cd[U];
#pragma unroll
        for (int i = 0; i < U; ++i) { cu[i] = ru[i]; cd[i] = rd[i]; }
        if (c0 + U < 256) {
#pragma unroll
            for (int i = 0; i < U; ++i) { ru[i] = *(const unsigned*)(STATES + SD_IDX(c0 + U + i)); rd[i] = CDEC[(size_t)(b * 256 + c0 + U + i) * 8 + h]; } }
#pragma unroll
        for (int i = 0; i < U; ++i) { *(unsigned*)(PREV + SD_IDX(c0 + i)) = pkbf(s0, s1); s0 = cd[i] * s0 + bflo(cu[i]); s1 = cd[i] * s1 + bfhi(cu[i]); }
    }
#undef SD_IDX
}
__device__ __forceinline__ void sd_p3_unit(const Args& a, unsigned char* ws, int l, int unit, LAS unsigned char* lds, int tid_in) {
    int tid = tid_in; asm volatile("" : "+v"(tid));
    const bf16* proj = (const bf16*)(ws + WS_HP); const bf16* PREV = (const bf16*)(ws + WS_SDPV); const float* DTV = (const float*)(ws + WS_DTV); bf16* Y = (bf16*)(ws + WS_Y);
    const int grp = unit & 1, chunk = (unit >> 1) & 255, b = unit >> 9, lane = tid & 63, wave = tid >> 6, fr = lane & 15, g = lane >> 4;
    const size_t row0 = (size_t)b * SEQ + (size_t)chunk * 64;
    LAS float* dtl = (LAS float*)lds; LAS float* acs = dtl + 256; LAS float* ssq = acs + 256;
    LAS bf16* XT = (LAS bf16*)(lds + 4096); LAS bf16* Brm = XT + 256 * SD_TS; LAS bf16* Crm = Brm + 64 * SD_RS;
    if (tid < 256) { const int t = tid >> 2, hh = tid & 3; dtl[t * 4 + hh] = DTV[(row0 + t) * 8 + 4 * grp + hh]; }
    v2u zrv[2][4];
    { const int hh_ = wave >> 1, half_ = wave & 1;
#pragma unroll
      for (int pt = 0; pt < 2; ++pt) {
#pragma unroll
          for (int j = 0; j < 4; ++j) zrv[pt][j] = *(const v2u*)(proj + (row0 + 16 * j + fr) * NPROJ + PC_CZ + grp * 256 + hh_ * 64 + 16 * (2 * half_ + pt) + 4 * g); } }
    __syncthreads();
    if (tid < 4) { const float An = -__expf(a.in[I_SALOG][l * 8 + 4 * grp + tid]); float run = 0.f; for (int t = 0; t < 64; ++t) { run += dtl[t * 4 + tid] * An; acs[t * 4 + tid] = run; } }
    { const float* cwp = a.in[I_SCW] + (size_t)l * 4 * 1024; const float* cbp = a.in[I_SCB] + (size_t)l * 1024;
      const int c = (tid < 256) ? (grp * 256 + tid) : (tid < 384) ? (512 + grp * 128 + (tid - 256)) : (768 + grp * 128 + (tid - 384));
      const float cw0 = cwp[c], cw1 = cwp[1024 + c], cw2 = cwp[2048 + c], cw3 = cwp[3072 + c], cb = cbp[c];
      const bf16* xp = proj + row0 * NPROJ + PC_CX + c;
      float xm3 = 0.f, xm2 = 0.f, xm1 = 0.f; if (chunk > 0) { xm3 = bf2f(xp[-3 * (ptrdiff_t)NPROJ]); xm2 = bf2f(xp[-2 * (ptrdiff_t)NPROJ]); xm1 = bf2f(xp[-(ptrdiff_t)NPROJ]); }
      bf16 xr[64];
#pragma unroll
      for (int t = 0; t < 64; ++t) xr[t] = xp[(ptrdiff_t)t * NPROJ];
#pragma unroll
      for (int s8 = 0; s8 < 8; ++s8) { float v[8]; SD_CONV8(v, 8 * s8);
          if (tid < 256) *(LAS v4u*)(XT + tid * SD_TS + 8 * s8) = (v4u){pkbf(v[0], v[1]), pkbf(v[2], v[3]), pkbf(v[4], v[5]), pkbf(v[6], v[7])};
          else { LAS bf16* d = ((tid < 384) ? Brm : Crm) + (8 * s8) * SD_RS + ((tid - 256) & 127);
#pragma unroll
              for (int i = 0; i < 8; ++i) d[i * SD_RS] = (bf16)f2bf(v[i]); } } }
    __syncthreads();
    const int hh = wave >> 1, half = wave & 1, hd = 4 * grp + hh;
    bf16x8_t mf[4][2];
    { const float Dk = a.in[I_SD][l * 8 + hd];
      float acl[4], acsv[16], dts[16];
#pragma unroll
      for (int j = 0; j < 4; ++j) acl[j] = acs[(16 * j + fr) * 4 + hh];
#pragma unroll
      for (int i = 0; i < 4; ++i)
#pragma unroll
          for (int r = 0; r < 4; ++r) { acsv[4 * i + r] = acs[(16 * i + 4 * g + r) * 4 + hh]; dts[4 * i + r] = dtl[(16 * i + 4 * g + r) * 4 + hh]; }
#pragma unroll
      for (int j = 0; j < 4; ++j) { unsigned pw[4][2];
#pragma unroll
          for (int i = 0; i < 4; ++i) { pw[i][0] = 0u; pw[i][1] = 0u;
              if (i <= j) { pg8::f32x4 acc = {0.f, 0.f, 0.f, 0.f};
#pragma unroll
                  for (int ks = 0; ks < 4; ++ks) { const bf16x8_t af = *(const LAS bf16x8_t*)(Brm + (16 * i + fr) * SD_RS + 8 * g + 32 * ks), bfr = *(const LAS bf16x8_t*)(Crm + (16 * j + fr) * SD_RS + 8 * g + 32 * ks);
                      acc = __builtin_amdgcn_mfma_f32_16x16x32_bf16(af, bfr, acc, 0, 0, 0); }
                  float m[4];
#pragma unroll
                  for (int r = 0; r < 4; ++r) { const int s = 16 * i + 4 * g + r, ll = 16 * j + fr; float v = acc[r] * __expf(fminf(acl[j] - acsv[4 * i + r], 0.f)) * dts[4 * i + r]; if (s > ll) v = 0.f; if (s == ll) v += Dk; m[r] = v; }
                  pw[i][0] = pkbf(m[0], m[1]); pw[i][1] = pkbf(m[2], m[3]); } }
          mf[j][0] = __builtin_bit_cast(bf16x8_t, (v4u){pw[0][0], pw[0][1], pw[1][0], pw[1][1]}); mf[j][1] = __builtin_bit_cast(bf16x8_t, (v4u){pw[2][0], pw[2][1], pw[3][0], pw[3][1]}); } }
    pg8::f32x4 yv[2][4];
    { const bf16* pv = PREV + ((size_t)(b * 256 + chunk) * 8 + hd) * 8192;
#pragma unroll
      for (int pt = 0; pt < 2; ++pt) { const int prow = 16 * (2 * half + pt) + fr;
          bf16x8_t pf[4];
#pragma unroll
          for (int ks = 0; ks < 4; ++ks) pf[ks] = *(const bf16x8_t*)(pv + prow * 128 + 8 * g + 32 * ks);
          bf16x8_t xf[2];
#pragma unroll
          for (int ks = 0; ks < 2; ++ks) { const v2u lo = *(const LAS v2u*)(XT + (hh * 64 + prow) * SD_TS + 32 * ks + 4 * g), hi = *(const LAS v2u*)(XT + (hh * 64 + prow) * SD_TS + 32 * ks + 16 + 4 * g);
              xf[ks] = __builtin_bit_cast(bf16x8_t, (v4u){lo.x, lo.y, hi.x, hi.y}); }
#pragma unroll
          for (int j = 0; j < 4; ++j) { pg8::f32x4 off = {0.f, 0.f, 0.f, 0.f};
#pragma unroll
              for (int ks = 0; ks < 4; ++ks) { const bf16x8_t bfr = *(const LAS bf16x8_t*)(Crm + (16 * j + fr) * SD_RS + 8 * g + 32 * ks); off = __builtin_amdgcn_mfma_f32_16x16x32_bf16(pf[ks], bfr, off, 0, 0, 0); }
              const float el = __expf(acs[(16 * j + fr) * 4 + hh]);
              pg8::f32x4 acc = off * el;
              acc = __builtin_amdgcn_mfma_f32_16x16x32_bf16(xf[0], mf[j][0], acc, 0, 0, 0);
              if (j >= 2) acc = __builtin_amdgcn_mfma_f32_16x16x32_bf16(xf[1], mf[j][1], acc, 0, 0, 0);
              yv[pt][j] = acc; } } }
    const int cbase = grp * 256 + hh * 64;
#pragma unroll
    for (int j = 0; j < 4; ++j) { const int ll = 16 * j + fr; float s = 0.f;
#pragma unroll
        for (int pt = 0; pt < 2; ++pt) { const v2u zr = zrv[pt][j];
            yv[pt][j][0] *= siluf_(bflo(zr.x)); yv[pt][j][1] *= siluf_(bfhi(zr.x)); yv[pt][j][2] *= siluf_(bflo(zr.y)); yv[pt][j][3] *= siluf_(bfhi(zr.y));
            s += (yv[pt][j][0] * yv[pt][j][0] + yv[pt][j][1] * yv[pt][j][1]) + (yv[pt][j][2] * yv[pt][j][2] + yv[pt][j][3] * yv[pt][j][3]); }
        s += __shfl_xor(s, 16); s += __shfl_xor(s, 32); if (g == 0) ssq[wave * 64 + ll] = s; }
    __syncthreads();
#pragma unroll
    for (int j = 0; j < 4; ++j) { const int ll = 16 * j + fr; float s = 0.f;
#pragma unroll
        for (int w = 0; w < 8; ++w) s += ssq[w * 64 + ll];
        const float r = 1.0f / sqrtf(s * (1.0f / 256.0f) + NORM_EPS);
#pragma unroll
        for (int pt = 0; pt < 2; ++pt) { const int cc = cbase + 16 * (2 * half + pt) + 4 * g; const float* nw = a.in[I_SNORM] + l * 512 + cc;
            *(v2u*)(Y + (row0 + ll) * DM + 1024 + cc) = (v2u){pkbf(yv[pt][j][0] * r * nw[0], yv[pt][j][1] * r * nw[1]), pkbf(yv[pt][j][2] * r * nw[2], yv[pt][j][3] * r * nw[3])}; } }
    __syncthreads();
}
constexpr int LR_RS = 520;
struct LruW { bf16x8_t wa[4][2], wx[4][2]; };
__device__ __forceinline__ void lru_load_w(const Args& a, int l, int wave, int lane, LruW& W) {
    const int fr = lane & 15, g = lane >> 4; const float* wa = a.in[I_LWA] + ((size_t)l * 8 + wave) * 4096; const float* wx = a.in[I_LWX] + ((size_t)l * 8 + wave) * 4096;
#pragma unroll
    for (int nt = 0; nt < 4; ++nt)
#pragma unroll
        for (int ks = 0; ks < 2; ++ks) { unsigned pa[4], px[4];
#pragma unroll
            for (int e = 0; e < 4; ++e) { const int i0 = 32 * ks + 8 * g + 2 * e, j = 16 * nt + fr; pa[e] = pkbf(wa[i0 * 64 + j], wa[(i0 + 1) * 64 + j]); px[e] = pkbf(wx[i0 * 64 + j], wx[(i0 + 1) * 64 + j]); }
            W.wa[nt][ks] = __builtin_bit_cast(bf16x8_t, (v4u){pa[0], pa[1], pa[2], pa[3]}); W.wx[nt][ks] = __builtin_bit_cast(bf16x8_t, (v4u){px[0], px[1], px[2], px[3]}); }
}
template <bool FINAL> __device__ __forceinline__ void lru_unit(const Args& a, unsigned char* ws, int l, int unit, const LruW& W, LAS unsigned char* lds, int tid_in) {
    int tid = tid_in; asm volatile("" : "+v"(tid));
    const bf16* proj = (const bf16*)(ws + WS_HP); float* LRA = (float*)(ws + WS_LRA); float* LRH = (float*)(ws + WS_LRH); const float* LRC = (const float*)(ws + WS_LRC); bf16* Y = (bf16*)(ws + WS_Y);
    const int chunk = unit & 255, b = unit >> 8, lane = tid & 63, wave = tid >> 6, fr = lane & 15, g = lane >> 4;
    const size_t row0 = (size_t)b * SEQ + (size_t)chunk * 64;
    LAS bf16* Xrm = (LAS bf16*)lds; LAS bf16* Hrm = Xrm + 64 * LR_RS; LAS float* ssq = (LAS float*)(lds + 2 * 64 * LR_RS * 2); LAS float* rst = ssq + 512;
    { const int c = tid; const float* cwp = a.in[I_LCW] + (size_t)l * 4 * 512; const float cw0 = cwp[c], cw1 = cwp[512 + c], cw2 = cwp[1024 + c], cw3 = cwp[1536 + c], cb = a.in[I_LCB][l * 512 + c];
      const bf16* xp = proj + row0 * NPROJ + PC_DX + c;
      float xm3 = 0.f, xm2 = 0.f, xm1 = 0.f; if (chunk > 0) { xm3 = bf2f(xp[-3 * (ptrdiff_t)NPROJ]); xm2 = bf2f(xp[-2 * (ptrdiff_t)NPROJ]); xm1 = bf2f(xp[-(ptrdiff_t)NPROJ]); }
      bf16 xr[64];
#pragma unroll
      for (int t = 0; t < 64; ++t) xr[t] = xp[(ptrdiff_t)t * NPROJ];
#pragma unroll
      for (int t = 0; t < 64; ++t) { const float xn = bf2f(xr[t]); const float y = cb + cw0 * xm3 + cw1 * xm2 + cw2 * xm1 + cw3 * xn; xm3 = xm2; xm2 = xm1; xm1 = xn; Xrm[t * LR_RS + c] = (bf16)f2bf(y); } }
    __syncthreads();
    float ssp[4][4];
#pragma unroll
    for (int mt = 0; mt < 4; ++mt)
#pragma unroll
        for (int r = 0; r < 4; ++r) ssp[mt][r] = 0.f;
#pragma unroll
    for (int nt = 0; nt < 4; ++nt) {
        const int c = wave * 64 + 16 * nt + fr;
        const float ba = a.in[I_LBA][l * 512 + c], bx = a.in[I_LBX][l * 512 + c], spn = softplusf_(-a.in[I_LAP][l * 512 + c]);
        float av[4][4], bv[4][4]; const float carry0 = FINAL ? LRC[((size_t)b * 256 + chunk) * 512 + c] : 0.f;
#pragma unroll
        for (int mt = 0; mt < 4; ++mt) { pg8::f32x4 ra = {0.f, 0.f, 0.f, 0.f}, ri = {0.f, 0.f, 0.f, 0.f};
#pragma unroll
            for (int ks = 0; ks < 2; ++ks) { const bf16x8_t af = *(const LAS bf16x8_t*)(Xrm + (16 * mt + fr) * LR_RS + wave * 64 + 32 * ks + 8 * g);
                ra = __builtin_amdgcn_mfma_f32_16x16x32_bf16(af, W.wa[nt][ks], ra, 0, 0, 0); ri = __builtin_amdgcn_mfma_f32_16x16x32_bf16(af, W.wx[nt][ks], ri, 0, 0, 0); }
#pragma unroll
            for (int r = 0; r < 4; ++r) { const float rg = sigmoidf_(ra[r] + ba), ig = sigmoidf_(ri[r] + bx), la = -8.0f * rg * spn, xc = bf2f(Xrm[(16 * mt + 4 * g + r) * LR_RS + c]);
                const float x2 = 2.0f * la, em = (x2 > -0.25f) ? -x2 * (1.0f + x2 * (0.5f + x2 * (0.16666667f + x2 * (0.041666668f + x2 * 0.0083333338f)))) : 1.0f - __expf(x2);
                av[mt][r] = __expf(la); bv[mt][r] = __builtin_amdgcn_sqrtf(fmaxf(em, 0.f)) * (ig * xc); } }
        float carry = carry0, atot = 1.f;
#pragma unroll
        for (int mt = 0; mt < 4; ++mt) {
            float As = av[mt][0], Hs = bv[mt][0];
#pragma unroll
            for (int r = 1; r < 4; ++r) { Hs = av[mt][r] * Hs + bv[mt][r]; As *= av[mt][r]; }
            float Ai = As, Hi = Hs;
            { const float Ap = __shfl_up(Ai, 16), Hp = __shfl_up(Hi, 16); if (g >= 1) { Hi = Ai * Hp + Hi; Ai = Ai * Ap; } }
            { const float Ap = __shfl_up(Ai, 32), Hp = __shfl_up(Hi, 32); if (g >= 2) { Hi = Ai * Hp + Hi; Ai = Ai * Ap; } }
            float Ae = __shfl_up(Ai, 16), He = __shfl_up(Hi, 16); if (g == 0) { Ae = 1.f; He = 0.f; }
            const float At = __shfl(Ai, fr + 48), Ht = __shfl(Hi, fr + 48);
            if (FINAL) { float hc = Ae * carry + He;
#pragma unroll
                for (int r = 0; r < 4; ++r) { hc = av[mt][r] * hc + bv[mt][r]; const float gt = bf2f(proj[(row0 + 16 * mt + 4 * g + r) * NPROJ + PC_DG + c]); const float u2 = 1.5957691216057308f * (gt + 0.044715f * gt * gt * gt); const float o = hc * gt * sigmoidf_(u2);
                    Hrm[(16 * mt + 4 * g + r) * LR_RS + c] = (bf16)f2bf(o); ssp[mt][r] += o * o; } }
            carry = At * carry + Ht; atot *= At;
        }
        if (!FINAL && g == 0) { LRA[((size_t)b * 256 + chunk) * 512 + c] = atot; LRH[((size_t)b * 256 + chunk) * 512 + c] = carry; }
        asm volatile("" ::: "memory");
    }
    if (FINAL) {
#pragma unroll
        for (int mt = 0; mt < 4; ++mt)
#pragma unroll
            for (int r = 0; r < 4; ++r) { float s = ssp[mt][r]; s += __shfl_xor(s, 1); s += __shfl_xor(s, 2); s += __shfl_xor(s, 4); s += __shfl_xor(s, 8); if (fr == 0) ssq[wave * 64 + 16 * mt + 4 * g + r] = s; }
        __syncthreads();
        if (tid < 64) { float s = 0.f;
#pragma unroll
            for (int w = 0; w < 8; ++w) s += ssq[w * 64 + tid];
            rst[tid] = 1.0f / sqrtf(s * (1.0f / 512.0f) + NORM_EPS); }
        __syncthreads();
        { const float* nw = a.in[I_LNORM] + l * 512;
#pragma unroll
          for (int i = 0; i < 8; ++i) { const int item = tid + NTHR * i, t = item >> 6, cg = (item & 63) * 8; const float rs = rst[t]; const v4u hv = *(const LAS v4u*)(Hrm + t * LR_RS + cg);
              const f32x4 w0 = *(const f32x4*)(nw + cg), w1 = *(const f32x4*)(nw + cg + 4);
              v4u o; o.x = pkbf(bflo(hv.x) * rs * w0.x, bfhi(hv.x) * rs * w0.y); o.y = pkbf(bflo(hv.y) * rs * w0.z, bfhi(hv.y) * rs * w0.w); o.z = pkbf(bflo(hv.z) * rs * w1.x, bfhi(hv.z) * rs * w1.y); o.w = pkbf(bflo(hv.w) * rs * w1.z, bfhi(hv.w) * rs * w1.w);
              *(v4u*)(Y + (row0 + t) * DM + 1536 + cg) = o; } }
    }
    __syncthreads();
}
__device__ __forceinline__ void lru_p2_item(unsigned char* ws, int item, int tid) {
    const float* LRA = (const float*)(ws + WS_LRA); const float* LRH = (const float*)(ws + WS_LRH); float* LRC = (float*)(ws + WS_LRC);
    const int idx = item * NTHR + tid, b = idx >> 9, c = idx & 511; const size_t base = (size_t)b * 256 * 512 + c;
    float hh = 0.f; constexpr int U = 16;
    float ra[U], rb[U];
#pragma unroll
    for (int i = 0; i < U; ++i) { ra[i] = LRA[base + (size_t)i * 512]; rb[i] = LRH[base + (size_t)i * 512]; }
    for (int k0 = 0; k0 < 256; k0 += U) {
        float ca[U], cbv[U];
#pragma unroll
        for (int i = 0; i < U; ++i) { ca[i] = ra[i]; cbv[i] = rb[i]; }
        if (k0 + U < 256) {
#pragma unroll
            for (int i = 0; i < U; ++i) { ra[i] = LRA[base + (size_t)(k0 + U + i) * 512]; rb[i] = LRH[base + (size_t)(k0 + U + i) * 512]; } }
#pragma unroll
        for (int i = 0; i < U; ++i) { LRC[base + (size_t)(k0 + i) * 512] = hh; hh = ca[i] * hh + cbv[i]; }
    }
}
typedef short v4i16_t __attribute__((ext_vector_type(4)));
constexpr float AT_DEFER = 8.0f;
constexpr int AT_VS = 72;
template <int KIND> struct AtCfg;
template <> struct AtCfg<0> { static constexpr int NSTEP = 5; };
template <> struct AtCfg<1> { static constexpr int NSTEP = 6 + 5; };
template <int KIND> __device__ __forceinline__ void at_pat(int gs, int& dsh, int& qsh, int& kk0) {
    if (KIND == 0) { dsh = 0; qsh = 0; kk0 = 32 * gs; }
    else { const bool p2 = gs >= 6; dsh = p2 ? 4 : 2; qsh = p2 ? 0 : 2; kk0 = 32 * (p2 ? gs - 6 : gs); }
}
struct AtLoad { bf16x8_t kf[2][2]; v4u vr[4]; };
template <int KIND> __device__ __forceinline__ void at_issue(AtLoad& L, const bf16* proj, size_t rowb, int tb0, int head, int gs, int lane) {
    const int fr = lane & 15, g = lane >> 4; int dsh, qsh, kk0; at_pat<KIND>(gs, dsh, qsh, kk0);
    const char* pb = (const char*)proj; const unsigned rb = (unsigned)rowb;
#pragma unroll
    for (int t2 = 0; t2 < 2; ++t2) { int pos = tb0 + (kk0 + 16 * t2 + fr - 128) * (1 << dsh); pos = max(0, min(pos, SEQ - 1)); const unsigned off = (rb + (unsigned)pos) * (unsigned)(NPROJ * 2) + (unsigned)((PC_BK + head * 64 + 8 * g) * 2);
#pragma unroll
        for (int ks = 0; ks < 2; ++ks) L.kf[t2][ks] = *(const bf16x8_t*)(pb + off + 64 * ks); }
#pragma unroll
    for (int i = 0; i < 4; ++i) { int pos = tb0 + (kk0 + 8 * i + (lane >> 3) - 128) * (1 << dsh); pos = max(0, min(pos, SEQ - 1));
        L.vr[i] = *(const v4u*)(pb + (rb + (unsigned)pos) * (unsigned)(NPROJ * 2) + (unsigned)((PC_BV + head * 64 + 8 * (lane & 7)) * 2)); }
}
template <int KIND> struct AtHead { v4u q[2]; v2u pao[4]; f32x2_t ml; };
template <int KIND> __device__ __forceinline__ void at_unit_pos(int unit, size_t& rowb, int& tb0) { rowb = (size_t)(unit >> 10) * SEQ; tb0 = (KIND == 0) ? 16 * (unit & 1023) : ((unit >> 4) & 63) * 256 + (unit & 15); }
template <int KIND> __device__ __forceinline__ void at_head_load(AtHead<KIND>& H, unsigned char* ws, size_t rowb, int tb0, int head, int lane) {
    const bf16* proj = (const bf16*)(ws + WS_HP); const int fr = lane & 15, g = lane >> 4; const size_t qrow = rowb + tb0 + ((KIND == 0) ? fr : 16 * fr);
    const bf16* qp = proj + qrow * NPROJ + PC_BQ + head * 64 + 8 * g; H.q[0] = *(const v4u*)qp; H.q[1] = *(const v4u*)(qp + 32);
    if (KIND == 1) { const bf16* PAO = (const bf16*)(ws + WS_PAO); const float* PAM = (const float*)(ws + WS_PAM);
#pragma unroll
        for (int dt = 0; dt < 4; ++dt) H.pao[dt] = *(const v2u*)(PAO + qrow * 512 + head * 64 + 16 * dt + 4 * g);
        H.ml = *(const f32x2_t*)(PAM + (qrow * 8 + head) * 2); }
}
template <int KIND> __device__ __forceinline__ void attn_pass(const Args& a, unsigned char* ws, int l, int vcu, int G, LAS unsigned char* lds, int tid) {
    constexpr int NSTEP = AtCfg<KIND>::NSTEP, NUNIT = 2048; static_assert(NSTEP % 3 == 2, "loop shape");
    const bf16* proj = (const bf16*)(ws + WS_HP); bf16* Y = (bf16*)(ws + WS_Y); bf16* PAO = (bf16*)(ws + WS_PAO); float* PAM = (float*)(ws + WS_PAM);
    const int lane = tid & 63, head = tid >> 6, fr = lane & 15, g = lane >> 4;
    LAS bf16* Vb = (LAS bf16*)(lds + head * (32 * AT_VS * 2)); LAS float* ssq = (LAS float*)(lds + 8 * 32 * AT_VS * 2);
    int unit = vcu; if (unit >= NUNIT) return;
    size_t rowb; int tb0; at_unit_pos<KIND>(unit, rowb, tb0);
    AtHead<KIND> H; at_head_load<KIND>(H, ws, rowb, tb0, head, lane);
    AtLoad c0, c1, c2; at_issue<KIND>(c0, proj, rowb, tb0, head, 0, lane); at_issue<KIND>(c1, proj, rowb, tb0, head, 1, lane); c2 = c0;
#pragma unroll 1
    for (;;) {
        const int nunit = unit + G; const bool has_next = nunit < NUNIT; size_t rowb_n = rowb; int tb0_n = tb0; if (has_next) at_unit_pos<KIND>(nunit, rowb_n, tb0_n);
        const size_t qrow = rowb + tb0 + ((KIND == 0) ? fr : 16 * fr);
        bf16x8_t qf[2]; constexpr float QS = 0.125f * 1.4426950408889634f;
#pragma unroll
        for (int ks = 0; ks < 2; ++ks) { const v4u u = H.q[ks];
            qf[ks] = __builtin_bit_cast(bf16x8_t, (v4u){pkbf(bflo(u.x) * QS, bfhi(u.x) * QS), pkbf(bflo(u.y) * QS, bfhi(u.y) * QS), pkbf(bflo(u.z) * QS, bfhi(u.z) * QS), pkbf(bflo(u.w) * QS, bfhi(u.w) * QS)}); }
        v2u pao[4]; float pam = 0.f, pal = 0.f;
        if (KIND == 1) {
#pragma unroll
            for (int dt = 0; dt < 4; ++dt) pao[dt] = H.pao[dt];
            pam = H.ml.x; pal = H.ml.y; }
        pg8::f32x4 o[4];
#pragma unroll
        for (int dt = 0; dt < 4; ++dt) o[dt] = (pg8::f32x4){0.f, 0.f, 0.f, 0.f};
        float mrun = -1e30f, lsum = 0.f;
#define AT_STEP(gs, CUR_, TGT_) do { if ((gs) + 2 < NSTEP) at_issue<KIND>(TGT_, proj, rowb, tb0, head, (gs) + 2, lane); else if (has_next) at_issue<KIND>(TGT_, proj, rowb_n, tb0_n, head, (gs) + 2 - NSTEP, lane); \
        int dsh, qsh, kk0; at_pat<KIND>(gs, dsh, qsh, kk0); \
        const int qlo = fr << qsh, klo = max(qlo, 128 - (tb0 >> dsh)); const unsigned kspan = (unsigned)(qlo + 128 - klo); \
        _Pragma("unroll") \
        for (int i = 0; i < 4; ++i) *(LAS v4u*)(Vb + (8 * i + (lane >> 3)) * AT_VS + 8 * (lane & 7)) = CUR_.vr[i]; \
        pg8::f32x4 st[2]; \
        _Pragma("unroll") \
        for (int t2 = 0; t2 < 2; ++t2) { pg8::f32x4 acc = {0.f, 0.f, 0.f, 0.f}; acc = __builtin_amdgcn_mfma_f32_16x16x32_bf16(CUR_.kf[t2][0], qf[0], acc, 0, 0, 0); acc = __builtin_amdgcn_mfma_f32_16x16x32_bf16(CUR_.kf[t2][1], qf[1], acc, 0, 0, 0); st[t2] = acc; } \
        bool val[2][4]; float mx = -1e30f; \
        _Pragma("unroll") \
        for (int t2 = 0; t2 < 2; ++t2) \
        _Pragma("unroll") \
            for (int r = 0; r < 4; ++r) { const int kk = kk0 + 16 * t2 + 4 * g + r; val[t2][r] = (unsigned)(kk - klo) <= kspan; if (val[t2][r]) mx = fmaxf(mx, st[t2][r]); } \
        if (__builtin_amdgcn_ballot_w64(mx > mrun + AT_DEFER) != 0ull) {       \
            mx = fmaxf(mx, __shfl_xor(mx, 16)); mx = fmaxf(mx, __shfl_xor(mx, 32)); \
            const float mn_ = fmaxf(mrun, mx), corr = __builtin_amdgcn_exp2f(mrun - mn_); mrun = mn_; lsum *= corr; \
            _Pragma("unroll") \
            for (int dt = 0; dt < 4; ++dt) o[dt] = o[dt] * corr; } \
        const float mn = mrun; \
        float p[2][4], ps = 0.f; \
        _Pragma("unroll") \
        for (int t2 = 0; t2 < 2; ++t2) \
        _Pragma("unroll") \
            for (int r = 0; r < 4; ++r) { p[t2][r] = val[t2][r] ? __builtin_amdgcn_exp2f(st[t2][r] - mn) : 0.f; ps += p[t2][r]; } \
        lsum += ps; \
        const bf16x8_t pf = __builtin_bit_cast(bf16x8_t, (v4u){pkbf(p[0][0], p[0][1]), pkbf(p[0][2], p[0][3]), pkbf(p[1][0], p[1][1]), pkbf(p[1][2], p[1][3])}); \
        { const int qq = fr >> 2, pp = fr & 3; \
        _Pragma("unroll") \
          for (int dt = 0; dt < 4; ++dt) { const v4i16_t lo = __builtin_amdgcn_ds_read_tr16_b64_v4i16((LAS v4i16_t*)(Vb + (4 * g + qq) * AT_VS + 16 * dt + 4 * pp)), hi = __builtin_amdgcn_ds_read_tr16_b64_v4i16((LAS v4i16_t*)(Vb + (16 + 4 * g + qq) * AT_VS + 16 * dt + 4 * pp)); \
              const bf16x8_t vf = {lo[0], lo[1], lo[2], lo[3], hi[0], hi[1], hi[2], hi[3]}; \
              o[dt] = __builtin_amdgcn_mfma_f32_16x16x32_bf16(vf, pf, o[dt], 0, 0, 0); } } \
    } while (0)
#pragma unroll 1
        for (int gs = 0; gs + 2 < NSTEP; gs += 3) { AT_STEP((gs), c0, c2); AT_STEP((gs + 1), c1, c0); AT_STEP((gs + 2), c2, c1); }
        if (has_next) at_head_load<KIND>(H, ws, rowb_n, tb0_n, head, lane);
        AT_STEP((NSTEP - 2), c0, c2); AT_STEP((NSTEP - 1), c1, c0);
#undef AT_STEP
        lsum += __shfl_xor(lsum, 16); lsum += __shfl_xor(lsum, 32);
        if (KIND == 0) {
#pragma unroll
            for (int dt = 0; dt < 4; ++dt) *(v2u*)(PAO + qrow * 512 + head * 64 + 16 * dt + 4 * g) = (v2u){pkbf(o[dt][0], o[dt][1]), pkbf(o[dt][2], o[dt][3])};
            if (g == 0) *(f32x2_t*)(PAM + (qrow * 8 + head) * 2) = (f32x2_t){mrun, lsum};
        } else {
            const float mm = fmaxf(mrun, pam), fa = __builtin_amdgcn_exp2f(pam - mm), fb = __builtin_amdgcn_exp2f(mrun - mm), inv = 1.0f / (pal * fa + lsum * fb); float ss = 0.f;
#pragma unroll
            for (int dt = 0; dt < 4; ++dt) { const pg8::f32x4 oa = {bflo(pao[dt].x), bfhi(pao[dt].x), bflo(pao[dt].y), bfhi(pao[dt].y)}; o[dt] = (oa * fa + o[dt] * fb) * inv;
                ss += (o[dt][0] * o[dt][0] + o[dt][1] * o[dt][1]) + (o[dt][2] * o[dt][2] + o[dt][3] * o[dt][3]); }
            ss += __shfl_xor(ss, 16); ss += __shfl_xor(ss, 32);
            __syncthreads();
            if (g == 0) ssq[head * 16 + fr] = ss;
            __syncthreads();
            { float s = 0.f;
#pragma unroll
              for (int w = 0; w < 8; ++w) s += ssq[w * 16 + fr];
              const float rs = 1.0f / sqrtf(s * (1.0f / 512.0f) + NORM_EPS); const float* nw = a.in[I_ATN] + l * 512 + head * 64;
#pragma unroll
              for (int dt = 0; dt < 4; ++dt) { const int dd = 16 * dt + 4 * g;
                  *(v2u*)(Y + qrow * DM + 512 + head * 64 + dd) = (v2u){pkbf(o[dt][0] * rs * nw[dd], o[dt][1] * rs * nw[dd + 1]), pkbf(o[dt][2] * rs * nw[dd + 2], o[dt][3] * rs * nw[dd + 3])}; } }
        }
        if (!has_next) break;
        { const AtLoad t = c0; c0 = c2; c1 = t; }
        unit = nunit; rowb = rowb_n; tb0 = tb0_n;
    }
    __syncthreads();
}
__device__ __forceinline__ void m2_hgrn(const Args& a, unsigned char* ws, int l, int w, LAS unsigned char* lds, int tid) {
    const bf16* proj = (const bf16*)(ws + WS_HP); float* OA = (float*)(ws + WS_OA);
    const int b = w >> 2, h = w & 3, v = tid >> 2, kq = tid & 3;
    constexpr int TB = 16, RS = 144;
    LAS float* fs = (LAS float*)lds; LAS float* ks = fs + TB * RS; LAS float* qs = ks + TB * RS; LAS float* vs = qs + TB * RS;
    const int kl = tid & 127, ch = h * 128 + kl;
    float lb = 0.f;
    { const float* lg = a.in[I_LBL]; float mx = lg[ch]; for (int i = 1; i < DEPTH; ++i) mx = fmaxf(mx, lg[i * 512 + ch]); float den = 0.f, num = 0.f;
      for (int i = 0; i < DEPTH; ++i) { const float e = __expf(lg[i * 512 + ch] - mx); den += e; if (i >= 1 && i <= l) num += e; } lb = num / den; }
    float S[32];
#pragma unroll
    for (int j = 0; j < 32; ++j) S[j] = 0.f;
    const size_t rowb = (size_t)b * SEQ;
    bf16 rq[4], rf[4], ri[4];
#define HG_LDBATCH(t0_) do { _Pragma("unroll") for (int i = 0; i < 4; ++i) { const int s_ = (tid >> 7) + 4 * i; const bf16* p_ = proj + (rowb + (t0_) + s_) * NPROJ + ch; rq[i] = p_[PC_AQ]; rf[i] = p_[PC_AF]; ri[i] = p_[PC_AI]; } } while (0)
    HG_LDBATCH(0);
    for (int t0 = 0; t0 < SEQ; t0 += TB) {
#pragma unroll
        for (int i = 0; i < 4; ++i) { const int s = (tid >> 7) + 4 * i; const int kp = kl + 4 * (kl >> 5);
            const float sg = sigmoidf_(bf2f(rf[i])); fs[s * RS + kp] = lb + (1.0f - lb) * sg; ks[s * RS + kp] = (1.0f - lb) * (1.0f - sg); qs[s * RS + kp] = siluf_(bf2f(rq[i])); vs[s * 128 + kl] = bf2f(ri[i]); }
        __syncthreads();
        if (t0 + TB < SEQ) HG_LDBATCH(t0 + TB);
        for (int s = 0; s < TB; ++s) {
            const float vv = vs[s * 128 + v]; float part = 0.f; const int kb = 36 * kq;
#pragma unroll
            for (int j4 = 0; j4 < 8; ++j4) { const f32x4 f4 = *(const LAS f32x4*)(fs + s * RS + kb + 4 * j4), k4 = *(const LAS f32x4*)(ks + s * RS + kb + 4 * j4), q4 = *(const LAS f32x4*)(qs + s * RS + kb + 4 * j4);
#pragma unroll
                for (int jj = 0; jj < 4; ++jj) { const int j = 4 * j4 + jj; S[j] = f4[jj] * S[j] + k4[jj] * vv; part += S[j] * q4[jj]; } }
            part += __shfl_xor(part, 1); part += __shfl_xor(part, 2);
            if (kq == 0) OA[(rowb + t0 + s) * 512 + h * 128 + v] = part;
        }
        __syncthreads();
    }
}
__device__ __forceinline__ void m2_ssd(const Args& a, unsigned char* ws, int l, int w, LAS unsigned char* lds, int tid) {
    const float* xbcc = (const float*)(ws + WS_XBCC); const float* dtv = (const float*)(ws + WS_DTV); float* OC = (float*)(ws + WS_OC);
    const int b = w >> 3, h = w & 7, g = h >> 2, p = tid >> 3, ns = tid & 7;
    constexpr int TB = 16, RS = 160;
    LAS float* Bs = (LAS float*)lds; LAS float* Cs = Bs + TB * RS; LAS float* xs = Cs + TB * RS; LAS float* dts = xs + TB * 64;
    const float Aneg = -__expf(a.in[I_SALOG][l * 8 + h]), Dk = a.in[I_SD][l * 8 + h];
    float hs[16];
#pragma unroll
    for (int j = 0; j < 16; ++j) hs[j] = 0.f;
    const size_t rowb = (size_t)b * SEQ;
    float rB[4], rC[4], rx[2], rdt = 0.f;
    const int nl = tid & 127, pl = tid & 63;
#define SSD_LDBATCH(t0_) do { _Pragma("unroll") for (int i = 0; i < 4; ++i) { const int s_ = (tid >> 7) + 4 * i; const float* q_ = xbcc + (rowb + (t0_) + s_) * 1024; rB[i] = q_[512 + g * 128 + nl]; rC[i] = q_[768 + g * 128 + nl]; } \
        _Pragma("unroll") for (int i = 0; i < 2; ++i) { const int s_ = (tid >> 6) + 8 * i; rx[i] = xbcc[(rowb + (t0_) + s_) * 1024 + h * 64 + pl]; } \
        if (tid < TB) rdt = dtv[(rowb + (t0_) + tid) * 8 + h]; } while (0)
    SSD_LDBATCH(0);
    for (int t0 = 0; t0 < SEQ; t0 += TB) {
#pragma unroll
        for (int i = 0; i < 4; ++i) { const int s = (tid >> 7) + 4 * i; const int np = nl + 4 * (nl >> 4); Bs[s * RS + np] = rB[i]; Cs[s * RS + np] = rC[i]; }
#pragma unroll
        for (int i = 0; i < 2; ++i) { const int s = (tid >> 6) + 8 * i; xs[s * 64 + pl] = rx[i]; }
        if (tid < TB) dts[tid] = rdt;
        __syncthreads();
        if (t0 + TB < SEQ) SSD_LDBATCH(t0 + TB);
        for (int s = 0; s < TB; ++s) {
            const float dt = dts[s], dA = __expf(dt * Aneg), xv = xs[s * 64 + p], xdt = xv * dt; float part = 0.f; const int nb = 20 * ns;
#pragma unroll
            for (int j4 = 0; j4 < 4; ++j4) { const f32x4 b4 = *(const LAS f32x4*)(Bs + s * RS + nb + 4 * j4), c4 = *(const LAS f32x4*)(Cs + s * RS + nb + 4 * j4);
#pragma unroll
                for (int jj = 0; jj < 4; ++jj) { const int j = 4 * j4 + jj; hs[j] = dA * hs[j] + b4[jj] * xdt; part += c4[jj] * hs[j]; } }
            part += __shfl_xor(part, 1); part += __shfl_xor(part, 2); part += __shfl_xor(part, 4);
            if (ns == 0) OC[(rowb + t0 + s) * 512 + h * 64 + p] = part + Dk * xv;
        }
        __syncthreads();
    }
}
__device__ __forceinline__ void m2_lru(const Args& a, unsigned char* ws, int w, int tid) {
    const float* LA = (const float*)(ws + WS_LA); const float* LB = (const float*)(ws + WS_LB); float* OD = (float*)(ws + WS_OD);
    const int idx = w * NTHR + tid, b = idx >> 9, c = idx & 511; const size_t base = (size_t)b * SEQ * 512 + c;
    float hh = 0.f; constexpr int U = 16;
    float ra[U], rb[U];
#pragma unroll
    for (int i = 0; i < U; ++i) { ra[i] = LA[base + (size_t)i * 512]; rb[i] = LB[base + (size_t)i * 512]; }
    for (int t0 = 0; t0 < SEQ; t0 += U) {
        float ca[U], cbv[U];
#pragma unroll
        for (int i = 0; i < U; ++i) { ca[i] = ra[i]; cbv[i] = rb[i]; }
        if (t0 + U < SEQ) {
#pragma unroll
            for (int i = 0; i < U; ++i) { ra[i] = LA[base + (size_t)(t0 + U + i) * 512]; rb[i] = LB[base + (size_t)(t0 + U + i) * 512]; } }
#pragma unroll
        for (int i = 0; i < U; ++i) { hh = ca[i] * hh + cbv[i]; OD[base + (size_t)(t0 + i) * 512] = hh; }
    }
}
__device__ __forceinline__ void m2_attn(const Args& a, unsigned char* ws, int item, int tid) {
    const bf16* proj = (const bf16*)(ws + WS_HP); float* OB = (float*)(ws + WS_OB);
    const int head = item & 7, blk = item >> 3, t = blk * NTHR + tid, tb = t & (SEQ - 1); const size_t rowb = (size_t)(t - tb);
    float q[64], acc[64];
    { const v4u* qp = (const v4u*)(proj + (size_t)t * NPROJ + PC_BQ + head * 64);
#pragma unroll
      for (int i = 0; i < 8; ++i) { const v4u u = qp[i]; q[8 * i + 0] = bflo(u.x) * 0.125f; q[8 * i + 1] = bfhi(u.x) * 0.125f; q[8 * i + 2] = bflo(u.y) * 0.125f; q[8 * i + 3] = bfhi(u.y) * 0.125f;
          q[8 * i + 4] = bflo(u.z) * 0.125f; q[8 * i + 5] = bfhi(u.z) * 0.125f; q[8 * i + 6] = bflo(u.w) * 0.125f; q[8 * i + 7] = bfhi(u.w) * 0.125f; } }
#pragma unroll
    for (int d = 0; d < 64; ++d) acc[d] = 0.f;
    float mrun = -1e30f, lrun = 0.f;
    for (int pat = 0; pat < 3; ++pat) { const int dil = (pat == 0) ? 1 : (pat == 1) ? 4 : 16;
        for (int j = 0; j <= 128; ++j) { const int pos = tb - j * dil;
            if (pos >= 0) {
                const v4u* kp = (const v4u*)(proj + (rowb + pos) * NPROJ + PC_BK + head * 64); const v4u* vp = (const v4u*)(proj + (rowb + pos) * NPROJ + PC_BV + head * 64);
                float s = 0.f;
#pragma unroll
                for (int i = 0; i < 8; ++i) { const v4u u = kp[i]; s += (q[8 * i] * bflo(u.x) + q[8 * i + 1] * bfhi(u.x)) + (q[8 * i + 2] * bflo(u.y) + q[8 * i + 3] * bfhi(u.y))
                        + (q[8 * i + 4] * bflo(u.z) + q[8 * i + 5] * bfhi(u.z)) + (q[8 * i + 6] * bflo(u.w) + q[8 * i + 7] * bfhi(u.w)); }
                const float mn = fmaxf(mrun, s), corr = __expf(mrun - mn), pr = __expf(s - mn); lrun = lrun * corr + pr; mrun = mn;
#pragma unroll
                for (int i = 0; i < 8; ++i) { const v4u u = vp[i];
                    acc[8 * i + 0] = acc[8 * i + 0] * corr + pr * bflo(u.x); acc[8 * i + 1] = acc[8 * i + 1] * corr + pr * bfhi(u.x); acc[8 * i + 2] = acc[8 * i + 2] * corr + pr * bflo(u.y); acc[8 * i + 3] = acc[8 * i + 3] * corr + pr * bfhi(u.y);
                    acc[8 * i + 4] = acc[8 * i + 4] * corr + pr * bflo(u.z); acc[8 * i + 5] = acc[8 * i + 5] * corr + pr * bfhi(u.z); acc[8 * i + 6] = acc[8 * i + 6] * corr + pr * bflo(u.w); acc[8 * i + 7] = acc[8 * i + 7] * corr + pr * bfhi(u.w); }
            } } }
    const float inv = 1.0f / lrun; float* o = OB + (size_t)t * 512 + head * 64;
#pragma unroll
    for (int i = 0; i < 16; ++i) *(f32x4*)(o + 4 * i) = (f32x4){acc[4 * i] * inv, acc[4 * i + 1] * inv, acc[4 * i + 2] * inv, acc[4 * i + 3] * inv};
}
__device__ __forceinline__ void hg_p2_item4(unsigned char* ws, int item, int t) {
    const bf16* UT = (const bf16*)(ws + WS_HGU); const float* DCH = (const float*)(ws + WS_HGD); bf16* SPT = (bf16*)(ws + WS_HGS);
    const int bh = item >> 4, v = (item & 15) * 8 + (t >> 5), k = 4 * (t & 31); const size_t cb = (size_t)bh * HG_NCH;
    f32x4 s = {0.f, 0.f, 0.f, 0.f}; constexpr int U = 8; v2u ru[U]; f32x4 rd[U];
#pragma unroll
    for (int i = 0; i < U; ++i) { ru[i] = *(const v2u*)(UT + (cb + i) * 16384 + v * 128 + k); rd[i] = *(const f32x4*)(DCH + (cb + i) * 128 + k); }
    for (int c0 = 0; c0 < HG_NCH; c0 += U) {
        v2u cu[U]; f32x4 cd[U];
#pragma unroll
        for (int i = 0; i < U; ++i) { cu[i] = ru[i]; cd[i] = rd[i]; }
        if (c0 + U < HG_NCH) {
#pragma unroll
            for (int i = 0; i < U; ++i) { ru[i] = *(const v2u*)(UT + (cb + c0 + U + i) * 16384 + v * 128 + k); rd[i] = *(const f32x4*)(DCH + (cb + c0 + U + i) * 128 + k); } }
#pragma unroll
        for (int i = 0; i < U; ++i) { *(v2u*)(SPT + (cb + c0 + i) * 16384 + v * 128 + k) = (v2u){pk2(s.x, s.y), pk2(s.z, s.w)};
            s = cd[i] * s + (f32x4){bflo(cu[i].x), bfhi(cu[i].x), bflo(cu[i].y), bfhi(cu[i].y)}; }
    }
}
__device__ __forceinline__ void sd_p2_item4(unsigned char* ws, int item, int t) {
    const bf16* STATES = (const bf16*)(ws + WS_SDST); const float* CDEC = (const float*)(ws + WS_CDEC); bf16* PREV = (bf16*)(ws + WS_SDPV);
    const int bh = item >> 3, b = bh >> 3, h = bh & 7, pp = (item & 7) * 8 + (t >> 5), n = 4 * (t & 31);
    f32x4 s = {0.f, 0.f, 0.f, 0.f}; constexpr int U = 8; v2u ru[U]; float rd[U];
#define SD_IDX4(c_) (((size_t)(b * 256 + (c_)) * 8 + h) * 8192 + pp * 128 + n)
#pragma unroll
    for (int i = 0; i < U; ++i) { ru[i] = *(const v2u*)(STATES + SD_IDX4(i)); rd[i] = CDEC[(size_t)(b * 256 + i) * 8 + h]; }
    for (int c0 = 0; c0 < 256; c0 += U) {
        v2u cu[U]; float cd[U];
#pragma unroll
        for (int i = 0; i < U; ++i) { cu[i] = ru[i]; cd[i] = rd[i]; }
        if (c0 + U < 256) {
#pragma unroll
            for (int i = 0; i < U; ++i) { ru[i] = *(const v2u*)(STATES + SD_IDX4(c0 + U + i)); rd[i] = CDEC[(size_t)(b * 256 + c0 + U + i) * 8 + h]; } }
#pragma unroll
        for (int i = 0; i < U; ++i) { *(v2u*)(PREV + SD_IDX4(c0 + i)) = (v2u){pk2(s.x, s.y), pk2(s.z, s.w)};
            s = s * cd[i] + (f32x4){bflo(cu[i].x), bfhi(cu[i].x), bflo(cu[i].y), bfhi(cu[i].y)}; }
    }
#undef SD_IDX4
}
__device__ __forceinline__ void lru_p2_item4(unsigned char* ws, int item, int t) {
    const float* LRA = (const float*)(ws + WS_LRA); const float* LRH = (const float*)(ws + WS_LRH); float* LRC = (float*)(ws + WS_LRC);
    const int idx = item * 256 + t, b = idx >> 9, c = idx & 511; const size_t base = (size_t)b * 256 * 512 + c;
    float hh = 0.f; constexpr int U = 16; float ra[U], rb[U];
#pragma unroll
    for (int i = 0; i < U; ++i) { ra[i] = LRA[base + (size_t)i * 512]; rb[i] = LRH[base + (size_t)i * 512]; }
    for (int k0 = 0; k0 < 256; k0 += U) {
        float ca[U], cbv[U];
#pragma unroll
        for (int i = 0; i < U; ++i) { ca[i] = ra[i]; cbv[i] = rb[i]; }
        if (k0 + U < 256) {
#pragma unroll
            for (int i = 0; i < U; ++i) { ra[i] = LRA[base + (size_t)(k0 + U + i) * 512]; rb[i] = LRH[base + (size_t)(k0 + U + i) * 512]; } }
#pragma unroll
        for (int i = 0; i < U; ++i) { LRC[base + (size_t)(k0 + i) * 512] = hh; hh = ca[i] * hh + cbv[i]; }
    }
}
__device__ __forceinline__ void ph_m2_half(unsigned char* ws, int vcu, int G, int t) {
    constexpr int N_ITEMS = 4 + 128 + 128;
    for (int w = vcu; w < N_ITEMS; w += G) {
        if (w < 4) lru_p2_item4(ws, w, t);
        else if (w < 132) hg_p2_item4(ws, w - 4, t);
        else sd_p2_item4(ws, w - 132, t);
    }
}
__device__ __forceinline__ void ph_convert_dyn(const Args& a, unsigned char* ws, int l, int mask, LAS unsigned char* lds, int vcu, int G, int wave, int lane, LAS unsigned* ctr) {
    LAS float* scr = (LAS float*)(lds + wave * 16384);
    const int nitems = cvt_nitems(mask);
#define CV_GRAB(dst) do { unsigned j_ = 0; if (lane == 0) j_ = __hip_atomic_fetch_add(ctr, 1u, __ATOMIC_RELAXED, __HIP_MEMORY_SCOPE_WORKGROUP); dst = vcu + G * (int)__builtin_amdgcn_readfirstlane(j_); } while (0)
    int it; CV_GRAB(it); if (it >= nitems) return;
    CvtDesc d0 = cvt_decode(a, ws, l, mask, it); f32x4 v[8]; cvt_load(d0, lane, v);
    for (;;) {
        int nx; CV_GRAB(nx); CvtDesc d1 = d0; f32x4 vn[8];
        if (nx < nitems) { d1 = cvt_decode(a, ws, l, mask, nx); cvt_load(d1, lane, vn); }
        else {
#pragma unroll
            for (int i = 0; i < 8; ++i) vn[i] = v[i]; }
        cvt_store(d0, ws, lane, v, scr);
        if (nx >= nitems) break;
        d0 = d1;
#pragma unroll
        for (int i = 0; i < 8; ++i) v[i] = vn[i];
    }
#undef CV_GRAB
}
__device__ __forceinline__ void ld8(const float* p, float (&o)[8]) { const f32x4 u0 = *(const f32x4*)p, u1 = *(const f32x4*)(p + 4); o[0] = u0.x; o[1] = u0.y; o[2] = u0.z; o[3] = u0.w; o[4] = u1.x; o[5] = u1.y; o[6] = u1.z; o[7] = u1.w; }
__device__ __forceinline__ void ldb8(const bf16* p, float (&o)[8]) { const v4u u = *(const v4u*)p; o[0] = bflo(u.x); o[1] = bfhi(u.x); o[2] = bflo(u.y); o[3] = bfhi(u.y); o[4] = bflo(u.z); o[5] = bfhi(u.z); o[6] = bflo(u.w); o[7] = bfhi(u.w); }
__device__ __forceinline__ void st8(bf16* p, const float (&o)[8]) { v4u u; u.x = pk2(o[0], o[1]); u.y = pk2(o[2], o[3]); u.z = pk2(o[4], o[5]); u.w = pk2(o[6], o[7]); *(v4u*)p = u; }
__device__ __forceinline__ void ph_m3(const Args& a, unsigned char* ws, int l, int gw, int ngw, int lane) {
    const bf16* proj = (const bf16*)(ws + WS_HP); bf16* Y = (bf16*)(ws + WS_Y);
    const float* OA = (const float*)(ws + WS_OA); const float* OB = (const float*)(ws + WS_OB); const float* OC = (const float*)(ws + WS_OC); const float* OD = (const float*)(ws + WS_OD);
    const float* nA = a.in[I_HGN] + l * 512; const float* nB = a.in[I_ATN] + l * 512; const float* nC = a.in[I_SNORM] + l * 512; const float* nD = a.in[I_LNORM] + l * 512;
    const int c = lane * 8;
    for (int t = gw; t < M; t += ngw) {
        float vb[8];
        ld8(OB + (size_t)t * 512 + c, vb);
        const bf16* pr = proj + (size_t)t * NPROJ;
        { float ss = 0.f;
#pragma unroll
          for (int i = 0; i < 8; ++i) ss += vb[i] * vb[i];
          ss = wave_sum(ss); const float r = 1.0f / sqrtf(ss * (1.0f / 512.0f) + NORM_EPS); float w[8]; ld8(nB + c, w);
#pragma unroll
          for (int i = 0; i < 8; ++i) vb[i] = vb[i] * r * w[i];
          st8(Y + (size_t)t * DM + 512 + c, vb); }
    }
}
__device__ __forceinline__ void ph_final(float* out, const bf16* xh, const unsigned char* xl, const rs_t* rowss, const float* w, int vcu, int G, int tid) {
    const int lane = tid & 63, wave = tid >> 6, wr = wave >> 2, wc = wave & 3, fr = lane & 15, fq = lane >> 4;
    for (int t = vcu; t < (M / 256) * (DM / 256); t += G) { const int pm = t >> 3, pn = t & 7;
#pragma unroll
        for (int am = 0; am < 8; ++am) { const int row = pm * 256 + (am >> 2) * 128 + wr * 64 + (am & 3) * 16 + fr; const float r = 1.0f / sqrtf((float)rowss[row] * (RS_INV / DM) + NORM_EPS);
            v4u lw = {0x80808080u, 0x80808080u, 0x80808080u, 0x80808080u}; if (MK_LO) lw = *(const v4u*)(xl + pg8::lo_addr(pm, pn, am, wave, lane));
#pragma unroll
            for (int bj = 0; bj < 2; ++bj) { const int col = pn * 256 + bj * 128 + wc * 32 + 8 * fq; const size_t o2 = (size_t)row * DM + col; const v4u h = *(const v4u*)(xh + o2);
                const f32x4 w0 = *(const f32x4*)(w + col), w1 = *(const f32x4*)(w + col + 4); const unsigned l0 = lw[2 * bj], l1 = lw[2 * bj + 1];
                f32x4 v0 = {bflo(h.x) + pg8::lo_dec(h.x & 0xffffu, l0 & 0xffu), bfhi(h.x) + pg8::lo_dec(h.x >> 16, (l0 >> 8) & 0xffu), bflo(h.y) + pg8::lo_dec(h.y & 0xffffu, (l0 >> 16) & 0xffu), bfhi(h.y) + pg8::lo_dec(h.y >> 16, l0 >> 24)};
                f32x4 v1 = {bflo(h.z) + pg8::lo_dec(h.z & 0xffffu, l1 & 0xffu), bfhi(h.z) + pg8::lo_dec(h.z >> 16, (l1 >> 8) & 0xffu), bflo(h.w) + pg8::lo_dec(h.w & 0xffffu, (l1 >> 16) & 0xffu), bfhi(h.w) + pg8::lo_dec(h.w >> 16, l1 >> 24)};
                *(f32x4*)(out + o2) = v0 * r * w0; *(f32x4*)(out + o2 + 4) = v1 * r * w1; } } }
}
constexpr int NPH = 66;
__host__ __device__ inline bool phase_active(int p) {
    if (p == 0 || p == NPH - 1) return true;
    const int f = (p - 1) >> 3, k = (p - 1) & 7, second = f & 1, l = f >> 1;
    if (k == 0) return false;
    if (k == 1 || k == 2) return true;
    return !second;
}
__global__ void __launch_bounds__(NTHR, 2) fwd_kernel(Args args) {
    extern __shared__ __attribute__((aligned(16))) unsigned char lds_raw[];
    LAS unsigned char* lds = (LAS unsigned char*)lds_raw;
    volatile LAS unsigned* MISC = (volatile LAS unsigned*)(lds + MISC_OFF);
    const int tid0 = threadIdx.x;
    const int G = gridDim.x, bx = blockIdx.x, vcu = (G % 8 == 0) ? (bx % 8) * (G / 8) + bx / 8 : bx;
    const int ngw = G * NWAVES;
    unsigned* ctl = (unsigned*)(args.ws + WS_CTL);
    for (int u = tid0; u < (LDS_BYTES - LDSCTL_OFF) / 4; u += NTHR) ((LAS unsigned*)(lds + LDSCTL_OFF))[u] = 0u;
    __syncthreads();
    const int lo = args.ph_lo, hi = args.ph_hi;
    const bool multi = (hi - lo) > 1;
    XcdBarrier bar; bar.bar = ctl + CW_BAR; bar.x = 0; bar.st = nullptr;
    if (multi) bar = xcd_barrier_post(ctl + CW_BAR, MISC + 8);
#define IN(k) (lo <= (k) && (k) < hi)
#define SEAM(k) do { if ((k) + 1 < hi) xcd_barrier(bar); } while (0)

    if (IN(0)) { unsigned char* ws = args.ws; rs_t* rowss_all = (rs_t*)(ws + WS_ROWSS); const int lane = tid0 & 63, wave = __builtin_amdgcn_readfirstlane(tid0 >> 6), gw = vcu * NWAVES + wave;
        ph_prep(args.in[I_X], (bf16*)(ws + WS_XB), (unsigned char*)(ws + WS_XLO), rowss_all, vcu, G, tid0); ph_convert(args, ws, 0, CVM_F1 | CVM_IN, lds, gw, ngw, wave, lane); SEAM(0); }

    for (int f = 0; f < 2 * DEPTH; ++f) {
        const int l = f >> 1, second = f & 1, base = 1 + 8 * f;
        unsigned long long wsv_ = (unsigned long long)args.ws, outv_ = (unsigned long long)args.out; asm volatile("" : "+s"(wsv_), "+s"(outv_));
        unsigned char* ws = (unsigned char*)(GAS unsigned char*)wsv_; float* out = (float*)(GAS float*)outv_; rs_t* rowss_all = (rs_t*)(ws + WS_ROWSS);
        int tid = tid0; asm volatile("" : "+v"(tid));
        const int lane = tid & 63, wave = __builtin_amdgcn_readfirstlane(tid >> 6), gw = vcu * NWAVES + wave;
        bf16* XB = (bf16*)(ws + WS_XB); bf16* HP = (bf16*)(ws + WS_HP); bf16* Y = (bf16*)(ws + WS_Y);
        const rs_t* rs_in = rowss_all + (size_t)(3 * l + 2 * second) * M;
        rs_t* rs_out = rowss_all + (size_t)(3 * l + 1 + 2 * second) * M;
        if (IN(base + 1)) {
            pg8::Gemm g{XB, (const bf16*)(ws + (second ? WS_WGU2 : WS_WGU1)), M, NGU, DM}; pg8::StaticOrder S; S.init(M, NGU, G, bx);
            pg8::EpiSwiglu E{HP, DFF, rs_in, RS_INV / DM, NORM_EPS};
            pg8::gemm_phase<pg8::EpiSwiglu, pg8::StaticOrder, true, true>(lds, g, S, E);
            SEAM(base + 1);
        }
        if (IN(base + 2)) {
            pg8::Gemm g{HP, (const bf16*)(ws + (second ? WS_WD2 : WS_WD1)), M, DM, DFF}; pg8::StaticOrderT<4, true> S; S.init(M, DM, G, bx);
            pg8::EpiResid E{XB, (unsigned char*)(ws + WS_XLO), rs_out, DM, 0.5f};
            pg8::gemm_phase<pg8::EpiResid, pg8::StaticOrderT<4, true>, true, true>(lds, g, S, E);
            SEAM(base + 2);
        }
        if (!second) {
            if (IN(base + 3)) {
                pg8::Gemm g{XB, (const bf16*)(ws + WS_WIN), M, NPROJ, DM}; pg8::StaticOrder S; S.init(M, NPROJ, G, bx);
                pg8::EpiRowScale E{HP, NPROJ, rs_out, RS_INV / DM, NORM_EPS};
                pg8::gemm_phase<pg8::EpiRowScale, pg8::StaticOrder, true, true>(lds, g, S, E);
                SEAM(base + 3);
            }
            if (IN(base + 4)) { const bool cfirst = vcu & 1;
                if (cfirst) { ph_convert(args, ws, l, CVM_OUT, lds, gw, ngw, wave, lane); __syncthreads(); }
                { LruW W; lru_load_w(args, l, wave, lane, W); for (int u = vcu; u < 512; u += G) lru_unit<false>(args, ws, l, u, W, lds, tid); }
                for (int u = vcu; u < 512; u += G) sd_p1_unit(args, ws, l, rs_out, u, lds, tid);
                { HgRaw R; hg_load<false>(R, ws, vcu, tid); for (int u = vcu; u < 2048; u += G) hg_p1_unit(args, ws, l, u, (u + G < 2048) ? u + G : -1, R, lds, tid); }
                attn_pass<0>(args, ws, l, vcu, G, lds, tid);
                if (!cfirst) { __syncthreads(); ph_convert(args, ws, l, CVM_OUT, lds, gw, ngw, wave, lane); } SEAM(base + 4); }
            if (IN(base + 5)) {
                LAS unsigned* cctr = (LAS unsigned*)(lds + LDSCTL_OFF + 64);
                if (tid == 0) *cctr = 0u;
                __syncthreads();
                if (wave < 4) ph_m2_half(ws, vcu, G, tid);
                if (l + 1 < DEPTH) ph_convert_dyn(args, ws, l + 1, CVM_F1 | CVM_IN, lds, vcu, G, wave, lane, cctr);
                __syncthreads();
                attn_pass<1>(args, ws, l, vcu, G, lds, tid);
                SEAM(base + 5); }
            if (IN(base + 6)) { const bool cfirst = vcu & 1;
                if (cfirst) { ph_convert(args, ws, l, CVM_F2, lds, gw, ngw, wave, lane); __syncthreads(); }
                { HgRaw R; hg_load<true>(R, ws, vcu, tid); for (int u = vcu; u < 2048; u += G) hg_p3_unit(args, ws, l, u, (u + G < 2048) ? u + G : -1, R, lds, tid); } for (int u = vcu; u < 1024; u += G) sd_p3_unit(args, ws, l, u, lds, tid);
                { LruW W; lru_load_w(args, l, wave, lane, W); for (int u = vcu; u < 512; u += G) lru_unit<true>(args, ws, l, u, W, lds, tid); }
                if (!cfirst) { __syncthreads(); ph_convert(args, ws, l, CVM_F2, lds, gw, ngw, wave, lane); } SEAM(base + 6); }
            if (IN(base + 7)) {
                pg8::Gemm g{Y, (const bf16*)(ws + WS_WOUT), M, DM, DM}; pg8::StaticOrderT<4> S; S.init(M, DM, G, bx);
                pg8::EpiResid E{XB, (unsigned char*)(ws + WS_XLO), rowss_all + (size_t)(3 * l + 2) * M, DM, 1.0f};
                pg8::gemm_phase<pg8::EpiResid, pg8::StaticOrderT<4>, true, true>(lds, g, S, E);
                SEAM(base + 7);
            }
        }
    }
    if (IN(NPH - 1)) { const int lane = tid0 & 63, wave = __builtin_amdgcn_readfirstlane(tid0 >> 6), gw = vcu * NWAVES + wave; ph_final(args.out, (const bf16*)(args.ws + WS_XB), (const unsigned char*)(args.ws + WS_XLO), (const rs_t*)(args.ws + WS_ROWSS) + (size_t)12 * M, args.in[I_FINN], vcu, G, tid0); }
#undef IN
#undef SEAM
}

extern "C" void kernel_launch(void* const* d_in, const int* in_sizes, int n_in, void* d_out, int out_size, void* d_ws, size_t ws_size, hipStream_t stream) {
    static int grid = 0;
    if (grid == 0) {
        if (n_in != 30 || in_sizes[0] != M * DM || out_size != M * DM || ws_size < WS_END) { fprintf(stderr, "kernel_launch: unexpected problem shape / workspace (n_in %d, ws %zu, need %zu); nothing launched\n", n_in, ws_size, (size_t)WS_END); grid = -1; return; }
        int dev = 0, cus = 0;
        if (hipGetDevice(&dev) != hipSuccess || hipDeviceGetAttribute(&cus, hipDeviceAttributeMultiprocessorCount, dev) != hipSuccess) { grid = -1; return; }
        if (hipFuncSetAttribute((const void*)fwd_kernel, hipFuncAttributeMaxDynamicSharedMemorySize, LDS_BYTES) != hipSuccess) { fprintf(stderr, "kernel_launch: hipFuncSetAttribute failed\n"); grid = -1; return; }
        int per_cu = 0;
        if (hipOccupancyMaxActiveBlocksPerMultiprocessor(&per_cu, (const void*)fwd_kernel, NTHR, LDS_BYTES) != hipSuccess || per_cu < 1) { fprintf(stderr, "kernel_launch: occupancy query says %d; nothing launched\n", per_cu); (void)hipGetLastError(); grid = -1; return; }
        grid = cus;
    }
    if (grid < 0) return;
    if (hipMemsetAsync((char*)d_ws + WS_CTL, 0, CTL_ZERO_BYTES, stream) != hipSuccess) return;
    Args a{};
    for (int i = 0; i < 30; ++i) a.in[i] = (const float*)d_in[i];
    a.out = (float*)d_out; a.ws = (unsigned char*)d_ws;
#if MK_ONE_LAUNCH
    a.ph_lo = 0; a.ph_hi = NPH;
    hipLaunchKernelGGL(fwd_kernel, dim3(grid), dim3(NTHR), LDS_BYTES, stream, a);
#else
    for (int p = 0; p < NPH; ++p) { if (!phase_active(p)) continue; a.ph_lo = p; a.ph_hi = p + 1; hipLaunchKernelGGL(fwd_kernel, dim3(grid), dim3(NTHR), LDS_BYTES, stream, a); }
#endif
}
```

```cpp
#include <hip/hip_runtime.h>
#include <cstdio>
#include <cstdint>
namespace pg8 {
#define PG8_LAS __attribute__((address_space(3)))
typedef unsigned short bf16_t;
typedef short bf16x8 __attribute__((ext_vector_type(8)));
typedef float f32x4 __attribute__((ext_vector_type(4)));
typedef unsigned u32x4 __attribute__((ext_vector_type(4)));
constexpr int BM = 256, BK = 64, HALF = 128, HTB = HALF * BK * 2  , STAGE_BYTES = 8 * HTB, NXCD = 8, WGM = 8;

__host__ __device__ __forceinline__ int lds_byte(int r, int c) { const int st = (r >> 4) * 2 + (c >> 5), rr = r & 15, cc = c & 31, ob = rr * 64 + cc * 2; return st * 1024 + (ob ^ (((ob >> 9) & 1) << 5)); }
__host__ __device__ __forceinline__ void stage_rc(int b, int& R, int& C) { const int st = b / 1024, sb = b % 1024, swz = sb ^ (((sb >> 9) & 1) << 5); R = (st >> 1) * 16 + swz / 64; C = (st & 1) * 32 + (swz % 64) / 2; }
__host__ __device__ __forceinline__ int perm32(int rho) { const int n = rho >> 4, i = rho & 15; return 8 * (i >> 2) + 4 * n + (i & 3); }

struct Unit { int pm, pn; };
struct Gemm { const bf16_t* A; const bf16_t* Bt; int M, N, K; };

template <int GH, bool REV = false> struct StaticOrderT {
    int nM, nN, nwg, G, c;
    __host__ __device__ void init(int M, int N, int G_, int c_) { nM = M / BM; nN = N / BM; nwg = nM * nN; G = G_; c = c_; }
    __host__ __device__ bool next(int i, Unit& u) const {
        if ((long)i * G + c >= nwg) return false;
        const long L = (long)((REV && nwg % G == 0) ? nwg / G - 1 - i : i) * G + c;
        int wgid = (int)L; { const int q = nwg / NXCD, r = nwg % NXCD, xcd = wgid % NXCD, off = wgid / NXCD; wgid = (xcd < r ? xcd * (q + 1) : r * (q + 1) + (xcd - r) * q) + off; }
        const int nig = GH * nN, gid = wgid / nig, fm = gid * GH, gsz = (nM % GH == 0) ? GH : ((nM - fm) < GH ? (nM - fm) : GH);
        u.pm = fm + ((wgid % nig) % gsz); u.pn = (wgid % nig) / gsz; return true;
    }
    __device__ __forceinline__ void a_ready(const Unit&) const {}
    __device__ __forceinline__ void done(const Unit&) const {}
};
typedef StaticOrderT<WGM> StaticOrder;

__device__ __forceinline__ unsigned cvt_pk_bf16(float lo, float hi) { unsigned r; asm volatile("v_cvt_pk_bf16_f32 %0, %1, %2" : "=v"(r) : "v"(lo), "v"(hi)); return r; }
__device__ __forceinline__ float fast_sigmoid(float v) { return __builtin_amdgcn_rcpf(1.0f + __expf(-v)); }
struct EpiSwiglu {
    static constexpr bool PERM = true, AFTER_DRAIN = false;
    bf16_t* H; int ldh; const unsigned* rowss; float inv_d, eps;
    struct Pre { const PG8_LAS unsigned* rs; };
    __device__ __forceinline__ void prefetch(Pre& p, const Unit& u, int wr, int fr, PG8_LAS unsigned char* lds, int ui, int wid, int lane) const {
        PG8_LAS unsigned* area = (PG8_LAS unsigned*)(lds + STAGE_BYTES + (ui & 1) * 1024);
        if (wid < 4) __builtin_amdgcn_global_load_lds((const unsigned*)(rowss + u.pm * BM + wid * 64 + lane), area + wid * 64, 4, 0, 0);
        p.rs = area; }
    __device__ __forceinline__ void operator()(const f32x4 (&acc)[2][2][4][2], const Unit& u, int wr, int wc, int fr, int fq, const Pre& pre) const {
        const int row0 = u.pm * BM + wr * 64 + fr, col0 = u.pn * HALF + wc * 32 + 8 * fq;
        unsigned rsv[2][4];
#pragma unroll
        for (int ai = 0; ai < 2; ++ai)
#pragma unroll
            for (int m = 0; m < 4; ++m) rsv[ai][m] = pre.rs[wr * 64 + fr + ai * HALF + m * 16];
        __builtin_amdgcn_sched_barrier(0);
#pragma unroll
        for (int ai = 0; ai < 2; ++ai)
#pragma unroll
            for (int m = 0; m < 4; ++m) { const int row = row0 + ai * HALF + m * 16; const float ms = (float)rsv[ai][m] * inv_d + eps, rl = __builtin_amdgcn_rsqf(ms) * -1.4426950408889634f;
                float o[8];
#pragma unroll
                for (int n = 0; n < 2; ++n)
#pragma unroll
                    for (int j = 0; j < 4; ++j) { const float g = acc[ai][0][m][n][j], uu = acc[ai][1][m][n][j], t = __builtin_amdgcn_exp2f(g * rl); o[4 * n + j] = (g * uu) * __builtin_amdgcn_rcpf(__builtin_fmaf(t, ms, ms)); }
                u32x4 w; w.x = cvt_pk_bf16(o[0], o[1]); w.y = cvt_pk_bf16(o[2], o[3]); w.z = cvt_pk_bf16(o[4], o[5]); w.w = cvt_pk_bf16(o[6], o[7]);
                *(u32x4*)(H + (size_t)row * ldh + col0) = w; }
    }
};
struct EpiRowScale {
    static constexpr bool PERM = true, AFTER_DRAIN = false;
    bf16_t* O; int ldc; const unsigned* rowss; float inv_d, eps;
    struct Pre { const PG8_LAS unsigned* rs; };
    __device__ __forceinline__ void prefetch(Pre& p, const Unit& u, int wr, int fr, PG8_LAS unsigned char* lds, int ui, int wid, int lane) const {
        PG8_LAS unsigned* area = (PG8_LAS unsigned*)(lds + STAGE_BYTES + (ui & 1) * 1024);
        if (wid < 4) __builtin_amdgcn_global_load_lds((const unsigned*)(rowss + u.pm * BM + wid * 64 + lane), area + wid * 64, 4, 0, 0);
        p.rs = area; }
    __device__ __forceinline__ void operator()(const f32x4 (&acc)[2][2][4][2], const Unit& u, int wr, int wc, int fr, int fq, const Pre& pre) const {
        const int row0 = u.pm * BM + wr * 64 + fr, col0 = u.pn * BM + wc * 32 + 8 * fq;
        unsigned rsv[2][4];
#pragma unroll
        for (int ai = 0; ai < 2; ++ai)
#pragma unroll
            for (int m = 0; m < 4; ++m) rsv[ai][m] = pre.rs[wr * 64 + fr + ai * HALF + m * 16];
        __builtin_amdgcn_sched_barrier(0);
#pragma unroll
        for (int ai = 0; ai < 2; ++ai)
#pragma unroll
            for (int m = 0; m < 4; ++m) { const int row = row0 + ai * HALF + m * 16; const float r = __builtin_amdgcn_rsqf((float)rsv[ai][m] * inv_d + eps);
                bf16_t* rowp = O + (size_t)row * ldc + col0;
#pragma unroll
                for (int bj = 0; bj < 2; ++bj) { const f32x4 v0 = acc[ai][bj][m][0] * r, v1 = acc[ai][bj][m][1] * r;
                    u32x4 w; w.x = cvt_pk_bf16(v0[0], v0[1]); w.y = cvt_pk_bf16(v0[2], v0[3]); w.z = cvt_pk_bf16(v1[0], v1[1]); w.w = cvt_pk_bf16(v1[2], v1[3]);
                    *(u32x4*)(rowp + bj * HALF) = w; } }
    }
};
__device__ __forceinline__ float lo_scale(unsigned hb) { int se = (int)((hb >> 7) & 0xffu) - 15; se = se < 0 ? 0 : se; return __builtin_bit_cast(float, (unsigned)se << 23); }
__device__ __forceinline__ float lo_inv(unsigned hb) { int ie = 269 - (int)((hb >> 7) & 0xffu); ie = ie > 254 ? 254 : ie; return __builtin_bit_cast(float, (unsigned)ie << 23); }
__device__ __forceinline__ float lo_dec(unsigned hb, unsigned byte) { return ((float)byte - 128.0f) * lo_scale(hb); }
__device__ __forceinline__ unsigned lo_enc(float x, unsigned hb) { const float hf = __builtin_bit_cast(float, hb << 16); float t = (x - hf) * lo_inv(hb) + 128.0f; t = fminf(fmaxf(t, 1.0f), 255.0f); return (unsigned)__builtin_rintf(t); }
#ifndef MK_LO
#define MK_LO 0
#endif
__device__ __forceinline__ size_t lo_addr(int pm, int pn, int am, int wave, int lane) { return ((((size_t)(pm * 8 + pn) * 8 + am) * 8 + wave) * 64 + lane) * 16; }
struct EpiResid {
    static constexpr bool PERM = true, AFTER_DRAIN = false;
    bf16_t* xh; unsigned char* xl; unsigned* rowss_out; int ldc; float scale;
    struct Pre {}; __device__ __forceinline__ void prefetch(Pre&, const Unit&, int, int, PG8_LAS unsigned char*, int, int, int) const {}
    __device__ __forceinline__ void operator()(const f32x4 (&acc)[2][2][4][2], const Unit& u, int wr, int wc, int fr, int fq, const Pre&) const {
        const int row0 = u.pm * BM + wr * 64 + fr, col0 = u.pn * BM + wc * 32 + 8 * fq, wave = wr * 4 + wc, lane = fq * 16 + fr;
        constexpr int NB = MK_LO ? 2 : 4;
#pragma unroll
        for (int ab = 0; ab < 8 / NB; ++ab) {
            u32x4 hi[NB][2], lo[NB];
#pragma unroll
            for (int mm = 0; mm < NB; ++mm) { const int am = NB * ab + mm, ai = am >> 2, m = am & 3; if (MK_LO) lo[mm] = *(const u32x4*)(xl + lo_addr(u.pm, u.pn, am, wave, lane)); else lo[mm] = (u32x4){0x80808080u, 0x80808080u, 0x80808080u, 0x80808080u};
#pragma unroll
                for (int bj = 0; bj < 2; ++bj) hi[mm][bj] = *(const u32x4*)(xh + (size_t)(row0 + ai * HALF + m * 16) * ldc + col0 + bj * HALF); }
#pragma unroll
            for (int mm = 0; mm < NB; ++mm) { const int am = NB * ab + mm, ai = am >> 2, m = am & 3; const int row = row0 + ai * HALF + m * 16; float ss = 0.f; u32x4 wl = {0u, 0u, 0u, 0u};
#pragma unroll
                for (int bj = 0; bj < 2; ++bj) { const size_t o2 = (size_t)row * ldc + col0 + bj * HALF; u32x4 wh;
#pragma unroll
                    for (int q = 0; q < 4; ++q) { const unsigned h = hi[mm][bj][q], lw = lo[mm][2 * bj + (q >> 1)] >> (16 * (q & 1));
                        float x0 = __builtin_bit_cast(float, h << 16), x1 = __builtin_bit_cast(float, h & 0xffff0000u); if (MK_LO) { x0 += lo_dec(h & 0xffffu, lw & 0xffu); x1 += lo_dec(h >> 16, (lw >> 8) & 0xffu); }
                        x0 += acc[ai][bj][m][q >> 1][2 * (q & 1)] * scale; x1 += acc[ai][bj][m][q >> 1][2 * (q & 1) + 1] * scale;
                        ss += x0 * x0 + x1 * x1;
                        const unsigned nh = cvt_pk_bf16(x0, x1); wh[q] = nh;
                        if (MK_LO) wl[2 * bj + (q >> 1)] |= (lo_enc(x0, nh & 0xffffu) | (lo_enc(x1, nh >> 16) << 8)) << (16 * (q & 1)); }
                    *(u32x4*)(xh + o2) = wh; }
                if (MK_LO) *(u32x4*)(xl + lo_addr(u.pm, u.pn, am, wave, lane)) = wl;
                ss += __shfl_xor(ss, 16); ss += __shfl_xor(ss, 32);
                if (fq == 0) atomicAdd(rowss_out + row, (unsigned)(ss * 1024.0f + 0.5f)); } }
    }
};
struct EpiNull {
    static constexpr bool PERM = true, AFTER_DRAIN = false;
    float* sink;
    struct Pre {}; __device__ __forceinline__ void prefetch(Pre&, const Unit&, int, int, PG8_LAS unsigned char*, int, int, int) const {}
    __device__ __forceinline__ void operator()(const f32x4 (&acc)[2][2][4][2], const Unit& u, int wr, int wc, int fr, int fq, const Pre&) const {
        float s = 0.f;
#pragma unroll
        for (int ai = 0; ai < 2; ++ai)
#pragma unroll
            for (int bj = 0; bj < 2; ++bj)
#pragma unroll
                for (int m = 0; m < 4; ++m)
#pragma unroll
                    for (int n = 0; n < 2; ++n) s += (acc[ai][bj][m][n][0] + acc[ai][bj][m][n][1]) + (acc[ai][bj][m][n][2] + acc[ai][bj][m][n][3]);
        if (s == 1234567.125f) sink[0] = s;
    }
};
template <class Epi, class Sched, bool ALIGN_EPI = false, bool SP2 = false>
__device__ __forceinline__ void gemm_phase(PG8_LAS unsigned char* lds, const Gemm g, const Sched& S, const Epi& E) {
    int tid_ = threadIdx.x; asm volatile("" : "+v"(tid_));
    const int tid = tid_, wid = __builtin_amdgcn_readfirstlane(tid >> 6), lane = tid & 63, wr = wid >> 2, wc = wid & 3, fr = lane & 15, fq = lane >> 4;
    const int K = g.K, nt = K / BK;
    unsigned voffA[2], voffB[2];
#pragma unroll
    for (int i = 0; i < 2; ++i) { int R, C; stage_rc(tid * 16 + i * 8192, R, C); const int Rb = Epi::PERM ? ((R & ~31) + perm32(R & 31)) : R;
        voffA[i] = (unsigned)(R * K + C) * 2u; voffB[i] = (unsigned)(Rb * K + C) * 2u; }
    const size_t kstep = (size_t)(BK * 2);
    const size_t hstep = (size_t)HALF * K * 2;
    const size_t tstep = 2 * hstep;
    const unsigned ldsw = (unsigned)wid * 1024u;
    const int aoff = lds_byte(wr * 64 + fr, fq * 8), boff = lds_byte(wc * 32 + fr, fq * 8);
#define PG8_SA(b, h) (((b) * 2 + (h)) * HTB)
#define PG8_SB(b, h) ((4 + (b) * 2 + (h)) * HTB)
#define PG8_STAGE(bufoff, gbase, voff) do { _Pragma("unroll") for (int _i = 0; _i < 2; ++_i) \
        __builtin_amdgcn_global_load_lds((const unsigned*)((const char*)(gbase) + (voff)[_i]), (PG8_LAS unsigned*)(lds + (bufoff) + ldsw + _i * 8192), 16, 0, 0); } while (0)
#define PG8_LDA(dst, b, h) do { _Pragma("unroll") for (int m = 0; m < 4; ++m) _Pragma("unroll") for (int k = 0; k < 2; ++k) dst[m][k] = *(const PG8_LAS bf16x8*)(lds + PG8_SA(b, h) + aoff + m * 2048 + k * 1024); } while (0)
#define PG8_LDB(dst, b, h) do { _Pragma("unroll") for (int n = 0; n < 2; ++n) _Pragma("unroll") for (int k = 0; k < 2; ++k) dst[n][k] = *(const PG8_LAS bf16x8*)(lds + PG8_SB(b, h) + boff + n * 2048 + k * 1024); } while (0)
#define PG8_MMA(ai, bj, At, Bt) do { __builtin_amdgcn_s_setprio(1); _Pragma("unroll") for (int m = 0; m < 4; ++m) _Pragma("unroll") for (int n = 0; n < 2; ++n) _Pragma("unroll") for (int k = 0; k < 2; ++k) \
        acc[ai][bj][m][n] = __builtin_amdgcn_mfma_f32_16x16x32_bf16(Bt[n][k], At[m][k], acc[ai][bj][m][n], 0, 0, 0); __builtin_amdgcn_s_setprio(0); } while (0)
#define PG8_WAIT_V(n) asm volatile("s_waitcnt vmcnt(" #n ")" ::: "memory")
#define PG8_WAIT_L(n) asm volatile("s_waitcnt lgkmcnt(" #n ")" ::: "memory")
#define PG8_BAR __builtin_amdgcn_s_barrier()
#define PG8_SCHED __builtin_amdgcn_sched_barrier(0)
    Unit cur, nxt; int ui = 0;
    if (!S.next(0, cur)) return;
    f32x4 acc[2][2][4][2];
#define PG8_ZERO_ACC() do { _Pragma("unroll") for (int a = 0; a < 2; ++a) _Pragma("unroll") for (int b = 0; b < 2; ++b) _Pragma("unroll") for (int m = 0; m < 4; ++m) _Pragma("unroll") for (int n = 0; n < 2; ++n) { \
        typedef unsigned long long u64x2_ __attribute__((ext_vector_type(2))); unsigned long long z0_, z1_; asm volatile("v_mov_b64 %0, 0\n\tv_mov_b64 %1, 0" : "=v"(z0_), "=v"(z1_)); \
        acc[a][b][m][n] = __builtin_bit_cast(f32x4, (u64x2_){z0_, z1_}); } } while (0)
    PG8_ZERO_ACC();
    bf16x8 At[4][2], B0[2][2], B1[2][2];
    const char* cA = (const char*)g.A + (size_t)cur.pm * tstep; const char* cB = (const char*)g.Bt + (size_t)cur.pn * tstep;
    S.a_ready(cur);
    if constexpr (SP2) {
        PG8_STAGE(PG8_SB(0, 0), cB, voffB); PG8_STAGE(PG8_SB(0, 1), cB + hstep, voffB); PG8_STAGE(PG8_SA(0, 0), cA, voffA); PG8_STAGE(PG8_SA(0, 1), cA + hstep, voffA);
        if (wr == 1) PG8_BAR;
        PG8_WAIT_V(2); PG8_BAR;
        PG8_STAGE(PG8_SB(1, 0), cB + kstep, voffB); PG8_STAGE(PG8_SA(1, 0), cA + kstep, voffA); PG8_STAGE(PG8_SB(1, 1), cB + hstep + kstep, voffB);
        PG8_WAIT_V(6); PG8_BAR;
    } else {
        PG8_STAGE(PG8_SB(0, 0), cB, voffB); PG8_STAGE(PG8_SA(0, 0), cA, voffA); PG8_STAGE(PG8_SB(0, 1), cB + hstep, voffB); PG8_STAGE(PG8_SA(0, 1), cA + hstep, voffA);
        if (wr == 1) PG8_BAR;
        PG8_WAIT_V(4); PG8_BAR;
        PG8_STAGE(PG8_SB(1, 0), cB + kstep, voffB); PG8_STAGE(PG8_SA(1, 0), cA + kstep, voffA); PG8_STAGE(PG8_SB(1, 1), cB + hstep + kstep, voffB);
        PG8_WAIT_V(6); PG8_BAR;
    }
    for (;;) {
        const bool has_next = S.next(ui + 1, nxt);
        typename Epi::Pre pre; E.prefetch(pre, cur, wr, fr, lds, ui, wid, lane);
        const char* nA = has_next ? (const char*)g.A + (size_t)nxt.pm * tstep : cA; const char* nB = has_next ? (const char*)g.Bt + (size_t)nxt.pn * tstep : cB;
        for (int t = 0; t < nt; t += 2) {
            const bool last = (t == nt - 2);
            const char* a1 = cA + (size_t)(t + 1) * kstep;
            const char* a2 = last ? nA : cA + (size_t)(t + 2) * kstep; const char* b2 = last ? nB : cB + (size_t)(t + 2) * kstep;
            const char* a3 = a2 + kstep; const char* b3 = b2 + kstep;
            if (last && has_next) S.a_ready(nxt);
            if constexpr (SP2) {
            PG8_LDB(B0, 0, 0); PG8_LDB(B1, 0, 1); PG8_SCHED; PG8_LDA(At, 0, 0); PG8_STAGE(PG8_SA(1, 1), a1 + hstep, voffA);
            PG8_WAIT_V(8); PG8_WAIT_L(0); PG8_BAR; PG8_MMA(0, 0, At, B0); PG8_MMA(0, 1, At, B1); PG8_BAR; PG8_SCHED;
            PG8_LDA(At, 0, 1); PG8_STAGE(PG8_SB(0, 0), b2, voffB); PG8_STAGE(PG8_SB(0, 1), b2 + hstep, voffB); PG8_STAGE(PG8_SA(0, 0), a2, voffA);
            PG8_WAIT_V(8); PG8_WAIT_L(0); PG8_BAR; PG8_MMA(1, 0, At, B0); PG8_MMA(1, 1, At, B1); PG8_BAR; PG8_SCHED;
            PG8_LDB(B0, 1, 0); PG8_LDB(B1, 1, 1); PG8_SCHED; PG8_LDA(At, 1, 0); PG8_STAGE(PG8_SA(0, 1), a2 + hstep, voffA);
            PG8_WAIT_V(8); PG8_WAIT_L(0); PG8_BAR; PG8_MMA(0, 0, At, B0); PG8_MMA(0, 1, At, B1); PG8_BAR; PG8_SCHED;
            PG8_LDA(At, 1, 1); PG8_STAGE(PG8_SB(1, 0), b3, voffB); PG8_STAGE(PG8_SB(1, 1), b3 + hstep, voffB); PG8_STAGE(PG8_SA(1, 0), a3, voffA);
            PG8_WAIT_V(8); PG8_WAIT_L(0); PG8_BAR; PG8_MMA(1, 0, At, B0); PG8_MMA(1, 1, At, B1); PG8_BAR; PG8_SCHED;
            } else {
            PG8_LDB(B0, 0, 0); PG8_SCHED; PG8_LDA(At, 0, 0); PG8_STAGE(PG8_SA(1, 1), a1 + hstep, voffA);
            PG8_WAIT_L(8); PG8_BAR; PG8_WAIT_L(0); PG8_MMA(0, 0, At, B0); PG8_BAR; PG8_SCHED;
            PG8_LDB(B1, 0, 1); PG8_STAGE(PG8_SB(0, 0), b2, voffB);
            PG8_BAR; PG8_WAIT_L(0); PG8_MMA(0, 1, At, B1); PG8_BAR;
            PG8_LDA(At, 0, 1); PG8_STAGE(PG8_SA(0, 0), a2, voffA);
            PG8_BAR; PG8_WAIT_L(0); PG8_MMA(1, 0, At, B0); PG8_BAR; PG8_SCHED;
            PG8_STAGE(PG8_SB(0, 1), b2 + hstep, voffB);
            PG8_WAIT_V(6); PG8_BAR; PG8_MMA(1, 1, At, B1); PG8_BAR;
            PG8_LDB(B0, 1, 0); PG8_SCHED; PG8_LDA(At, 1, 0); PG8_STAGE(PG8_SA(0, 1), a2 + hstep, voffA);
            PG8_WAIT_L(8); PG8_BAR; PG8_WAIT_L(0); PG8_MMA(0, 0, At, B0); PG8_BAR; PG8_SCHED;
            PG8_LDB(B1, 1, 1); PG8_STAGE(PG8_SB(1, 0), b3, voffB);
            PG8_BAR; PG8_WAIT_L(0); PG8_MMA(0, 1, At, B1); PG8_BAR;
            PG8_LDA(At, 1, 1); PG8_STAGE(PG8_SA(1, 0), a3, voffA);
            PG8_BAR; PG8_WAIT_L(0); PG8_MMA(1, 0, At, B0); PG8_BAR; PG8_SCHED;
            PG8_STAGE(PG8_SB(1, 1), b3 + hstep, voffB);
            PG8_WAIT_V(6); PG8_BAR; PG8_MMA(1, 1, At, B1); PG8_BAR;
            }
        }
        if constexpr (ALIGN_EPI) { if (wr == 0) PG8_BAR; }
        if constexpr (!Epi::AFTER_DRAIN) { E(acc, cur, wr, wc, fr, fq, pre); S.done(cur); }
        if (!has_next) break;
        PG8_ZERO_ACC();
        cur = nxt; cA = nA; cB = nB; ++ui;
        if constexpr (ALIGN_EPI) { if (wr == 1) PG8_BAR; }
    }
    PG8_WAIT_V(0);
    if constexpr (!ALIGN_EPI) { if (wr == 0) PG8_BAR; }
    PG8_BAR;
    if constexpr (Epi::AFTER_DRAIN) { E.fused(acc, cur, wr, wc, fr, fq, lds, wid, lane); S.done(cur); }
#undef PG8_SA
#undef PG8_SB
#undef PG8_STAGE
#undef PG8_LDA
#undef PG8_LDB
#undef PG8_MMA
#undef PG8_WAIT_V
#undef PG8_WAIT_L
#undef PG8_BAR
#undef PG8_SCHED
}
}
constexpr int BATCH = 2, SEQ = 16384, DM = 2048, M = BATCH * SEQ, DFF = 5632, NGU = 2 * DFF, NIN = 6152, NPROJ = 6144, DEPTH = 4, GW = 512;
constexpr float NORM_EPS = 1e-6f;
constexpr int PC_AQ = 0, PC_AF = 512, PC_AI = 1024, PC_AG = 1536, PC_BQ = 2048, PC_BK = 2560, PC_BV = 3072, PC_CZ = 3584, PC_CX = 4096, PC_DX = 5120, PC_DG = 5632;
constexpr int NWAVES = 8, NTHR = 512;
#ifndef MK_ONE_LAUNCH
#define MK_ONE_LAUNCH 1
#endif
constexpr size_t MiB = 1u << 20;
constexpr size_t WS_CTL = 0, CTL_ZERO_BYTES = 4 * MiB;
constexpr size_t WS_ROWSS = 64 * 1024;
typedef unsigned rs_t;
constexpr float RS_SCALE = 1024.0f, RS_INV = 1.0f / 1024.0f;
constexpr size_t WS_WGU1 = 4 * MiB, WS_WD1 = 48 * MiB, WS_WGU2 = 70 * MiB, WS_WD2 = 114 * MiB, WS_WIN = 136 * MiB, WS_WOUT = 160 * MiB, WS_WDT = 168 * MiB;
constexpr size_t WS_XB = 170 * MiB;
constexpr size_t WS_HP = 298 * MiB;
constexpr size_t WS_Y = 682 * MiB;
constexpr size_t WS_XBCC = 810 * MiB;
constexpr size_t WS_DTV = 938 * MiB;
constexpr size_t WS_LA = 939 * MiB, WS_LB = 1003 * MiB;
constexpr size_t WS_OA = 1067 * MiB, WS_OB = 1131 * MiB, WS_OC = 1195 * MiB, WS_OD = 1259 * MiB;
constexpr size_t WS_HGU = 1323 * MiB, WS_HGD = 1451 * MiB, WS_HGS = 1452 * MiB;
constexpr size_t WS_WDTB = WS_WDT + 65536, WS_CDEC = WS_WDT + 131072;
constexpr size_t WS_SDST = WS_XBCC, WS_SDPV = WS_OA;
constexpr size_t WS_LRA = WS_LA, WS_LRH = WS_LA + MiB, WS_LRC = WS_LA + 2 * MiB;
constexpr size_t WS_XLO = WS_OB;
constexpr size_t WS_PAO = WS_OC, WS_PAM = WS_OC + 32 * MiB;
constexpr size_t WS_END = 1516 * MiB;
static_assert(WS_ROWSS + 13 * (size_t)M * 8 <= CTL_ZERO_BYTES, "ctl");
static_assert(WS_WGU1 + (size_t)NGU * DM * 2 <= WS_WD1 && WS_WD1 + (size_t)DM * DFF * 2 <= WS_WGU2 && WS_WGU2 + (size_t)NGU * DM * 2 <= WS_WD2 && WS_WD2 + (size_t)DM * DFF * 2 <= WS_WIN &&
              WS_WIN + (size_t)NPROJ * DM * 2 <= WS_WOUT && WS_WOUT + (size_t)DM * DM * 2 <= WS_WDT && WS_WDT + 8 * DM * 4 <= WS_XB && WS_XB + (size_t)M * DM * 2 <= WS_HP &&
              WS_HP + (size_t)M * NPROJ * 2 <= WS_Y && WS_Y + (size_t)M * DM * 2 <= WS_XBCC && WS_XBCC + (size_t)M * 1024 * 4 <= WS_DTV && WS_DTV + (size_t)M * 8 * 4 <= WS_LA &&
              WS_LA + (size_t)M * 512 * 4 <= WS_LB && WS_LB + (size_t)M * 512 * 4 <= WS_OA && WS_OD + (size_t)M * 512 * 4 <= WS_END, "d_ws map");
constexpr int CW_BAR = 1024;
constexpr int RING_BYTES = 131072, LDSCTL_OFF = 143360, MISC_OFF = LDSCTL_OFF + 320, LDS_BYTES = 147456;

#define GAS __attribute__((address_space(1)))
#define LAS __attribute__((address_space(3)))
typedef unsigned short bf16;
typedef unsigned v4u __attribute__((ext_vector_type(4)));
typedef unsigned v2u __attribute__((ext_vector_type(2)));
typedef float f32x4 __attribute__((ext_vector_type(4)));
#define LDS_WAIT() asm volatile("s_waitcnt lgkmcnt(0)" ::: "memory")
typedef float f32x2_t __attribute__((ext_vector_type(2)));
typedef __bf16 bf16x2_t __attribute__((ext_vector_type(2)));
__device__ __forceinline__ unsigned pk2(float lo, float hi) { const f32x2_t v = {lo, hi}; return __builtin_bit_cast(unsigned, __builtin_convertvector(v, bf16x2_t)); }
__device__ __forceinline__ unsigned f2bf(float f) { return pk2(f, f) & 0xffffu; }
__device__ __forceinline__ float bf2f(unsigned b) { return __builtin_bit_cast(float, b << 16); }
__device__ __forceinline__ float bflo(unsigned w) { return __builtin_bit_cast(float, w << 16); }
__device__ __forceinline__ float bfhi(unsigned w) { return __builtin_bit_cast(float, w & 0xffff0000u); }
__device__ __forceinline__ float wave_sum(float v) {
#pragma unroll
    for (int o = 1; o < 64; o <<= 1) v += __shfl_xor(v, o);
    return v;
}
__device__ __forceinline__ float sigmoidf_(float v) { return __builtin_amdgcn_rcpf(1.0f + __builtin_amdgcn_exp2f(v * -1.4426950408889634f)); }
__device__ __forceinline__ float siluf_(float v) { return v * __builtin_amdgcn_rcpf(1.0f + __builtin_amdgcn_exp2f(v * -1.4426950408889634f)); }
__device__ __forceinline__ float softplusf_(float v) { return v > 20.f ? v : log1pf(__expf(v)); }
__device__ __forceinline__ float geluf_(float v) { const float u = 0.7978845608028654f * (v + 0.044715f * v * v * v); return 0.5f * v * (1.0f + tanhf(u)); }
#define XB_TMO      128
#define XB_XCNT(j)  (256  + 64 * (j))
#define XB_XSUB(j)  (1280 + 64 * (j))
#define XB_XGEN(j)  (2304 + 64 * (j))
#define XB_TOP      3328
#define XB_TOPGEN   3392
#define XCD_BAR_WORDS 3456
#define XB_SPIN_CAP (1u << 18)

__device__ __forceinline__ unsigned xb_ld(unsigned* p)              { return __hip_atomic_load(p, __ATOMIC_RELAXED, __HIP_MEMORY_SCOPE_AGENT); }
__device__ __forceinline__ unsigned xb_add(unsigned* p, unsigned v) { return __hip_atomic_fetch_add(p, v, __ATOMIC_RELAXED, __HIP_MEMORY_SCOPE_AGENT); }
__device__ __forceinline__ unsigned xb_xcc_id() { return (unsigned)__builtin_amdgcn_s_getreg((3 << 11) | 20) & 0xFu; }
#define XB_SPIN(cond, bar) do { unsigned _sp = 0; while (cond) { __builtin_amdgcn_s_sleep(1); \
    if ((++_sp & 255u) == 0u) { if (xb_ld(&(bar)[XB_TMO])) break; if (_sp > XB_SPIN_CAP) { atomicAdd(&(bar)[XB_TMO], 1u); break; } } } } while (0)

struct XcdBarrier {
    unsigned* bar; unsigned x;
    volatile LAS unsigned* st;
};

__device__ __forceinline__ XcdBarrier xcd_barrier_post(unsigned* bar, volatile LAS unsigned* st) {
    XcdBarrier b; b.bar = bar; b.x = xb_xcc_id(); b.st = st;
    if (threadIdx.x == 0) (void)xb_add(&bar[XB_XCNT(b.x)], 1u);
    return b;
}
__device__ __forceinline__ void xcd_barrier_complete(unsigned* bar, unsigned x, unsigned& nloc, unsigned& nx) {
    const unsigned G = gridDim.x * gridDim.y * gridDim.z;
    unsigned sum, cnt, mine, sp = 0u;
    for (;;) {
        sum = 0u; cnt = 0u; mine = 0u;
#pragma unroll
        for (unsigned j = 0; j < 16; ++j) { const unsigned c = xb_ld(&bar[XB_XCNT(j)]); sum += c; cnt += (c > 0u) ? 1u : 0u; mine = (j == x) ? c : mine; }
        if (sum == G) break;
        __builtin_amdgcn_s_sleep(1);
        if ((++sp & 255u) == 0u) { if (xb_ld(&bar[XB_TMO])) break; if (sp > XB_SPIN_CAP) { atomicAdd(&bar[XB_TMO], 1u); break; } }
    }
    nloc = mine > 0u ? mine : 1u; nx = cnt > 0u ? cnt : 1u;
}

__device__ __forceinline__ void xcd_barrier(const XcdBarrier& b) {
    asm volatile("s_waitcnt vmcnt(0)" ::: "memory");
    __syncthreads();
    if (threadIdx.x == 0) {
        unsigned* bar = b.bar;
        __builtin_amdgcn_s_waitcnt(0);
        unsigned nloc = b.st[0], nx = b.st[1];
        if (nloc == 0u) { xcd_barrier_complete(bar, b.x, nloc, nx); b.st[0] = nloc; b.st[1] = nx; }
        const unsigned old = xb_add(&bar[XB_XSUB(b.x)], 1u);
        const unsigned gen = old / nloc;
        if (old + 1u == (gen + 1u) * nloc) {
            __builtin_amdgcn_fence(__ATOMIC_RELEASE, "agent");
            asm volatile("s_waitcnt vmcnt(0)" ::: "memory");
            const unsigned og = xb_add(&bar[XB_TOP], 1u);
            const unsigned tg = og / nx;
            if (og + 1u == (tg + 1u) * nx) xb_add(&bar[XB_TOPGEN], 1u);
            else XB_SPIN(xb_ld(&bar[XB_TOPGEN]) == tg, bar);
            __builtin_amdgcn_fence(__ATOMIC_ACQUIRE, "agent");
            xb_add(&bar[XB_XGEN(b.x)], 1u);
            asm volatile("s_waitcnt vmcnt(0)" ::: "memory");
        } else {
            XB_SPIN(xb_ld(&bar[XB_XGEN(b.x)]) == gen, bar);
            __builtin_amdgcn_fence(__ATOMIC_ACQUIRE, "agent");
            asm volatile("s_waitcnt vmcnt(0)" ::: "memory");
        }
    }
    __syncthreads();
}

struct Args {
    const float* in[30];
    float* out; unsigned char* ws; int ph_lo, ph_hi;
};
enum { I_X = 0, I_F1N, I_F1G, I_F1U, I_F1D, I_MIXN, I_WIN, I_WOUT, I_LBL, I_HGN, I_ATN, I_SCW, I_SCB, I_SDTB, I_SALOG, I_SD, I_SNORM, I_LCW, I_LCB, I_LWA, I_LBA, I_LWX, I_LBX, I_LAP, I_LNORM,
       I_F2N, I_F2G, I_F2U, I_F2D, I_FINN };

__device__ __forceinline__ void ph_prep(const float* __restrict__ x, bf16* __restrict__ xb, unsigned char* __restrict__ xlo, rs_t* __restrict__ rowss, int vcu, int G, int tid) {
    const int lane = tid & 63, wave = tid >> 6, wr = wave >> 2, wc = wave & 3, fr = lane & 15, fq = lane >> 4;
    for (int t = vcu; t < (M / 256) * (DM / 256); t += G) { const int pm = t >> 3, pn = t & 7;
#pragma unroll
        for (int hf = 0; hf < 2; ++hf) {
        f32x4 vv[4][2][2];
#pragma unroll
        for (int a4 = 0; a4 < 4; ++a4) { const int am = 4 * hf + a4, row = pm * 256 + (am >> 2) * 128 + wr * 64 + (am & 3) * 16 + fr;
#pragma unroll
            for (int bj = 0; bj < 2; ++bj) { const size_t o2 = (size_t)row * DM + pn * 256 + bj * 128 + wc * 32 + 8 * fq; vv[a4][bj][0] = *(const f32x4*)(x + o2); vv[a4][bj][1] = *(const f32x4*)(x + o2 + 4); } }
        __builtin_amdgcn_sched_barrier(0);
#pragma unroll
        for (int a4 = 0; a4 < 4; ++a4) { const int am = 4 * hf + a4; const int row = pm * 256 + (am >> 2) * 128 + wr * 64 + (am & 3) * 16 + fr; float ss = 0.f; v4u wl = {0u, 0u, 0u, 0u};
#pragma unroll
            for (int bj = 0; bj < 2; ++bj) { const size_t o2 = (size_t)row * DM + pn * 256 + bj * 128 + wc * 32 + 8 * fq; const f32x4 v0 = vv[a4][bj][0], v1 = vv[a4][bj][1];
                ss += (v0.x * v0.x + v0.y * v0.y) + (v0.z * v0.z + v0.w * v0.w) + (v1.x * v1.x + v1.y * v1.y) + (v1.z * v1.z + v1.w * v1.w);
                v4u w; w.x = pk2(v0.x, v0.y); w.y = pk2(v0.z, v0.w); w.z = pk2(v1.x, v1.y); w.w = pk2(v1.z, v1.w); *(v4u*)(xb + o2) = w;
                if (MK_LO) { wl[2 * bj] = pg8::lo_enc(v0.x, w.x & 0xffffu) | (pg8::lo_enc(v0.y, w.x >> 16) << 8) | (pg8::lo_enc(v0.z, w.y & 0xffffu) << 16) | (pg8::lo_enc(v0.w, w.y >> 16) << 24);
                wl[2 * bj + 1] = pg8::lo_enc(v1.x, w.z & 0xffffu) | (pg8::lo_enc(v1.y, w.z >> 16) << 8) | (pg8::lo_enc(v1.z, w.w & 0xffffu) << 16) | (pg8::lo_enc(v1.w, w.w >> 16) << 24); } }
            if (MK_LO) *(v4u*)(xlo + pg8::lo_addr(pm, pn, am, wave, lane)) = wl;
            ss += __shfl_xor(ss, 16); ss += __shfl_xor(ss, 32);
            if (fq == 0) atomicAdd(rowss + row, (rs_t)(ss * RS_SCALE + 0.5f)); } } }
}
struct CvtDesc { const float* W; const float* kscale; bf16* WT; int K, N, mode, r; };
constexpr int CV_G = (DM / 64) * (DFF / 32), CV_IN = (DM / 64) * ((NIN + 31) / 32), CV_OUT = (DM / 64) * (DM / 32);
static_assert((DFF / 64) * (DM / 32) == CV_G, "items");
constexpr int CVM_F1 = 1, CVM_F2 = 2, CVM_IN = 4, CVM_OUT = 8;
__host__ __device__ constexpr int cvt_nitems(int mask) { return ((mask & CVM_F1) ? 3 * CV_G : 0) + ((mask & CVM_F2) ? 3 * CV_G : 0) + ((mask & CVM_IN) ? CV_IN : 0) + ((mask & CVM_OUT) ? CV_OUT : 0); }
__device__ __forceinline__ CvtDesc cvt_decode(const Args& a, unsigned char* ws, int l, int mask, int it) {
    const size_t oF = (size_t)l * DM * DFF, oN = (size_t)l * DM; int r = it; CvtDesc d;
    if (mask & CVM_F1) {
        if (r < CV_G) { d = CvtDesc{a.in[I_F1G] + oF, a.in[I_F1N] + oN, (bf16*)(ws + WS_WGU1), DM, DFF, 1, r}; return d; } r -= CV_G;
        if (r < CV_G) { d = CvtDesc{a.in[I_F1U] + oF, a.in[I_F1N] + oN, (bf16*)(ws + WS_WGU1), DM, DFF, 2, r}; return d; } r -= CV_G;
        if (r < CV_G) { d = CvtDesc{a.in[I_F1D] + oF, nullptr, (bf16*)(ws + WS_WD1), DFF, DM, 0, r}; return d; } r -= CV_G; }
    if (mask & CVM_F2) {
        if (r < CV_G) { d = CvtDesc{a.in[I_F2G] + oF, a.in[I_F2N] + oN, (bf16*)(ws + WS_WGU2), DM, DFF, 1, r}; return d; } r -= CV_G;
        if (r < CV_G) { d = CvtDesc{a.in[I_F2U] + oF, a.in[I_F2N] + oN, (bf16*)(ws + WS_WGU2), DM, DFF, 2, r}; return d; } r -= CV_G;
        if (r < CV_G) { d = CvtDesc{a.in[I_F2D] + oF, nullptr, (bf16*)(ws + WS_WD2), DFF, DM, 0, r}; return d; } r -= CV_G; }
    if (mask & CVM_IN) { if (r < CV_IN) { d = CvtDesc{a.in[I_WIN] + (size_t)l * DM * NIN, a.in[I_MIXN] + oN, (bf16*)(ws + WS_WIN), DM, NIN, 3, r}; return d; } r -= CV_IN; }
    d = CvtDesc{a.in[I_WOUT] + (size_t)l * DM * DM, nullptr, (bf16*)(ws + WS_WOUT), DM, DM, 0, r}; return d;
}
__device__ __forceinline__ void cvt_load(const CvtDesc& d, int lane, f32x4 (&v)[8]) {
    const int nblk = (d.N + 31) / 32, kb = d.r / nblk, nb = d.r % nblk, k0 = 64 * kb, n = 32 * nb + (lane & 7) * 4, kr = lane >> 3;
#pragma unroll
    for (int i = 0; i < 8; ++i) v[i] = (n < d.N) ? *(const f32x4*)(d.W + (size_t)(k0 + kr + 8 * i) * d.N + n) : (f32x4){0.f, 0.f, 0.f, 0.f};
}
__device__ __forceinline__ void cvt_store(const CvtDesc& d, unsigned char* ws, int lane, const f32x4 (&v)[8], LAS float* scr) {
    const int nblk = (d.N + 31) / 32, kb = d.r / nblk, nb = d.r % nblk, k0 = 64 * kb, n0 = 32 * nb, kr = lane >> 3, n4 = (lane & 7) * 4, K = d.K;
#pragma unroll
    for (int i = 0; i < 8; ++i) { const int kk = kr + 8 * i; const float sc = d.kscale ? d.kscale[k0 + kk] : 1.0f; LAS float* s = scr + kk * 33 + n4; s[0] = v[i][0] * sc; s[1] = v[i][1] * sc; s[2] = v[i][2] * sc; s[3] = v[i][3] * sc; }
    LDS_WAIT(); asm volatile("" ::: "memory");
    const int c = lane & 7;
#pragma unroll
    for (int j = 0; j < 4; ++j) { const int nl = (lane >> 3) + 8 * j, n = n0 + nl; const LAS float* s = scr + (8 * c) * 33 + nl;
        const float a0 = s[0 * 33], a1 = s[1 * 33], a2 = s[2 * 33], a3 = s[3 * 33], a4 = s[4 * 33], a5 = s[5 * 33], a6 = s[6 * 33], a7 = s[7 * 33];
        if (n < d.N) {
            int dr = n; bool special = false;
            if (d.mode == 1) dr = 256 * (n >> 7) + (n & 127);
            if (d.mode == 2) dr = 256 * (n >> 7) + 128 + (n & 127);
            if (d.mode == 3) { if (n >= 5128) dr = n - 8; else if (n >= 5120) special = true; }
            v4u o; o.x = pk2(a0, a1); o.y = pk2(a2, a3); o.z = pk2(a4, a5); o.w = pk2(a6, a7);
            if (special) { float* f = (float*)(ws + WS_WDT) + (size_t)(n - 5120) * K + k0 + 8 * c; *(f32x4*)f = (f32x4){a0, a1, a2, a3}; *(f32x4*)(f + 4) = (f32x4){a4, a5, a6, a7};
                *(v4u*)((bf16*)(ws + WS_WDTB) + (size_t)(n - 5120) * K + k0 + 8 * c) = o; }
            else *(v4u*)(d.WT + (size_t)dr * K + k0 + 8 * c) = o;
        } }
    LDS_WAIT(); asm volatile("" ::: "memory");
}
__device__ __forceinline__ void ph_convert(const Args& a, unsigned char* ws, int l, int mask, LAS unsigned char* lds, int gw, int ngw, int wave, int lane) {
    LAS float* scr = (LAS float*)(lds + wave * 16384);
    const int nitems = cvt_nitems(mask);
    int it = gw; if (it >= nitems) return;
    CvtDesc d0 = cvt_decode(a, ws, l, mask, it); f32x4 v[8]; cvt_load(d0, lane, v);
    for (; it < nitems; it += ngw) {
        const int nx = it + ngw; CvtDesc d1 = d0; f32x4 vn[8];
        if (nx < nitems) { d1 = cvt_decode(a, ws, l, mask, nx); cvt_load(d1, lane, vn); }
        else {
#pragma unroll
            for (int i = 0; i < 8; ++i) vn[i] = v[i]; }
        cvt_store(d0, ws, lane, v, scr);
        d0 = d1;
#pragma unroll
        for (int i = 0; i < 8; ++i) v[i] = vn[i];
    }
}
typedef short bf16x8_t __attribute__((ext_vector_type(8)));
typedef short s16x4_t __attribute__((ext_vector_type(4)));
constexpr int HG_NCH = SEQ / 64;
constexpr int HG_TS = 72;
constexpr int HG_RS = 136;
__device__ __forceinline__ float hg_lb(const float* lg, int l, int ch) {
    float mx = lg[ch];
#pragma unroll
    for (int i = 1; i < DEPTH; ++i) mx = fmaxf(mx, lg[i * 512 + ch]);
    float den = 0.f, num = 0.f;
#pragma unroll
    for (int i = 0; i < DEPTH; ++i) { const float e = __expf(lg[i * 512 + ch] - mx); den += e; if (i >= 1 && i <= l) num += e; }
    return num / den;
}
__device__ __forceinline__ unsigned pkbf(float a, float b) { return pk2(a, b); }
struct HgRaw { bf16 z[16], v[16], q[16]; };
template <bool WITHQ> __device__ __forceinline__ void hg_load(HgRaw& R, unsigned char* ws, int unit, int tid) {
    const bf16* proj = (const bf16*)(ws + WS_HP);
    const int h = unit & 3, chunk = (unit >> 2) & (HG_NCH - 1), b = unit >> 10, qt = tid >> 7, col = tid & 127, ch = h * 128 + col;
    const size_t row0 = (size_t)b * SEQ + (size_t)chunk * 64 + 16 * qt;
#pragma unroll
    for (int i = 0; i < 16; ++i) { const bf16* p = proj + (row0 + i) * NPROJ + ch; R.z[i] = p[PC_AF]; R.v[i] = p[PC_AI]; if (WITHQ) R.q[i] = p[PC_AQ]; }
}
__device__ __forceinline__ void hg_p1_unit(const Args& a, unsigned char* ws, int l, int unit, int next, HgRaw& R, LAS unsigned char* lds, int tid_in) {
    int tid = tid_in; asm volatile("" : "+v"(tid));
    const bf16* proj = (const bf16*)(ws + WS_HP); bf16* UT = (bf16*)(ws + WS_HGU); float* DCH = (float*)(ws + WS_HGD);
    const int h = unit & 3, chunk = (unit >> 2) & (HG_NCH - 1), b = unit >> 10;
    const int qt = tid >> 7, col = tid & 127, ch = h * 128 + col, lane = tid & 63, wave = tid >> 6;
    LAS bf16* kT = (LAS bf16*)lds; LAS bf16* vT = kT + 128 * HG_TS; LAS float* tots = (LAS float*)(vT + 128 * HG_TS);
    const float lb = hg_lb(a.in[I_LBL], l, ch);
    const size_t row0 = (size_t)b * SEQ + (size_t)chunk * 64 + 16 * qt;
    float suf[16], kk[16], vv[16];
    { float ff[16];
#pragma unroll
      for (int i = 0; i < 16; ++i) { const float z = bf2f(R.z[i]); vv[i] = bf2f(R.v[i]);
          const float sg = sigmoidf_(z); ff[i] = lb + (1.0f - lb) * sg; kk[i] = (1.0f - lb) * (1.0f - sg); }
      float run = 1.0f;
#pragma unroll
      for (int i = 15; i >= 0; --i) { suf[i] = run; run *= ff[i]; }
      tots[qt * 128 + col] = run; }
    if (next >= 0) hg_load<false>(R, ws, next, tid);
    __syncthreads();
    float post = 1.0f, total = 1.0f;
#pragma unroll
    for (int q = 0; q < 4; ++q) { const float t = tots[q * 128 + col]; total *= t; if (q > qt) post *= t; }
    { unsigned wk[8], wv[8];
#pragma unroll
      for (int i = 0; i < 8; ++i) { const float e0 = kk[2 * i] * (suf[2 * i] * post), e1 = kk[2 * i + 1] * (suf[2 * i + 1] * post); wk[i] = pkbf(e0, e1); wv[i] = pkbf(vv[2 * i], vv[2 * i + 1]); }
      LAS v4u* pk = (LAS v4u*)(kT + col * HG_TS + 16 * qt); LAS v4u* pv = (LAS v4u*)(vT + col * HG_TS + 16 * qt);
      pk[0] = (v4u){wk[0], wk[1], wk[2], wk[3]}; pk[1] = (v4u){wk[4], wk[5], wk[6], wk[7]}; pv[0] = (v4u){wv[0], wv[1], wv[2], wv[3]}; pv[1] = (v4u){wv[4], wv[5], wv[6], wv[7]}; }
    const size_t ubase = ((size_t)(b * 4 + h) * HG_NCH + chunk);
    if (qt == 0) DCH[ubase * 128 + col] = total;
    __syncthreads();
    { const int fr = lane & 15, g = lane >> 4;
      bf16x8_t af[2];
#pragma unroll
      for (int ks = 0; ks < 2; ++ks) af[ks] = *(const LAS bf16x8_t*)(kT + (16 * wave + fr) * HG_TS + 8 * g + 32 * ks);
      bf16* up = UT + ubase * 16384 + (size_t)fr * 128 + 16 * wave + 4 * g;
#pragma unroll
      for (int n = 0; n < 8; ++n) { pg8::f32x4 acc = {0.f, 0.f, 0.f, 0.f};
#pragma unroll
          for (int ks = 0; ks < 2; ++ks) { const bf16x8_t bfr = *(const LAS bf16x8_t*)(vT + (16 * n + fr) * HG_TS + 8 * g + 32 * ks); acc = __builtin_amdgcn_mfma_f32_16x16x32_bf16(af[ks], bfr, acc, 0, 0, 0); }
          *(v2u*)(up + (size_t)(16 * n) * 128) = (v2u){pkbf(acc[0], acc[1]), pkbf(acc[2], acc[3])}; } }
    __syncthreads();
}
__device__ __forceinline__ void hg_p2_item(unsigned char* ws, int item, int tid) {
    const bf16* UT = (const bf16*)(ws + WS_HGU); const float* DCH = (const float*)(ws + WS_HGD); bf16* SPT = (bf16*)(ws + WS_HGS);
    const int bh = item >> 4, v = (item & 15) * 8 + (tid >> 6), k = 2 * (tid & 63);
    typedef float f32x2 __attribute__((ext_vector_type(2)));
    const size_t cb = (size_t)bh * HG_NCH;
    float s0 = 0.f, s1 = 0.f; constexpr int U = 8;
    unsigned ru[U]; f32x2 rd[U];
#pragma unroll
    for (int i = 0; i < U; ++i) { ru[i] = *(const unsigned*)(UT + (cb + i) * 16384 + v * 128 + k); rd[i] = *(const f32x2*)(DCH + (cb + i) * 128 + k); }
    for (int c0 = 0; c0 < HG_NCH; c0 += U) {
        unsigned cu[U]; f32x2 cd[U];
#pragma unroll
        for (int i = 0; i < U; ++i) { cu[i] = ru[i]; cd[i] = rd[i]; }
        if (c0 + U < HG_NCH) {
#pragma unroll
            for (int i = 0; i < U; ++i) { ru[i] = *(const unsigned*)(UT + (cb + c0 + U + i) * 16384 + v * 128 + k); rd[i] = *(const f32x2*)(DCH + (cb + c0 + U + i) * 128 + k); } }
#pragma unroll
        for (int i = 0; i < U; ++i) { *(unsigned*)(SPT + (cb + c0 + i) * 16384 + v * 128 + k) = pkbf(s0, s1); s0 = cd[i].x * s0 + bflo(cu[i]); s1 = cd[i].y * s1 + bfhi(cu[i]); }
    }
}
__device__ __forceinline__ void hg_p3_unit(const Args& a, unsigned char* ws, int l, int unit, int next, HgRaw& R, LAS unsigned char* lds, int tid_in) {
    int tid = tid_in; asm volatile("" : "+v"(tid));
    const bf16* proj = (const bf16*)(ws + WS_HP); const bf16* SPT = (const bf16*)(ws + WS_HGS); bf16* Y = (bf16*)(ws + WS_Y);
    const int h = unit & 3, chunk = (unit >> 2) & (HG_NCH - 1), b = unit >> 10;
    const int qt = tid >> 7, col = tid & 127, ch = h * 128 + col, lane = tid & 63, wave = tid >> 6, fr = lane & 15, g = lane >> 4;
    LAS bf16* Qm = (LAS bf16*)lds; LAS bf16* Qs = Qm + 64 * HG_RS; LAS bf16* Km = Qs + 64 * HG_RS; LAS bf16* vT = Km + 64 * HG_RS; LAS bf16* PT = vT + 128 * HG_TS;
    LAS float* tots = (LAS float*)(PT + 64 * HG_TS); LAS float* ssq = tots + 512;
    const float lb = hg_lb(a.in[I_LBL], l, ch);
    const size_t rowc = (size_t)b * SEQ + (size_t)chunk * 64, row0 = rowc + 16 * qt;
    bf16x8_t sf[4]; v2u grv[4];
    { const size_t sbase = ((size_t)(b * 4 + h) * HG_NCH + chunk) * 16384 + (size_t)(16 * wave + fr) * 128 + 8 * g;
#pragma unroll
      for (int ks = 0; ks < 4; ++ks) sf[ks] = *(const bf16x8_t*)(SPT + sbase + 32 * ks);
#pragma unroll
      for (int j = 0; j < 4; ++j) grv[j] = *(const v2u*)(proj + (rowc + 16 * j + fr) * NPROJ + PC_AG + h * 128 + 16 * wave + 4 * g); }
    float rr[16], kk[16], qq[16], vv[16];
    { float ff[16];
#pragma unroll
      for (int i = 0; i < 16; ++i) { const float z = bf2f(R.z[i]); vv[i] = bf2f(R.v[i]); qq[i] = siluf_(bf2f(R.q[i]));
          const float sg = sigmoidf_(z); ff[i] = lb + (1.0f - lb) * sg; kk[i] = (1.0f - lb) * (1.0f - sg); }
      float run = 1.0f;
      if (qt < 2) {
#pragma unroll
          for (int i = 15; i >= 0; --i) { rr[i] = run; run *= ff[i]; }
      } else {
#pragma unroll
          for (int i = 0; i < 16; ++i) { run *= ff[i]; rr[i] = run; } }
      tots[qt * 128 + col] = run; }
    if (next >= 0) hg_load<true>(R, ws, next, tid);
    if (tid < 128) { const int which = tid >> 6, t = (which ? 32 : 0) + ((tid & 63) >> 2), sq = (which ? 48 : 16) + 4 * (tid & 3); unsigned z0 = 0u; asm volatile("" : "+v"(z0));     *(LAS v2u*)(PT + t * HG_TS + sq) = (v2u){z0, z0}; }
    __syncthreads();
    const float t0_ = tots[col], t1_ = tots[128 + col], t2_ = tots[256 + col];
    const float em = t0_ * t1_, xq = (qt == 0) ? t1_ : (qt == 3) ? t2_ : 1.0f;
    { unsigned wv[8];
#pragma unroll
      for (int i = 0; i < 16; ++i) { const float rv = fmaxf(rr[i] * xq, 1e-30f), ri = __builtin_amdgcn_rcpf(rv); const int t = 16 * qt + i;
          const float ea = (qt < 2) ? ri : rv, eb = (qt < 2) ? rv : ri;
          Qm[t * HG_RS + col] = (bf16)f2bf(qq[i] * ea); Qs[t * HG_RS + col] = (bf16)f2bf(qq[i] * (em * ea)); Km[t * HG_RS + col] = (bf16)f2bf(kk[i] * eb); }
#pragma unroll
      for (int i = 0; i < 8; ++i) wv[i] = pkbf(vv[2 * i], vv[2 * i + 1]);
      LAS v4u* pv = (LAS v4u*)(vT + col * HG_TS + 16 * qt); pv[0] = (v4u){wv[0], wv[1], wv[2], wv[3]}; pv[1] = (v4u){wv[4], wv[5], wv[6], wv[7]}; }
    __syncthreads();
    for (int tt = wave; tt < 10; tt += 8) {
        int ti, tj; { const int ii[10] = {0, 0, 0, 0, 1, 1, 1, 2, 2, 3}, jj[10] = {0, 1, 2, 3, 1, 2, 3, 2, 3, 3}; ti = ii[0]; tj = jj[0];
#pragma unroll
          for (int q = 1; q < 10; ++q) if (tt == q) { ti = ii[q]; tj = jj[q]; } }
        pg8::f32x4 acc = {0.f, 0.f, 0.f, 0.f};
#pragma unroll
        for (int ks = 0; ks < 4; ++ks) { const bf16x8_t af = *(const LAS bf16x8_t*)(Km + (16 * ti + fr) * HG_RS + 8 * g + 32 * ks), bfr = *(const LAS bf16x8_t*)(Qm + (16 * tj + fr) * HG_RS + 8 * g + 32 * ks);
            acc = __builtin_amdgcn_mfma_f32_16x16x32_bf16(af, bfr, acc, 0, 0, 0); }
        const int t = 16 * tj + fr, s0 = 16 * ti + 4 * g;
#pragma unroll
        for (int r = 0; r < 4; ++r) if (s0 + r > t) acc[r] = 0.f;
        *(LAS v2u*)(PT + t * HG_TS + s0) = (v2u){pkbf(acc[0], acc[1]), pkbf(acc[2], acc[3])};
    }
    __syncthreads();
    pg8::f32x4 o[4];
    { bf16x8_t vf[2];
#pragma unroll
      for (int ks = 0; ks < 2; ++ks) vf[ks] = *(const LAS bf16x8_t*)(vT + (16 * wave + fr) * HG_TS + 8 * g + 32 * ks);
#pragma unroll
      for (int j = 0; j < 4; ++j) { pg8::f32x4 acc = {0.f, 0.f, 0.f, 0.f};
#pragma unroll
          for (int ks = 0; ks < 4; ++ks) { const bf16x8_t bfr = *(const LAS bf16x8_t*)(Qs + (16 * j + fr) * HG_RS + 8 * g + 32 * ks); acc = __builtin_amdgcn_mfma_f32_16x16x32_bf16(sf[ks], bfr, acc, 0, 0, 0); }
#pragma unroll
          for (int ks = 0; ks < 2; ++ks) if (ks == 0 || j >= 2) { const bf16x8_t bfr = *(const LAS bf16x8_t*)(PT + (16 * j + fr) * HG_TS + 8 * g + 32 * ks); acc = __builtin_amdgcn_mfma_f32_16x16x32_bf16(vf[ks], bfr, acc, 0, 0, 0); }
          o[j] = acc; } }
#pragma unroll
    for (int j = 0; j < 4; ++j) { float s = (o[j][0] * o[j][0] + o[j][1] * o[j][1]) + (o[j][2] * o[j][2] + o[j][3] * o[j][3]); s += __shfl_xor(s, 16); s += __shfl_xor(s, 32); if (g == 0) ssq[wave * 64 + 16 * j + fr] = s; }
    __syncthreads();
    { const float* nw = a.in[I_HGN] + l * 512 + h * 128 + 16 * wave + 4 * g; const float w0 = nw[0], w1 = nw[1], w2 = nw[2], w3 = nw[3];
#pragma unroll
      for (int j = 0; j < 4; ++j) { const int t = 16 * j + fr; float s = 0.f;
#pragma unroll
          for (int w = 0; w < 8; ++w) s += ssq[w * 64 + t];
          const float r = 1.0f / sqrtf(s * (1.0f / 128.0f) + NORM_EPS);
          const v2u gr = grv[j];
          const float y0 = o[j][0] * r * w0 * siluf_(bflo(gr.x)), y1 = o[j][1] * r * w1 * siluf_(bfhi(gr.x)), y2 = o[j][2] * r * w2 * siluf_(bflo(gr.y)), y3 = o[j][3] * r * w3 * siluf_(bfhi(gr.y));
          *(v2u*)(Y + (rowc + t) * DM + h * 128 + 16 * wave + 4 * g) = (v2u){pkbf(y0, y1), pkbf(y2, y3)}; } }
    __syncthreads();
}
constexpr int SD_TS = 72, SD_RS = 136;
#define SD_CONV8(dst, tok0) do { _Pragma("unroll") for (int i_ = 0; i_ < 8; ++i_) { const float xn_ = bf2f(xr[(tok0) + i_]); \
        const float y_ = cb + cw0 * xm3 + cw1 * xm2 + cw2 * xm1 + cw3 * xn_; xm3 = xm2; xm2 = xm1; xm1 = xn_; dst[i_] = siluf_(y_); } } while (0)
__device__ __forceinline__ void sd_p1_unit(const Args& a, unsigned char* ws, int l, const rs_t* rowss, int unit, LAS unsigned char* lds, int tid_in) {
    int tid = tid_in; asm volatile("" : "+v"(tid));
    const bf16* proj = (const bf16*)(ws + WS_HP); const bf16* xb = (const bf16*)(ws + WS_XB); const bf16* wdtb = (const bf16*)(ws + WS_WDTB);
    bf16* STATES = (bf16*)(ws + WS_SDST); float* CDEC = (float*)(ws + WS_CDEC); float* DTV = (float*)(ws + WS_DTV);
    const int chunk = unit & 255, b = unit >> 8, lane = tid & 63, wave = tid >> 6, fr = lane & 15, g = lane >> 4;
    const size_t row0 = (size_t)b * SEQ + (size_t)chunk * 64;
    LAS float* dtl = (LAS float*)lds; LAS float* acs = dtl + 512;
    LAS float* part = (LAS float*)(lds + 4096);
    LAS bf16* XT = (LAS bf16*)(lds + 4096); LAS bf16* BT = XT + 512 * SD_TS;
    { pg8::f32x4 acc[4];
#pragma unroll
      for (int tt = 0; tt < 4; ++tt) acc[tt] = (pg8::f32x4){0.f, 0.f, 0.f, 0.f};
#pragma unroll 4
      for (int ks = 0; ks < 8; ++ks) { const int k = 256 * wave + 32 * ks + 8 * g;
          bf16x8_t bfr = {0, 0, 0, 0, 0, 0, 0, 0}; if (fr < 8) bfr = *(const bf16x8_t*)(wdtb + fr * DM + k);
#pragma unroll
          for (int tt = 0; tt < 4; ++tt) { const bf16x8_t af = *(const bf16x8_t*)(xb + (row0 + 16 * tt + fr) * DM + k); acc[tt] = __builtin_amdgcn_mfma_f32_16x16x32_bf16(af, bfr, acc[tt], 0, 0, 0); } }
      if (fr < 8) {
#pragma unroll
          for (int tt = 0; tt < 4; ++tt)
#pragma unroll
              for (int r = 0; r < 4; ++r) part[(wave * 64 + 16 * tt + 4 * g + r) * 8 + fr] = acc[tt][r]; } }
    __syncthreads();
    { const int t = tid >> 3, h = tid & 7; float s = 0.f;
#pragma unroll
      for (int w = 0; w < 8; ++w) s += part[(w * 64 + t) * 8 + h];
      const float r = 1.0f / sqrtf((float)rowss[row0 + t] * (RS_INV / DM) + NORM_EPS);
      const float dt = softplusf_(s * r + a.in[I_SDTB][l * 8 + h]); dtl[t * 8 + h] = dt; DTV[(row0 + t) * 8 + h] = dt; }
    __syncthreads();
    if (tid < 8) { const float An = -__expf(a.in[I_SALOG][l * 8 + tid]); float run = 0.f; for (int t = 0; t < 64; ++t) { run += dtl[t * 8 + tid] * An; acs[t * 8 + tid] = run; }
        CDEC[(size_t)(b * 256 + chunk) * 8 + tid] = __expf(run); }
    __syncthreads();
    { const float* cwp = a.in[I_SCW] + (size_t)l * 4 * 1024; const float* cbp = a.in[I_SCB] + (size_t)l * 1024;
#pragma unroll
      for (int pass = 0; pass < 2; ++pass) { if (pass == 1 && tid >= 256) break;
          const int c = pass * 512 + tid; const float cw0 = cwp[c], cw1 = cwp[1024 + c], cw2 = cwp[2048 + c], cw3 = cwp[3072 + c], cb = cbp[c];
          const bf16* xp = proj + row0 * NPROJ + PC_CX + c;
          float xm3 = 0.f, xm2 = 0.f, xm1 = 0.f; if (chunk > 0) { xm3 = bf2f(xp[-3 * (ptrdiff_t)NPROJ]); xm2 = bf2f(xp[-2 * (ptrdiff_t)NPROJ]); xm1 = bf2f(xp[-(ptrdiff_t)NPROJ]); }
          const int h = tid >> 6; const float al = acs[63 * 8 + h];
          LAS bf16* dst = (pass == 0) ? (XT + tid * SD_TS) : (BT + tid * SD_TS);
          bf16 xr[64];
#pragma unroll
          for (int t = 0; t < 64; ++t) xr[t] = xp[(ptrdiff_t)t * NPROJ];
#pragma unroll
          for (int s8 = 0; s8 < 8; ++s8) { float v[8]; SD_CONV8(v, 8 * s8);
              if (pass == 0) {
#pragma unroll
                  for (int i = 0; i < 8; ++i) { const int s = 8 * s8 + i; v[i] *= dtl[s * 8 + h] * __expf(al - acs[s * 8 + h]); } }
              *(LAS v4u*)(dst + 8 * s8) = (v4u){pkbf(v[0], v[1]), pkbf(v[2], v[3]), pkbf(v[4], v[5]), pkbf(v[6], v[7])}; } } }
    __syncthreads();
    { const int grp = wave >> 2; bf16* sp = STATES + ((size_t)(b * 256 + chunk) * 8 + wave) * 8192;
#pragma unroll 1
      for (int mt = 0; mt < 4; ++mt) { bf16x8_t bfx[2];
#pragma unroll
          for (int ks = 0; ks < 2; ++ks) bfx[ks] = *(const LAS bf16x8_t*)(XT + (wave * 64 + 16 * mt + fr) * SD_TS + 8 * g + 32 * ks);
#pragma unroll
          for (int nt = 0; nt < 8; ++nt) { pg8::f32x4 acc = {0.f, 0.f, 0.f, 0.f};
#pragma unroll
              for (int ks = 0; ks < 2; ++ks) { const bf16x8_t afn = *(const LAS bf16x8_t*)(BT + (grp * 128 + 16 * nt + fr) * SD_TS + 8 * g + 32 * ks); acc = __builtin_amdgcn_mfma_f32_16x16x32_bf16(afn, bfx[ks], acc, 0, 0, 0); }
              *(v2u*)(sp + (16 * mt + fr) * 128 + 16 * nt + 4 * g) = (v2u){pkbf(acc[0], acc[1]), pkbf(acc[2], acc[3])}; } } }
    __syncthreads();
}
__device__ __forceinline__ void sd_p2_item(unsigned char* ws, int item, int tid) {
    const bf16* STATES = (const bf16*)(ws + WS_SDST); const float* CDEC = (const float*)(ws + WS_CDEC); bf16* PREV = (bf16*)(ws + WS_SDPV);
    const int bh = item >> 3, b = bh >> 3, h = bh & 7, p = (item & 7) * 8 + (tid >> 6), n = 2 * (tid & 63);
    typedef float f32x2 __attribute__((ext_vector_type(2)));
    float s0 = 0.f, s1 = 0.f; constexpr int U = 8;
    unsigned ru[U]; float rd[U];
#define SD_IDX(c_) (((size_t)(b * 256 + (c_)) * 8 + h) * 8192 + p * 128 + n)
#pragma unroll
    for (int i = 0; i < U; ++i) { ru[i] = *(const unsigned*)(STATES + SD_IDX(i)); rd[i] = CDEC[(size_t)(b * 256 + i) * 8 + h]; }
    for (int c0 = 0; c0 < 256; c0 += U) {
        unsigned cu[U]; float cd[U];
#pragma unroll
        for (int i = 0; i < U; ++i) { cu[i] = ru[i]; cd[i] = rd[i]; }
        if (c0 + U < 256) {
#pragma unroll
            for (int i = 0; i < U; ++i) { ru[i] = *(const unsigned*)(STATES + SD_IDX(c0 + U + i)); rd[i] = CDEC[(size_t)(b * 256 + c0 + U + i) * 8 + h]; } }
#pragma unroll
        for (int i = 0; i < U; ++i) { *(unsigned*)(PREV + SD_IDX(c0 + i)) = pkbf(s0, s1); s0 = cd[i] * s0 + bflo(cu[i]); s1 = cd[i] * s1 + bfhi(cu[i]); }
    }
#undef SD_IDX
}
__device__ __forceinline__ void sd_p3_unit(const Args& a, unsigned char* ws, int l, int unit, LAS unsigned char* lds, int tid_in) {
    int tid = tid_in; asm volatile("" : "+v"(tid));
    const bf16* proj = (const bf16*)(ws + WS_HP); const bf16* PREV = (const bf16*)(ws + WS_SDPV); const float* DTV = (const float*)(ws + WS_DTV); bf16* Y = (bf16*)(ws + WS_Y);
    const int grp = unit & 1, chunk = (unit >> 1) & 255, b = unit >> 9, lane = tid & 63, wave = tid >> 6, fr = lane & 15, g = lane >> 4;
    const size_t row0 = (size_t)b * SEQ + (size_t)chunk * 64;
    LAS float* dtl = (LAS float*)lds; LAS float* acs = dtl + 256; LAS float* ssq = acs + 256;
    LAS bf16* XT = (LAS bf16*)(lds + 4096); LAS bf16* Brm = XT + 256 * SD_TS; LAS bf16* Crm = Brm + 64 * SD_RS;
    if (tid < 256) { const int t = tid >> 2, hh = tid & 3; dtl[t * 4 + hh] = DTV[(row0 + t) * 8 + 4 * grp + hh]; }
    v2u zrv[2][4];
    { const int hh_ = wave >> 1, half_ = wave & 1;
#pragma unroll
      for (int pt = 0; pt < 2; ++pt) {
#pragma unroll
          for (int j = 0; j < 4; ++j) zrv[pt][j] = *(const v2u*)(proj + (row0 + 16 * j + fr) * NPROJ + PC_CZ + grp * 256 + hh_ * 64 + 16 * (2 * half_ + pt) + 4 * g); } }
    __syncthreads();
    if (tid < 4) { const float An = -__expf(a.in[I_SALOG][l * 8 + 4 * grp + tid]); float run = 0.f; for (int t = 0; t < 64; ++t) { run += dtl[t * 4 + tid] * An; acs[t * 4 + tid] = run; } }
    { const float* cwp = a.in[I_SCW] + (size_t)l * 4 * 1024; const float* cbp = a.in[I_SCB] + (size_t)l * 1024;
      const int c = (tid < 256) ? (grp * 256 + tid) : (tid < 384) ? (512 + grp * 128 + (tid - 256)) : (768 + grp * 128 + (tid - 384));
      const float cw0 = cwp[c], cw1 = cwp[1024 + c], cw2 = cwp[2048 + c], cw3 = cwp[3072 + c], cb = cbp[c];
      const bf16* xp = proj + row0 * NPROJ + PC_CX + c;
      float xm3 = 0.f, xm2 = 0.f, xm1 = 0.f; if (chunk > 0) { xm3 = bf2f(xp[-3 * (ptrdiff_t)NPROJ]); xm2 = bf2f(xp[-2 * (ptrdiff_t)NPROJ]); xm1 = bf2f(xp[-(ptrdiff_t)NPROJ]); }
      bf16 xr[64];
#pragma unroll
      for (int t = 0; t < 64; ++t) xr[t] = xp[(ptrdiff_t)t * NPROJ];
#pragma unroll
      for (int s8 = 0; s8 < 8; ++s8) { float v[8]; SD_CONV8(v, 8 * s8);
          if (tid < 256) *(LAS v4u*)(XT + tid * SD_TS + 8 * s8) = (v4u){pkbf(v[0], v[1]), pkbf(v[2], v[3]), pkbf(v[4], v[5]), pkbf(v[6], v[7])};
          else { LAS bf16* d = ((tid < 384) ? Brm : Crm) + (8 * s8) * SD_RS + ((tid - 256) & 127);
#pragma unroll
              for (int i = 0; i < 8; ++i) d[i * SD_RS] = (bf16)f2bf(v[i]); } } }
    __syncthreads();
    const int hh = wave >> 1, half = wave & 1, hd = 4 * grp + hh;
    bf16x8_t mf[4][2];
    { const float Dk = a.in[I_SD][l * 8 + hd];
      float acl[4], acsv[16], dts[16];
#pragma unroll
      for (int j = 0; j < 4; ++j) acl[j] = acs[(16 * j + fr) * 4 + hh];
#pragma unroll
      for (int i = 0; i < 4; ++i)
#pragma unroll
          for (int r = 0; r < 4; ++r) { acsv[4 * i + r] = acs[(16 * i + 4 * g + r) * 4 + hh]; dts[4 * i + r] = dtl[(16 * i + 4 * g + r) * 4 + hh]; }
#pragma unroll
      for (int j = 0; j < 4; ++j) { unsigned pw[4][2];
#pragma unroll
          for (int i = 0; i < 4; ++i) { pw[i][0] = 0u; pw[i][1] = 0u;
              if (i <= j) { pg8::f32x4 acc = {0.f, 0.f, 0.f, 0.f};
#pragma unroll
                  for (int ks = 0; ks < 4; ++ks) { const bf16x8_t af = *(const LAS bf16x8_t*)(Brm + (16 * i + fr) * SD_RS + 8 * g + 32 * ks), bfr = *(const LAS bf16x8_t*)(Crm + (16 * j + fr) * SD_RS + 8 * g + 32 * ks);
                      acc = __builtin_amdgcn_mfma_f32_16x16x32_bf16(af, bfr, acc, 0, 0, 0); }
                  float m[4];
#pragma unroll
                  for (int r = 0; r < 4; ++r) { const int s = 16 * i + 4 * g + r, ll = 16 * j + fr; float v = acc[r] * __expf(fminf(acl[j] - acsv[4 * i + r], 0.f)) * dts[4 * i + r]; if (s > ll) v = 0.f; if (s == ll) v += Dk; m[r] = v; }
                  pw[i][0] = pkbf(m[0], m[1]); pw[i][1] = pkbf(m[2], m[3]); } }
          mf[j][0] = __builtin_bit_cast(bf16x8_t, (v4u){pw[0][0], pw[0][1], pw[1][0], pw[1][1]}); mf[j][1] = __builtin_bit_cast(bf16x8_t, (v4u){pw[2][0], pw[2][1], pw[3][0], pw[3][1]}); } }
    pg8::f32x4 yv[2][4];
    { const bf16* pv = PREV + ((size_t)(b * 256 + chunk) * 8 + hd) * 8192;
#pragma unroll
      for (int pt = 0; pt < 2; ++pt) { const int prow = 16 * (2 * half + pt) + fr;
          bf16x8_t pf[4];
#pragma unroll
          for (int ks = 0; ks < 4; ++ks) pf[ks] = *(const bf16x8_t*)(pv + prow * 128 + 8 * g + 32 * ks);
          bf16x8_t xf[2];
#pragma unroll
          for (int ks = 0; ks < 2; ++ks) { const v2u lo = *(const LAS v2u*)(XT + (hh * 64 + prow) * SD_TS + 32 * ks + 4 * g), hi = *(const LAS v2u*)(XT + (hh * 64 + prow) * SD_TS + 32 * ks + 16 + 4 * g);
              xf[ks] = __builtin_bit_cast(bf16x8_t, (v4u){lo.x, lo.y, hi.x, hi.y}); }
#pragma unroll
          for (int j = 0; j < 4; ++j) { pg8::f32x4 off = {0.f, 0.f, 0.f, 0.f};
#pragma unroll
              for (int ks = 0; ks < 4; ++ks) { const bf16x8_t bfr = *(const LAS bf16x8_t*)(Crm + (16 * j + fr) * SD_RS + 8 * g + 32 * ks); off = __builtin_amdgcn_mfma_f32_16x16x32_bf16(pf[ks], bfr, off, 0, 0, 0); }
              const float el = __expf(acs[(16 * j + fr) * 4 + hh]);
              pg8::f32x4 acc = off * el;
              acc = __builtin_amdgcn_mfma_f32_16x16x32_bf16(xf[0], mf[j][0], acc, 0, 0, 0);
              if (j >= 2) acc = __builtin_amdgcn_mfma_f32_16x16x32_bf16(xf[1], mf[j][1], acc, 0, 0, 0);
              yv[pt][j] = acc; } } }
    const int cbase = grp * 256 + hh * 64;
#pragma unroll
    for (int j = 0; j < 4; ++j) { const int ll = 16 * j + fr; float s = 0.f;
#pragma unroll
        for (int pt = 0; pt < 2; ++pt) { const v2u zr = zrv[pt][j];
            yv[pt][j][0] *= siluf_(bflo(zr.x)); yv[pt][j][1] *= siluf_(bfhi(zr.x)); yv[pt][j][2] *= siluf_(bflo(zr.y)); yv[pt][j][3] *= siluf_(bfhi(zr.y));
            s += (yv[pt][j][0] * yv[pt][j][0] + yv[pt][j][1] * yv[pt][j][1]) + (yv[pt][j][2] * yv[pt][j][2] + yv[pt][j][3] * yv[pt][j][3]); }
        s += __shfl_xor(s, 16); s += __shfl_xor(s, 32); if (g == 0) ssq[wave * 64 + ll] = s; }
    __syncthreads();
#pragma unroll
    for (int j = 0; j < 4; ++j) { const int ll = 16 * j + fr; float s = 0.f;
#pragma unroll
        for (int w = 0; w < 8; ++w) s += ssq[w * 64 + ll];
        const float r = 1.0f / sqrtf(s * (1.0f / 256.0f) + NORM_EPS);
#pragma unroll
        for (int pt = 0; pt < 2; ++pt) { const int cc = cbase + 16 * (2 * half + pt) + 4 * g; const float* nw = a.in[I_SNORM] + l * 512 + cc;
            *(v2u*)(Y + (row0 + ll) * DM + 1024 + cc) = (v2u){pkbf(yv[pt][j][0] * r * nw[0], yv[pt][j][1] * r * nw[1]), pkbf(yv[pt][j][2] * r * nw[2], yv[pt][j][3] * r * nw[3])}; } }
    __syncthreads();
}
constexpr int LR_RS = 520;
struct LruW { bf16x8_t wa[4][2], wx[4][2]; };
__device__ __forceinline__ void lru_load_w(const Args& a, int l, int wave, int lane, LruW& W) {
    const int fr = lane & 15, g = lane >> 4; const float* wa = a.in[I_LWA] + ((size_t)l * 8 + wave) * 4096; const float* wx = a.in[I_LWX] + ((size_t)l * 8 + wave) * 4096;
#pragma unroll
    for (int nt = 0; nt < 4; ++nt)
#pragma unroll
        for (int ks = 0; ks < 2; ++ks) { unsigned pa[4], px[4];
#pragma unroll
            for (int e = 0; e < 4; ++e) { const int i0 = 32 * ks + 8 * g + 2 * e, j = 16 * nt + fr; pa[e] = pkbf(wa[i0 * 64 + j], wa[(i0 + 1) * 64 + j]); px[e] = pkbf(wx[i0 * 64 + j], wx[(i0 + 1) * 64 + j]); }
            W.wa[nt][ks] = __builtin_bit_cast(bf16x8_t, (v4u){pa[0], pa[1], pa[2], pa[3]}); W.wx[nt][ks] = __builtin_bit_cast(bf16x8_t, (v4u){px[0], px[1], px[2], px[3]}); }
}
template <bool FINAL> __device__ __forceinline__ void lru_unit(const Args& a, unsigned char* ws, int l, int unit, const LruW& W, LAS unsigned char* lds, int tid_in) {
    int tid = tid_in; asm volatile("" : "+v"(tid));
    const bf16* proj = (const bf16*)(ws + WS_HP); float* LRA = (float*)(ws + WS_LRA); float* LRH = (float*)(ws + WS_LRH); const float* LRC = (const float*)(ws + WS_LRC); bf16* Y = (bf16*)(ws + WS_Y);
    const int chunk = unit & 255, b = unit >> 8, lane = tid & 63, wave = tid >> 6, fr = lane & 15, g = lane >> 4;
    const size_t row0 = (size_t)b * SEQ + (size_t)chunk * 64;
    LAS bf16* Xrm = (LAS bf16*)lds; LAS bf16* Hrm = Xrm + 64 * LR_RS; LAS float* ssq = (LAS float*)(lds + 2 * 64 * LR_RS * 2); LAS float* rst = ssq + 512;
    { const int c = tid; const float* cwp = a.in[I_LCW] + (size_t)l * 4 * 512; const float cw0 = cwp[c], cw1 = cwp[512 + c], cw2 = cwp[1024 + c], cw3 = cwp[1536 + c], cb = a.in[I_LCB][l * 512 + c];
      const bf16* xp = proj + row0 * NPROJ + PC_DX + c;
      float xm3 = 0.f, xm2 = 0.f, xm1 = 0.f; if (chunk > 0) { xm3 = bf2f(xp[-3 * (ptrdiff_t)NPROJ]); xm2 = bf2f(xp[-2 * (ptrdiff_t)NPROJ]); xm1 = bf2f(xp[-(ptrdiff_t)NPROJ]); }
      bf16 xr[64];
#pragma unroll
      for (int t = 0; t < 64; ++t) xr[t] = xp[(ptrdiff_t)t * NPROJ];
#pragma unroll
      for (int t = 0; t < 64; ++t) { const float xn = bf2f(xr[t]); const float y = cb + cw0 * xm3 + cw1 * xm2 + cw2 * xm1 + cw3 * xn; xm3 = xm2; xm2 = xm1; xm1 = xn; Xrm[t * LR_RS + c] = (bf16)f2bf(y); } }
    __syncthreads();
    float ssp[4][4];
#pragma unroll
    for (int mt = 0; mt < 4; ++mt)
#pragma unroll
        for (int r = 0; r < 4; ++r) ssp[mt][r] = 0.f;
#pragma unroll
    for (int nt = 0; nt < 4; ++nt) {
        const int c = wave * 64 + 16 * nt + fr;
        const float ba = a.in[I_LBA][l * 512 + c], bx = a.in[I_LBX][l * 512 + c], spn = softplusf_(-a.in[I_LAP][l * 512 + c]);
        float av[4][4], bv[4][4]; const float carry0 = FINAL ? LRC[((size_t)b * 256 + chunk) * 512 + c] : 0.f;
#pragma unroll
        for (int mt = 0; mt < 4; ++mt) { pg8::f32x4 ra = {0.f, 0.f, 0.f, 0.f}, ri = {0.f, 0.f, 0.f, 0.f};
#pragma unroll
            for (int ks = 0; ks < 2; ++ks) { const bf16x8_t af = *(const LAS bf16x8_t*)(Xrm + (16 * mt + fr) * LR_RS + wave * 64 + 32 * ks + 8 * g);
                ra = __builtin_amdgcn_mfma_f32_16x16x32_bf16(af, W.wa[nt][ks], ra, 0, 0, 0); ri = __builtin_amdgcn_mfma_f32_16x16x32_bf16(af, W.wx[nt][ks], ri, 0, 0, 0); }
#pragma unroll
            for (int r = 0; r < 4; ++r) { const float rg = sigmoidf_(ra[r] + ba), ig = sigmoidf_(ri[r] + bx), la = -8.0f * rg * spn, xc = bf2f(Xrm[(16 * mt + 4 * g + r) * LR_RS + c]);
                const float x2 = 2.0f * la, em = (x2 > -0.25f) ? -x2 * (1.0f + x2 * (0.5f + x2 * (0.16666667f + x2 * (0.041666668f + x2 * 0.0083333338f)))) : 1.0f - __expf(x2);
                av[mt][r] = __expf(la); bv[mt][r] = __builtin_amdgcn_sqrtf(fmaxf(em, 0.f)) * (ig * xc); } }
        float carry = carry0, atot = 1.f;
#pragma unroll
        for (int mt = 0; mt < 4; ++mt) {
            float As = av[mt][0], Hs = bv[mt][0];
#pragma unroll
            for (int r = 1; r < 4; ++r) { Hs = av[mt][r] * Hs + bv[mt][r]; As *= av[mt][r]; }
            float Ai = As, Hi = Hs;
            { const float Ap = __shfl_up(Ai, 16), Hp = __shfl_up(Hi, 16); if (g >= 1) { Hi = Ai * Hp + Hi; Ai = Ai * Ap; } }
            { const float Ap = __shfl_up(Ai, 32), Hp = __shfl_up(Hi, 32); if (g >= 2) { Hi = Ai * Hp + Hi; Ai = Ai * Ap; } }
            float Ae = __shfl_up(Ai, 16), He = __shfl_up(Hi, 16); if (g == 0) { Ae = 1.f; He = 0.f; }
            const float At = __shfl(Ai, fr + 48), Ht = __shfl(Hi, fr + 48);
            if (FINAL) { float hc = Ae * carry + He;
#pragma unroll
                for (int r = 0; r < 4; ++r) { hc = av[mt][r] * hc + bv[mt][r]; const float gt = bf2f(proj[(row0 + 16 * mt + 4 * g + r) * NPROJ + PC_DG + c]); const float u2 = 1.5957691216057308f * (gt + 0.044715f * gt * gt * gt); const float o = hc * gt * sigmoidf_(u2);
                    Hrm[(16 * mt + 4 * g + r) * LR_RS + c] = (bf16)f2bf(o); ssp[mt][r] += o * o; } }
            carry = At * carry + Ht; atot *= At;
        }
        if (!FINAL && g == 0) { LRA[((size_t)b * 256 + chunk) * 512 + c] = atot; LRH[((size_t)b * 256 + chunk) * 512 + c] = carry; }
        asm volatile("" ::: "memory");
    }
    if (FINAL) {
#pragma unroll
        for (int mt = 0; mt < 4; ++mt)
#pragma unroll
            for (int r = 0; r < 4; ++r) { float s = ssp[mt][r]; s += __shfl_xor(s, 1); s += __shfl_xor(s, 2); s += __shfl_xor(s, 4); s += __shfl_xor(s, 8); if (fr == 0) ssq[wave * 64 + 16 * mt + 4 * g + r] = s; }
        __syncthreads();
        if (tid < 64) { float s = 0.f;
#pragma unroll
            for (int w = 0; w < 8; ++w) s += ssq[w * 64 + tid];
            rst[tid] = 1.0f / sqrtf(s * (1.0f / 512.0f) + NORM_EPS); }
        __syncthreads();
        { const float* nw = a.in[I_LNORM] + l * 512;
#pragma unroll
          for (int i = 0; i < 8; ++i) { const int item = tid + NTHR * i, t = item >> 6, cg = (item & 63) * 8; const float rs = rst[t]; const v4u hv = *(const LAS v4u*)(Hrm + t * LR_RS + cg);
              const f32x4 w0 = *(const f32x4*)(nw + cg), w1 = *(const f32x4*)(nw + cg + 4);
              v4u o; o.x = pkbf(bflo(hv.x) * rs * w0.x, bfhi(hv.x) * rs * w0.y); o.y = pkbf(bflo(hv.y) * rs * w0.z, bfhi(hv.y) * rs * w0.w); o.z = pkbf(bflo(hv.z) * rs * w1.x, bfhi(hv.z) * rs * w1.y); o.w = pkbf(bflo(hv.w) * rs * w1.z, bfhi(hv.w) * rs * w1.w);
              *(v4u*)(Y + (row0 + t) * DM + 1536 + cg) = o; } }
    }
    __syncthreads();
}
__device__ __forceinline__ void lru_p2_item(unsigned char* ws, int item, int tid) {
    const float* LRA = (const float*)(ws + WS_LRA); const float* LRH = (const float*)(ws + WS_LRH); float* LRC = (float*)(ws + WS_LRC);
    const int idx = item * NTHR + tid, b = idx >> 9, c = idx & 511; const size_t base = (size_t)b * 256 * 512 + c;
    float hh = 0.f; constexpr int U = 16;
    float ra[U], rb[U];
#pragma unroll
    for (int i = 0; i < U; ++i) { ra[i] = LRA[base + (size_t)i * 512]; rb[i] = LRH[base + (size_t)i * 512]; }
    for (int k0 = 0; k0 < 256; k0 += U) {
        float ca[U], cbv[U];
#pragma unroll
        for (int i = 0; i < U; ++i) { ca[i] = ra[i]; cbv[i] = rb[i]; }
        if (k0 + U < 256) {
#pragma unroll
            for (int i = 0; i < U; ++i) { ra[i] = LRA[base + (size_t)(k0 + U + i) * 512]; rb[i] = LRH[base + (size_t)(k0 + U + i) * 512]; } }
#pragma unroll
        for (int i = 0; i < U; ++i) { LRC[base + (size_t)(k0 + i) * 512] = hh; hh = ca[i] * hh + cbv[i]; }
    }
}
typedef short v4i16_t __attribute__((ext_vector_type(4)));
constexpr float AT_DEFER = 8.0f;
constexpr int AT_VS = 72;
template <int KIND> struct AtCfg;
template <> struct AtCfg<0> { static constexpr int NSTEP = 5; };
template <> struct AtCfg<1> { static constexpr int NSTEP = 6 + 5; };
template <int KIND> __device__ __forceinline__ void at_pat(int gs, int& dsh, int& qsh, int& kk0) {
    if (KIND == 0) { dsh = 0; qsh = 0; kk0 = 32 * gs; }
    else { const bool p2 = gs >= 6; dsh = p2 ? 4 : 2; qsh = p2 ? 0 : 2; kk0 = 32 * (p2 ? gs - 6 : gs); }
}
struct AtLoad { bf16x8_t kf[2][2]; v4u vr[4]; };
template <int KIND> __device__ __forceinline__ void at_issue(AtLoad& L, const bf16* proj, size_t rowb, int tb0, int head, int gs, int lane) {
    const int fr = lane & 15, g = lane >> 4; int dsh, qsh, kk0; at_pat<KIND>(gs, dsh, qsh, kk0);
    const char* pb = (const char*)proj; const unsigned rb = (unsigned)rowb;
#pragma unroll
    for (int t2 = 0; t2 < 2; ++t2) { int pos = tb0 + (kk0 + 16 * t2 + fr - 128) * (1 << dsh); pos = max(0, min(pos, SEQ - 1)); const unsigned off = (rb + (unsigned)pos) * (unsigned)(NPROJ * 2) + (unsigned)((PC_BK + head * 64 + 8 * g) * 2);
#pragma unroll
        for (int ks = 0; ks < 2; ++ks) L.kf[t2][ks] = *(const bf16x8_t*)(pb + off + 64 * ks); }
#pragma unroll
    for (int i = 0; i < 4; ++i) { int pos = tb0 + (kk0 + 8 * i + (lane >> 3) - 128) * (1 << dsh); pos = max(0, min(pos, SEQ - 1));
        L.vr[i] = *(const v4u*)(pb + (rb + (unsigned)pos) * (unsigned)(NPROJ * 2) + (unsigned)((PC_BV + head * 64 + 8 * (lane & 7)) * 2)); }
}
template <int KIND> struct AtHead { v4u q[2]; v2u pao[4]; f32x2_t ml; };
template <int KIND> __device__ __forceinline__ void at_unit_pos(int unit, size_t& rowb, int& tb0) { rowb = (size_t)(unit >> 10) * SEQ; tb0 = (KIND == 0) ? 16 * (unit & 1023) : ((unit >> 4) & 63) * 256 + (unit & 15); }
template <int KIND> __device__ __forceinline__ void at_head_load(AtHead<KIND>& H, unsigned char* ws, size_t rowb, int tb0, int head, int lane) {
    const bf16* proj = (const bf16*)(ws + WS_HP); const int fr = lane & 15, g = lane >> 4; const size_t qrow = rowb + tb0 + ((KIND == 0) ? fr : 16 * fr);
    const bf16* qp = proj + qrow * NPROJ + PC_BQ + head * 64 + 8 * g; H.q[0] = *(const v4u*)qp; H.q[1] = *(const v4u*)(qp + 32);
    if (KIND == 1) { const bf16* PAO = (const bf16*)(ws + WS_PAO); const float* PAM = (const float*)(ws + WS_PAM);
#pragma unroll
        for (int dt = 0; dt < 4; ++dt) H.pao[dt] = *(const v2u*)(PAO + qrow * 512 + head * 64 + 16 * dt + 4 * g);
        H.ml = *(const f32x2_t*)(PAM + (qrow * 8 + head) * 2); }
}
template <int KIND> __device__ __forceinline__ void attn_pass(const Args& a, unsigned char* ws, int l, int vcu, int G, LAS unsigned char* lds, int tid) {
    constexpr int NSTEP = AtCfg<KIND>::NSTEP, NUNIT = 2048; static_assert(NSTEP % 3 == 2, "loop shape");
    const bf16* proj = (const bf16*)(ws + WS_HP); bf16* Y = (bf16*)(ws + WS_Y); bf16* PAO = (bf16*)(ws + WS_PAO); float* PAM = (float*)(ws + WS_PAM);
    const int lane = tid & 63, head = tid >> 6, fr = lane & 15, g = lane >> 4;
    LAS bf16* Vb = (LAS bf16*)(lds + head * (32 * AT_VS * 2)); LAS float* ssq = (LAS float*)(lds + 8 * 32 * AT_VS * 2);
    int unit = vcu; if (unit >= NUNIT) return;
    size_t rowb; int tb0; at_unit_pos<KIND>(unit, rowb, tb0);
    AtHead<KIND> H; at_head_load<KIND>(H, ws, rowb, tb0, head, lane);
    AtLoad c0, c1, c2; at_issue<KIND>(c0, proj, rowb, tb0, head, 0, lane); at_issue<KIND>(c1, proj, rowb, tb0, head, 1, lane); c2 = c0;
#pragma unroll 1
    for (;;) {
        const int nunit = unit + G; const bool has_next = nunit < NUNIT; size_t rowb_n = rowb; int tb0_n = tb0; if (has_next) at_unit_pos<KIND>(nunit, rowb_n, tb0_n);
        const size_t qrow = rowb + tb0 + ((KIND == 0) ? fr : 16 * fr);
        bf16x8_t qf[2]; constexpr float QS = 0.125f * 1.4426950408889634f;
#pragma unroll
        for (int ks = 0; ks < 2; ++ks) { const v4u u = H.q[ks];
            qf[ks] = __builtin_bit_cast(bf16x8_t, (v4u){pkbf(bflo(u.x) * QS, bfhi(u.x) * QS), pkbf(bflo(u.y) * QS, bfhi(u.y) * QS), pkbf(bflo(u.z) * QS, bfhi(u.z) * QS), pkbf(bflo(u.w) * QS, bfhi(u.w) * QS)}); }
        v2u pao[4]; float pam = 0.f, pal = 0.f;
        if (KIND == 1) {
#pragma unroll
            for (int dt = 0; dt < 4; ++dt) pao[dt] = H.pao[dt];
            pam = H.ml.x; pal = H.ml.y; }
        pg8::f32x4 o[4];
#pragma unroll
        for (int dt = 0; dt < 4; ++dt) o[dt] = (pg8::f32x4){0.f, 0.f, 0.f, 0.f};
        float mrun = -1e30f, lsum = 0.f;
#define AT_STEP(gs, CUR_, TGT_) do { if ((gs) + 2 < NSTEP) at_issue<KIND>(TGT_, proj, rowb, tb0, head, (gs) + 2, lane); else if (has_next) at_issue<KIND>(TGT_, proj, rowb_n, tb0_n, head, (gs) + 2 - NSTEP, lane); \
        int dsh, qsh, kk0; at_pat<KIND>(gs, dsh, qsh, kk0); \
        const int qlo = fr << qsh, klo = max(qlo, 128 - (tb0 >> dsh)); const unsigned kspan = (unsigned)(qlo + 128 - klo); \
        _Pragma("unroll") \
        for (int i = 0; i < 4; ++i) *(LAS v4u*)(Vb + (8 * i + (lane >> 3)) * AT_VS + 8 * (lane & 7)) = CUR_.vr[i]; \
        pg8::f32x4 st[2]; \
        _Pragma("unroll") \
        for (int t2 = 0; t2 < 2; ++t2) { pg8::f32x4 acc = {0.f, 0.f, 0.f, 0.f}; acc = __builtin_amdgcn_mfma_f32_16x16x32_bf16(CUR_.kf[t2][0], qf[0], acc, 0, 0, 0); acc = __builtin_amdgcn_mfma_f32_16x16x32_bf16(CUR_.kf[t2][1], qf[1], acc, 0, 0, 0); st[t2] = acc; } \
        bool val[2][4]; float mx = -1e30f; \
        _Pragma("unroll") \
        for (int t2 = 0; t2 < 2; ++t2) \
        _Pragma("unroll") \
            for (int r = 0; r < 4; ++r) { const int kk = kk0 + 16 * t2 + 4 * g + r; val[t2][r] = (unsigned)(kk - klo) <= kspan; if (val[t2][r]) mx = fmaxf(mx, st[t2][r]); } \
        if (__builtin_amdgcn_ballot_w64(mx > mrun + AT_DEFER) != 0ull) {       \
            mx = fmaxf(mx, __shfl_xor(mx, 16)); mx = fmaxf(mx, __shfl_xor(mx, 32)); \
            const float mn_ = fmaxf(mrun, mx), corr = __builtin_amdgcn_exp2f(mrun - mn_); mrun = mn_; lsum *= corr; \
            _Pragma("unroll") \
            for (int dt = 0; dt < 4; ++dt) o[dt] = o[dt] * corr; } \
        const float mn = mrun; \
        float p[2][4], ps = 0.f; \
        _Pragma("unroll") \
        for (int t2 = 0; t2 < 2; ++t2) \
        _Pragma("unroll") \
            for (int r = 0; r < 4; ++r) { p[t2][r] = val[t2][r] ? __builtin_amdgcn_exp2f(st[t2][r] - mn) : 0.f; ps += p[t2][r]; } \
        lsum += ps; \
        const bf16x8_t pf = __builtin_bit_cast(bf16x8_t, (v4u){pkbf(p[0][0], p[0][1]), pkbf(p[0][2], p[0][3]), pkbf(p[1][0], p[1][1]), pkbf(p[1][2], p[1][3])}); \
        { const int qq = fr >> 2, pp = fr & 3; \
        _Pragma("unroll") \
          for (int dt = 0; dt < 4; ++dt) { const v4i16_t lo = __builtin_amdgcn_ds_read_tr16_b64_v4i16((LAS v4i16_t*)(Vb + (4 * g + qq) * AT_VS + 16 * dt + 4 * pp)), hi = __builtin_amdgcn_ds_read_tr16_b64_v4i16((LAS v4i16_t*)(Vb + (16 + 4 * g + qq) * AT_VS + 16 * dt + 4 * pp)); \
              const bf16x8_t vf = {lo[0], lo[1], lo[2], lo[3], hi[0], hi[1], hi[2], hi[3]}; \
              o[dt] = __builtin_amdgcn_mfma_f32_16x16x32_bf16(vf, pf, o[dt], 0, 0, 0); } } \
    } while (0)
#pragma unroll 1
        for (int gs = 0; gs + 2 < NSTEP; gs += 3) { AT_STEP((gs), c0, c2); AT_STEP((gs + 1), c1, c0); AT_STEP((gs + 2), c2, c1); }
        if (has_next) at_head_load<KIND>(H, ws, rowb_n, tb0_n, head, lane);
        AT_STEP((NSTEP - 2), c0, c2); AT_STEP((NSTEP - 1), c1, c0);
#undef AT_STEP
        lsum += __shfl_xor(lsum, 16); lsum += __shfl_xor(lsum, 32);
        if (KIND == 0) {
#pragma unroll
            for (int dt = 0; dt < 4; ++dt) *(v2u*)(PAO + qrow * 512 + head * 64 + 16 * dt + 4 * g) = (v2u){pkbf(o[dt][0], o[dt][1]), pkbf(o[dt][2], o[dt][3])};
            if (g == 0) *(f32x2_t*)(PAM + (qrow * 8 + head) * 2) = (f32x2_t){mrun, lsum};
        } else {
            const float mm = fmaxf(mrun, pam), fa = __builtin_amdgcn_exp2f(pam - mm), fb = __builtin_amdgcn_exp2f(mrun - mm), inv = 1.0f / (pal * fa + lsum * fb); float ss = 0.f;
#pragma unroll
            for (int dt = 0; dt < 4; ++dt) { const pg8::f32x4 oa = {bflo(pao[dt].x), bfhi(pao[dt].x), bflo(pao[dt].y), bfhi(pao[dt].y)}; o[dt] = (oa * fa + o[dt] * fb) * inv;
                ss += (o[dt][0] * o[dt][0] + o[dt][1] * o[dt][1]) + (o[dt][2] * o[dt][2] + o[dt][3] * o[dt][3]); }
            ss += __shfl_xor(ss, 16); ss += __shfl_xor(ss, 32);
            __syncthreads();
            if (g == 0) ssq[head * 16 + fr] = ss;
            __syncthreads();
            { float s = 0.f;
#pragma unroll
              for (int w = 0; w < 8; ++w) s += ssq[w * 16 + fr];
              const float rs = 1.0f / sqrtf(s * (1.0f / 512.0f) + NORM_EPS); const float* nw = a.in[I_ATN] + l * 512 + head * 64;
#pragma unroll
              for (int dt = 0; dt < 4; ++dt) { const int dd = 16 * dt + 4 * g;
                  *(v2u*)(Y + qrow * DM + 512 + head * 64 + dd) = (v2u){pkbf(o[dt][0] * rs * nw[dd], o[dt][1] * rs * nw[dd + 1]), pkbf(o[dt][2] * rs * nw[dd + 2], o[dt][3] * rs * nw[dd + 3])}; } }
        }
        if (!has_next) break;
        { const AtLoad t = c0; c0 = c2; c1 = t; }
        unit = nunit; rowb = rowb_n; tb0 = tb0_n;
    }
    __syncthreads();
}
__device__ __forceinline__ void m2_hgrn(const Args& a, unsigned char* ws, int l, int w, LAS unsigned char* lds, int tid) {
    const bf16* proj = (const bf16*)(ws + WS_HP); float* OA = (float*)(ws + WS_OA);
    const int b = w >> 2, h = w & 3, v = tid >> 2, kq = tid & 3;
    constexpr int TB = 16, RS = 144;
    LAS float* fs = (LAS float*)lds; LAS float* ks = fs + TB * RS; LAS float* qs = ks + TB * RS; LAS float* vs = qs + TB * RS;
    const int kl = tid & 127, ch = h * 128 + kl;
    float lb = 0.f;
    { const float* lg = a.in[I_LBL]; float mx = lg[ch]; for (int i = 1; i < DEPTH; ++i) mx = fmaxf(mx, lg[i * 512 + ch]); float den = 0.f, num = 0.f;
      for (int i = 0; i < DEPTH; ++i) { const float e = __expf(lg[i * 512 + ch] - mx); den += e; if (i >= 1 && i <= l) num += e; } lb = num / den; }
    float S[32];
#pragma unroll
    for (int j = 0; j < 32; ++j) S[j] = 0.f;
    const size_t rowb = (size_t)b * SEQ;
    bf16 rq[4], rf[4], ri[4];
#define HG_LDBATCH(t0_) do { _Pragma("unroll") for (int i = 0; i < 4; ++i) { const int s_ = (tid >> 7) + 4 * i; const bf16* p_ = proj + (rowb + (t0_) + s_) * NPROJ + ch; rq[i] = p_[PC_AQ]; rf[i] = p_[PC_AF]; ri[i] = p_[PC_AI]; } } while (0)
    HG_LDBATCH(0);
    for (int t0 = 0; t0 < SEQ; t0 += TB) {
#pragma unroll
        for (int i = 0; i < 4; ++i) { const int s = (tid >> 7) + 4 * i; const int kp = kl + 4 * (kl >> 5);
            const float sg = sigmoidf_(bf2f(rf[i])); fs[s * RS + kp] = lb + (1.0f - lb) * sg; ks[s * RS + kp] = (1.0f - lb) * (1.0f - sg); qs[s * RS + kp] = siluf_(bf2f(rq[i])); vs[s * 128 + kl] = bf2f(ri[i]); }
        __syncthreads();
        if (t0 + TB < SEQ) HG_LDBATCH(t0 + TB);
        for (int s = 0; s < TB; ++s) {
            const float vv = vs[s * 128 + v]; float part = 0.f; const int kb = 36 * kq;
#pragma unroll
            for (int j4 = 0; j4 < 8; ++j4) { const f32x4 f4 = *(const LAS f32x4*)(fs + s * RS + kb + 4 * j4), k4 = *(const LAS f32x4*)(ks + s * RS + kb + 4 * j4), q4 = *(const LAS f32x4*)(qs + s * RS + kb + 4 * j4);
#pragma unroll
                for (int jj = 0; jj < 4; ++jj) { const int j = 4 * j4 + jj; S[j] = f4[jj] * S[j] + k4[jj] * vv; part += S[j] * q4[jj]; } }
            part += __shfl_xor(part, 1); part += __shfl_xor(part, 2);
            if (kq == 0) OA[(rowb + t0 + s) * 512 + h * 128 + v] = part;
        }
        __syncthreads();
    }
}
__device__ __forceinline__ void m2_ssd(const Args& a, unsigned char* ws, int l, int w, LAS unsigned char* lds, int tid) {
    const float* xbcc = (const float*)(ws + WS_XBCC); const float* dtv = (const float*)(ws + WS_DTV); float* OC = (float*)(ws + WS_OC);
    const int b = w >> 3, h = w & 7, g = h >> 2, p = tid >> 3, ns = tid & 7;
    constexpr int TB = 16, RS = 160;
    LAS float* Bs = (LAS float*)lds; LAS float* Cs = Bs + TB * RS; LAS float* xs = Cs + TB * RS; LAS float* dts = xs + TB * 64;
    const float Aneg = -__expf(a.in[I_SALOG][l * 8 + h]), Dk = a.in[I_SD][l * 8 + h];
    float hs[16];
#pragma unroll
    for (int j = 0; j < 16; ++j) hs[j] = 0.f;
    const size_t rowb = (size_t)b * SEQ;
    float rB[4], rC[4], rx[2], rdt = 0.f;
    const int nl = tid & 127, pl = tid & 63;
#define SSD_LDBATCH(t0_) do { _Pragma("unroll") for (int i = 0; i < 4; ++i) { const int s_ = (tid >> 7) + 4 * i; const float* q_ = xbcc + (rowb + (t0_) + s_) * 1024; rB[i] = q_[512 + g * 128 + nl]; rC[i] = q_[768 + g * 128 + nl]; } \
        _Pragma("unroll") for (int i = 0; i < 2; ++i) { const int s_ = (tid >> 6) + 8 * i; rx[i] = xbcc[(rowb + (t0_) + s_) * 1024 + h * 64 + pl]; } \
        if (tid < TB) rdt = dtv[(rowb + (t0_) + tid) * 8 + h]; } while (0)
    SSD_LDBATCH(0);
    for (int t0 = 0; t0 < SEQ; t0 += TB) {
#pragma unroll
        for (int i = 0; i < 4; ++i) { const int s = (tid >> 7) + 4 * i; const int np = nl + 4 * (nl >> 4); Bs[s * RS + np] = rB[i]; Cs[s * RS + np] = rC[i]; }
#pragma unroll
        for (int i = 0; i < 2; ++i) { const int s = (tid >> 6) + 8 * i; xs[s * 64 + pl] = rx[i]; }
        if (tid < TB) dts[tid] = rdt;
        __syncthreads();
        if (t0 + TB < SEQ) SSD_LDBATCH(t0 + TB);
        for (int s = 0; s < TB; ++s) {
            const float dt = dts[s], dA = __expf(dt * Aneg), xv = xs[s * 64 + p], xdt = xv * dt; float part = 0.f; const int nb = 20 * ns;
#pragma unroll
            for (int j4 = 0; j4 < 4; ++j4) { const f32x4 b4 = *(const LAS f32x4*)(Bs + s * RS + nb + 4 * j4), c4 = *(const LAS f32x4*)(Cs + s * RS + nb + 4 * j4);
#pragma unroll
                for (int jj = 0; jj < 4; ++jj) { const int j = 4 * j4 + jj; hs[j] = dA * hs[j] + b4[jj] * xdt; part += c4[jj] * hs[j]; } }
            part += __shfl_xor(part, 1); part += __shfl_xor(part, 2); part += __shfl_xor(part, 4);
            if (ns == 0) OC[(rowb + t0 + s) * 512 + h * 64 + p] = part + Dk * xv;
        }
        __syncthreads();
    }
}
__device__ __forceinline__ void m2_lru(const Args& a, unsigned char* ws, int w, int tid) {
    const float* LA = (const float*)(ws + WS_LA); const float* LB = (const float*)(ws + WS_LB); float* OD = (float*)(ws + WS_OD);
    const int idx = w * NTHR + tid, b = idx >> 9, c = idx & 511; const size_t base = (size_t)b * SEQ * 512 + c;
    float hh = 0.f; constexpr int U = 16;
    float ra[U], rb[U];
#pragma unroll
    for (int i = 0; i < U; ++i) { ra[i] = LA[base + (size_t)i * 512]; rb[i] = LB[base + (size_t)i * 512]; }
    for (int t0 = 0; t0 < SEQ; t0 += U) {
        float ca[U], cbv[U];
#pragma unroll
        for (int i = 0; i < U; ++i) { ca[i] = ra[i]; cbv[i] = rb[i]; }
        if (t0 + U < SEQ) {
#pragma unroll
            for (int i = 0; i < U; ++i) { ra[i] = LA[base + (size_t)(t0 + U + i) * 512]; rb[i] = LB[base + (size_t)(t0 + U + i) * 512]; } }
#pragma unroll
        for (int i = 0; i < U; ++i) { hh = ca[i] * hh + cbv[i]; OD[base + (size_t)(t0 + i) * 512] = hh; }
    }
}
__device__ __forceinline__ void m2_attn(const Args& a, unsigned char* ws, int item, int tid) {
    const bf16* proj = (const bf16*)(ws + WS_HP); float* OB = (float*)(ws + WS_OB);
    const int head = item & 7, blk = item >> 3, t = blk * NTHR + tid, tb = t & (SEQ - 1); const size_t rowb = (size_t)(t - tb);
    float q[64], acc[64];
    { const v4u* qp = (const v4u*)(proj + (size_t)t * NPROJ + PC_BQ + head * 64);
#pragma unroll
      for (int i = 0; i < 8; ++i) { const v4u u = qp[i]; q[8 * i + 0] = bflo(u.x) * 0.125f; q[8 * i + 1] = bfhi(u.x) * 0.125f; q[8 * i + 2] = bflo(u.y) * 0.125f; q[8 * i + 3] = bfhi(u.y) * 0.125f;
          q[8 * i + 4] = bflo(u.z) * 0.125f; q[8 * i + 5] = bfhi(u.z) * 0.125f; q[8 * i + 6] = bflo(u.w) * 0.125f; q[8 * i + 7] = bfhi(u.w) * 0.125f; } }
#pragma unroll
    for (int d = 0; d < 64; ++d) acc[d] = 0.f;
    float mrun = -1e30f, lrun = 0.f;
    for (int pat = 0; pat < 3; ++pat) { const int dil = (pat == 0) ? 1 : (pat == 1) ? 4 : 16;
        for (int j = 0; j <= 128; ++j) { const int pos = tb - j * dil;
            if (pos >= 0) {
                const v4u* kp = (const v4u*)(proj + (rowb + pos) * NPROJ + PC_BK + head * 64); const v4u* vp = (const v4u*)(proj + (rowb + pos) * NPROJ + PC_BV + head * 64);
                float s = 0.f;
#pragma unroll
                for (int i = 0; i < 8; ++i) { const v4u u = kp[i]; s += (q[8 * i] * bflo(u.x) + q[8 * i + 1] * bfhi(u.x)) + (q[8 * i + 2] * bflo(u.y) + q[8 * i + 3] * bfhi(u.y))
                        + (q[8 * i + 4] * bflo(u.z) + q[8 * i + 5] * bfhi(u.z)) + (q[8 * i + 6] * bflo(u.w) + q[8 * i + 7] * bfhi(u.w)); }
                const float mn = fmaxf(mrun, s), corr = __expf(mrun - mn), pr = __expf(s - mn); lrun = lrun * corr + pr; mrun = mn;
#pragma unroll
                for (int i = 0; i < 8; ++i) { const v4u u = vp[i];
                    acc[8 * i + 0] = acc[8 * i + 0] * corr + pr * bflo(u.x); acc[8 * i + 1] = acc[8 * i + 1] * corr + pr * bfhi(u.x); acc[8 * i + 2] = acc[8 * i + 2] * corr + pr * bflo(u.y); acc[8 * i + 3] = acc[8 * i + 3] * corr + pr * bfhi(u.y);
                    acc[8 * i + 4] = acc[8 * i + 4] * corr + pr * bflo(u.z); acc[8 * i + 5] = acc[8 * i + 5] * corr + pr * bfhi(u.z); acc[8 * i + 6] = acc[8 * i + 6] * corr + pr * bflo(u.w); acc[8 * i + 7] = acc[8 * i + 7] * corr + pr * bfhi(u.w); }
            } } }
    const float inv = 1.0f / lrun; float* o = OB + (size_t)t * 512 + head * 64;
#pragma unroll
    for (int i = 0; i < 16; ++i) *(f32x4*)(o + 4 * i) = (f32x4){acc[4 * i] * inv, acc[4 * i + 1] * inv, acc[4 * i + 2] * inv, acc[4 * i + 3] * inv};
}
__device__ __forceinline__ void hg_p2_item4(unsigned char* ws, int item, int t) {
    const bf16* UT = (const bf16*)(ws + WS_HGU); const float* DCH = (const float*)(ws + WS_HGD); bf16* SPT = (bf16*)(ws + WS_HGS);
    const int bh = item >> 4, v = (item & 15) * 8 + (t >> 5), k = 4 * (t & 31); const size_t cb = (size_t)bh * HG_NCH;
    f32x4 s = {0.f, 0.f, 0.f, 0.f}; constexpr int U = 8; v2u ru[U]; f32x4 rd[U];
#pragma unroll
    for (int i = 0; i < U; ++i) { ru[i] = *(const v2u*)(UT + (cb + i) * 16384 + v * 128 + k); rd[i] = *(const f32x4*)(DCH + (cb + i) * 128 + k); }
    for (int c0 = 0; c0 < HG_NCH; c0 += U) {
        v2u cu[U]; f32x4 cd[U];
#pragma unroll
        for (int i = 0; i < U; ++i) { cu[i] = ru[i]; cd[i] = rd[i]; }
        if (c0 + U < HG_NCH) {
#pragma unroll
            for (int i = 0; i < U; ++i) { ru[i] = *(const v2u*)(UT + (cb + c0 + U + i) * 16384 + v * 128 + k); rd[i] = *(const f32x4*)(DCH + (cb + c0 + U + i) * 128 + k); } }
#pragma unroll
        for (int i = 0; i < U; ++i) { *(v2u*)(SPT + (cb + c0 + i) * 16384 + v * 128 + k) = (v2u){pk2(s.x, s.y), pk2(s.z, s.w)};
            s = cd[i] * s + (f32x4){bflo(cu[i].x), bfhi(cu[i].x), bflo(cu[i].y), bfhi(cu[i].y)}; }
    }
}
__device__ __forceinline__ void sd_p2_item4(unsigned char* ws, int item, int t) {
    const bf16* STATES = (const bf16*)(ws + WS_SDST); const float* CDEC = (const float*)(ws + WS_CDEC); bf16* PREV = (bf16*)(ws + WS_SDPV);
    const int bh = item >> 3, b = bh >> 3, h = bh & 7, pp = (item & 7) * 8 + (t >> 5), n = 4 * (t & 31);
    f32x4 s = {0.f, 0.f, 0.f, 0.f}; constexpr int U = 8; v2u ru[U]; float rd[U];
#define SD_IDX4(c_) (((size_t)(b * 256 + (c_)) * 8 + h) * 8192 + pp * 128 + n)
#pragma unroll
    for (int i = 0; i < U; ++i) { ru[i] = *(const v2u*)(STATES + SD_IDX4(i)); rd[i] = CDEC[(size_t)(b * 256 + i) * 8 + h]; }
    for (int c0 = 0; c0 < 256; c0 += U) {
        v2u cu[U]; float cd[U];
#pragma unroll
        for (int i = 0; i < U; ++i) { cu[i] = ru[i]; cd[i] = rd[i]; }
        if (c0 + U < 256) {
#pragma unroll
            for (int i = 0; i < U; ++i) { ru[i] = *(const v2u*)(STATES + SD_IDX4(c0 + U + i)); rd[i] = CDEC[(size_t)(b * 256 + c0 + U + i) * 8 + h]; } }
#pragma unroll
        for (int i = 0; i < U; ++i) { *(v2u*)(PREV + SD_IDX4(c0 + i)) = (v2u){pk2(s.x, s.y), pk2(s.z, s.w)};
            s = s * cd[i] + (f32x4){bflo(cu[i].x), bfhi(cu[i].x), bflo(cu[i].y), bfhi(cu[i].y)}; }
    }
#undef SD_IDX4
}
__device__ __forceinline__ void lru_p2_item4(unsigned char* ws, int item, int t) {
    const float* LRA = (const float*)(ws + WS_LRA); const float* LRH = (const float*)(ws + WS_LRH); float* LRC = (float*)(ws + WS_LRC);
    const int idx = item * 256 + t, b = idx >> 9, c = idx & 511; const size_t base = (size_t)b * 256 * 512 + c;
    float hh = 0.f; constexpr int U = 16; float ra[U], rb[U];
#pragma unroll
    for (int i = 0; i < U; ++i) { ra[i] = LRA[base + (size_t)i * 512]; rb[i] = LRH[base + (size_t)i * 512]; }
    for (int k0 = 0; k0 < 256; k0 += U) {
        float ca[U], cbv[U];
#pragma unroll
        for (int i = 0; i < U; ++i) { ca[i] = ra[i]; cbv[i] = rb[i]; }
        if (k0 + U < 256) {
#pragma unroll
            for (int i = 0; i < U; ++i) { ra[i] = LRA[base + (size_t)(k0 + U + i) * 512]; rb[i] = LRH[base + (size_t)(k0 + U + i) * 512]; } }
#pragma unroll
        for (int i = 0; i < U; ++i) { LRC[base + (size_t)(k0 + i) * 512] = hh; hh = ca[i] * hh + cbv[i]; }
    }
}
__device__ __forceinline__ void ph_m2_half(unsigned char* ws, int vcu, int G, int t) {
    constexpr int N_ITEMS = 4 + 128 + 128;
    for (int w = vcu; w < N_ITEMS; w += G) {
        if (w < 4) lru_p2_item4(ws, w, t);
        else if (w < 132) hg_p2_item4(ws, w - 4, t);
        else sd_p2_item4(ws, w - 132, t);
    }
}
__device__ __forceinline__ void ph_convert_dyn(const Args& a, unsigned char* ws, int l, int mask, LAS unsigned char* lds, int vcu, int G, int wave, int lane, LAS unsigned* ctr) {
    LAS float* scr = (LAS float*)(lds + wave * 16384);
    const int nitems = cvt_nitems(mask);
#define CV_GRAB(dst) do { unsigned j_ = 0; if (lane == 0) j_ = __hip_atomic_fetch_add(ctr, 1u, __ATOMIC_RELAXED, __HIP_MEMORY_SCOPE_WORKGROUP); dst = vcu + G * (int)__builtin_amdgcn_readfirstlane(j_); } while (0)
    int it; CV_GRAB(it); if (it >= nitems) return;
    CvtDesc d0 = cvt_decode(a, ws, l, mask, it); f32x4 v[8]; cvt_load(d0, lane, v);
    for (;;) {
        int nx; CV_GRAB(nx); CvtDesc d1 = d0; f32x4 vn[8];
        if (nx < nitems) { d1 = cvt_decode(a, ws, l, mask, nx); cvt_load(d1, lane, vn); }
        else {
#pragma unroll
            for (int i = 0; i < 8; ++i) vn[i] = v[i]; }
        cvt_store(d0, ws, lane, v, scr);
        if (nx >= nitems) break;
        d0 = d1;
#pragma unroll
        for (int i = 0; i < 8; ++i) v[i] = vn[i];
    }
#undef CV_GRAB
}
__device__ __forceinline__ void ld8(const float* p, float (&o)[8]) { const f32x4 u0 = *(const f32x4*)p, u1 = *(const f32x4*)(p + 4); o[0] = u0.x; o[1] = u0.y; o[2] = u0.z; o[3] = u0.w; o[4] = u1.x; o[5] = u1.y; o[6] = u1.z; o[7] = u1.w; }
__device__ __forceinline__ void ldb8(const bf16* p, float (&o)[8]) { const v4u u = *(const v4u*)p; o[0] = bflo(u.x); o[1] = bfhi(u.x); o[2] = bflo(u.y); o[3] = bfhi(u.y); o[4] = bflo(u.z); o[5] = bfhi(u.z); o[6] = bflo(u.w); o[7] = bfhi(u.w); }
__device__ __forceinline__ void st8(bf16* p, const float (&o)[8]) { v4u u; u.x = pk2(o[0], o[1]); u.y = pk2(o[2], o[3]); u.z = pk2(o[4], o[5]); u.w = pk2(o[6], o[7]); *(v4u*)p = u; }
__device__ __forceinline__ void ph_m3(const Args& a, unsigned char* ws, int l, int gw, int ngw, int lane) {
    const bf16* proj = (const bf16*)(ws + WS_HP); bf16* Y = (bf16*)(ws + WS_Y);
    const float* OA = (const float*)(ws + WS_OA); const float* OB = (const float*)(ws + WS_OB); const float* OC = (const float*)(ws + WS_OC); const float* OD = (const float*)(ws + WS_OD);
    const float* nA = a.in[I_HGN] + l * 512; const float* nB = a.in[I_ATN] + l * 512; const float* nC = a.in[I_SNORM] + l * 512; const float* nD = a.in[I_LNORM] + l * 512;
    const int c = lane * 8;
    for (int t = gw; t < M; t += ngw) {
        float vb[8];
        ld8(OB + (size_t)t * 512 + c, vb);
        const bf16* pr = proj + (size_t)t * NPROJ;
        { float ss = 0.f;
#pragma unroll
          for (int i = 0; i < 8; ++i) ss += vb[i] * vb[i];
          ss = wave_sum(ss); const float r = 1.0f / sqrtf(ss * (1.0f / 512.0f) + NORM_EPS); float w[8]; ld8(nB + c, w);
#pragma unroll
          for (int i = 0; i < 8; ++i) vb[i] = vb[i] * r * w[i];
          st8(Y + (size_t)t * DM + 512 + c, vb); }
    }
}
__device__ __forceinline__ void ph_final(float* __restrict__ out, const bf16* __restrict__ xh, const unsigned char* __restrict__ xl, const rs_t* __restrict__ rowss, const float* __restrict__ w, int vcu, int G, int tid) {
    const int lane = tid & 63, wave = tid >> 6, wr = wave >> 2, wc = wave & 3, fr = lane & 15, fq = lane >> 4;
    for (int t = vcu; t < (M / 256) * (DM / 256); t += G) { const int pm = t >> 3, pn = t & 7;
        v4u hh[8][2], lww[8]; rs_t rsq_[8];
#pragma unroll
        for (int am = 0; am < 8; ++am) { const int row = pm * 256 + (am >> 2) * 128 + wr * 64 + (am & 3) * 16 + fr; rsq_[am] = rowss[row];
            lww[am] = (v4u){0x80808080u, 0x80808080u, 0x80808080u, 0x80808080u}; if (MK_LO) lww[am] = *(const v4u*)(xl + pg8::lo_addr(pm, pn, am, wave, lane));
#pragma unroll
            for (int bj = 0; bj < 2; ++bj) hh[am][bj] = *(const v4u*)(xh + (size_t)row * DM + pn * 256 + bj * 128 + wc * 32 + 8 * fq); }
        __builtin_amdgcn_sched_barrier(0);
#pragma unroll
        for (int am = 0; am < 8; ++am) { const int row = pm * 256 + (am >> 2) * 128 + wr * 64 + (am & 3) * 16 + fr; const float r = 1.0f / sqrtf((float)rsq_[am] * (RS_INV / DM) + NORM_EPS);
            const v4u lw = lww[am];
#pragma unroll
            for (int bj = 0; bj < 2; ++bj) { const int col = pn * 256 + bj * 128 + wc * 32 + 8 * fq; const size_t o2 = (size_t)row * DM + col; const v4u h = hh[am][bj];
                const f32x4 w0 = *(const f32x4*)(w + col), w1 = *(const f32x4*)(w + col + 4); const unsigned l0 = lw[2 * bj], l1 = lw[2 * bj + 1];
                f32x4 v0 = {bflo(h.x) + pg8::lo_dec(h.x & 0xffffu, l0 & 0xffu), bfhi(h.x) + pg8::lo_dec(h.x >> 16, (l0 >> 8) & 0xffu), bflo(h.y) + pg8::lo_dec(h.y & 0xffffu, (l0 >> 16) & 0xffu), bfhi(h.y) + pg8::lo_dec(h.y >> 16, l0 >> 24)};
                f32x4 v1 = {bflo(h.z) + pg8::lo_dec(h.z & 0xffffu, l1 & 0xffu), bfhi(h.z) + pg8::lo_dec(h.z >> 16, (l1 >> 8) & 0xffu), bflo(h.w) + pg8::lo_dec(h.w & 0xffffu, (l1 >> 16) & 0xffu), bfhi(h.w) + pg8::lo_dec(h.w >> 16, l1 >> 24)};
                *(f32x4*)(out + o2) = v0 * r * w0; *(f32x4*)(out + o2 + 4) = v1 * r * w1; } } }
}
constexpr int NPH = 66;
__host__ __device__ inline bool phase_active(int p) {
    if (p == 0 || p == NPH - 1) return true;
    const int f = (p - 1) >> 3, k = (p - 1) & 7, second = f & 1, l = f >> 1;
    if (k == 0) return false;
    if (k == 1 || k == 2) return true;
    return !second;
}
__global__ void __launch_bounds__(NTHR, 2) fwd_kernel(Args args) {
    extern __shared__ __attribute__((aligned(16))) unsigned char lds_raw[];
    LAS unsigned char* lds = (LAS unsigned char*)lds_raw;
    volatile LAS unsigned* MISC = (volatile LAS unsigned*)(lds + MISC_OFF);
    const int tid0 = threadIdx.x;
    const int G = gridDim.x, bx = blockIdx.x, vcu = (G % 8 == 0) ? (bx % 8) * (G / 8) + bx / 8 : bx;
    const int ngw = G * NWAVES;
    unsigned* ctl = (unsigned*)(args.ws + WS_CTL);
    for (int u = tid0; u < (LDS_BYTES - LDSCTL_OFF) / 4; u += NTHR) ((LAS unsigned*)(lds + LDSCTL_OFF))[u] = 0u;
    __syncthreads();
    const int lo = args.ph_lo, hi = args.ph_hi;
    const bool multi = (hi - lo) > 1;
    XcdBarrier bar; bar.bar = ctl + CW_BAR; bar.x = 0; bar.st = nullptr;
    if (multi) bar = xcd_barrier_post(ctl + CW_BAR, MISC + 8);
#define IN(k) (lo <= (k) && (k) < hi)
#define SEAM(k) do { if ((k) + 1 < hi) xcd_barrier(bar); } while (0)

    if (IN(0)) { unsigned char* ws = args.ws; rs_t* rowss_all = (rs_t*)(ws + WS_ROWSS); const int lane = tid0 & 63, wave = __builtin_amdgcn_readfirstlane(tid0 >> 6), gw = vcu * NWAVES + wave;
        ph_prep(args.in[I_X], (bf16*)(ws + WS_XB), (unsigned char*)(ws + WS_XLO), rowss_all, vcu, G, tid0); ph_convert(args, ws, 0, CVM_F1 | CVM_IN, lds, gw, ngw, wave, lane); SEAM(0); }

    for (int f = 0; f < 2 * DEPTH; ++f) {
        const int l = f >> 1, second = f & 1, base = 1 + 8 * f;
        unsigned long long wsv_ = (unsigned long long)args.ws, outv_ = (unsigned long long)args.out; asm volatile("" : "+s"(wsv_), "+s"(outv_));
        unsigned char* ws = (unsigned char*)(GAS unsigned char*)wsv_; float* out = (float*)(GAS float*)outv_; rs_t* rowss_all = (rs_t*)(ws + WS_ROWSS);
        int tid = tid0; asm volatile("" : "+v"(tid));
        const int lane = tid & 63, wave = __builtin_amdgcn_readfirstlane(tid >> 6), gw = vcu * NWAVES + wave;
        bf16* XB = (bf16*)(ws + WS_XB); bf16* HP = (bf16*)(ws + WS_HP); bf16* Y = (bf16*)(ws + WS_Y);
        const rs_t* rs_in = rowss_all + (size_t)(3 * l + 2 * second) * M;
        rs_t* rs_out = rowss_all + (size_t)(3 * l + 1 + 2 * second) * M;
        if (IN(base + 1)) {
            pg8::Gemm g{XB, (const bf16*)(ws + (second ? WS_WGU2 : WS_WGU1)), M, NGU, DM}; pg8::StaticOrder S; S.init(M, NGU, G, bx);
            pg8::EpiSwiglu E{HP, DFF, rs_in, RS_INV / DM, NORM_EPS};
            pg8::gemm_phase<pg8::EpiSwiglu, pg8::StaticOrder, true, true>(lds, g, S, E);
            SEAM(base + 1);
        }
        if (IN(base + 2)) {
            pg8::Gemm g{HP, (const bf16*)(ws + (second ? WS_WD2 : WS_WD1)), M, DM, DFF}; pg8::StaticOrderT<4, true> S; S.init(M, DM, G, bx);
            pg8::EpiResid E{XB, (unsigned char*)(ws + WS_XLO), rs_out, DM, 0.5f};
            pg8::gemm_phase<pg8::EpiResid, pg8::StaticOrderT<4, true>, true, true>(lds, g, S, E);
            SEAM(base + 2);
        }
        if (!second) {
            if (IN(base + 3)) {
                pg8::Gemm g{XB, (const bf16*)(ws + WS_WIN), M, NPROJ, DM}; pg8::StaticOrder S; S.init(M, NPROJ, G, bx);
                pg8::EpiRowScale E{HP, NPROJ, rs_out, RS_INV / DM, NORM_EPS};
                pg8::gemm_phase<pg8::EpiRowScale, pg8::StaticOrder, true, true>(lds, g, S, E);
                SEAM(base + 3);
            }
            if (IN(base + 4)) { const bool cfirst = vcu & 1;
                if (cfirst) { ph_convert(args, ws, l, CVM_OUT, lds, gw, ngw, wave, lane); __syncthreads(); }
                { LruW W; lru_load_w(args, l, wave, lane, W); for (int u = vcu; u < 512; u += G) lru_unit<false>(args, ws, l, u, W, lds, tid); }
                for (int u = vcu; u < 512; u += G) sd_p1_unit(args, ws, l, rs_out, u, lds, tid);
                { HgRaw R; hg_load<false>(R, ws, vcu, tid); for (int u = vcu; u < 2048; u += G) hg_p1_unit(args, ws, l, u, (u + G < 2048) ? u + G : -1, R, lds, tid); }
                attn_pass<0>(args, ws, l, vcu, G, lds, tid);
                if (!cfirst) { __syncthreads(); ph_convert(args, ws, l, CVM_OUT, lds, gw, ngw, wave, lane); } SEAM(base + 4); }
            if (IN(base + 5)) {
                LAS unsigned* cctr = (LAS unsigned*)(lds + LDSCTL_OFF + 64);
                if (tid == 0) *cctr = 0u;
                __syncthreads();
                if (wave < 4) ph_m2_half(ws, vcu, G, tid);
                if (l + 1 < DEPTH) ph_convert_dyn(args, ws, l + 1, CVM_F1 | CVM_IN, lds, vcu, G, wave, lane, cctr);
                __syncthreads();
                attn_pass<1>(args, ws, l, vcu, G, lds, tid);
                SEAM(base + 5); }
            if (IN(base + 6)) { const bool cfirst = vcu & 1;
                if (cfirst) { ph_convert(args, ws, l, CVM_F2, lds, gw, ngw, wave, lane); __syncthreads(); }
                { HgRaw R; hg_load<true>(R, ws, vcu, tid); for (int u = vcu; u < 2048; u += G) hg_p3_unit(args, ws, l, u, (u + G < 2048) ? u + G : -1, R, lds, tid); } for (int u = vcu; u < 1024; u += G) sd_p3_unit(args, ws, l, u, lds, tid);
                { LruW W; lru_load_w(args, l, wave, lane, W); for (int u = vcu; u < 512; u += G) lru_unit<true>(args, ws, l, u, W, lds, tid); }
                if (!cfirst) { __syncthreads(); ph_convert(args, ws, l, CVM_F2, lds, gw, ngw, wave, lane); } SEAM(base + 6); }
            if (IN(base + 7)) {
                pg8::Gemm g{Y, (const bf16*)(ws + WS_WOUT), M, DM, DM}; pg8::StaticOrderT<4> S; S.init(M, DM, G, bx);
                pg8::EpiResid E{XB, (unsigned char*)(ws + WS_XLO), rowss_all + (size_t)(3 * l + 2) * M, DM, 1.0f};
                pg8::gemm_phase<pg8::EpiResid, pg8::StaticOrderT<4>, true, true>(lds, g, S, E);
                SEAM(base + 7);
            }
        }
    }
    if (IN(NPH - 1)) { const int lane = tid0 & 63, wave = __builtin_amdgcn_readfirstlane(tid0 >> 6), gw = vcu * NWAVES + wave; ph_final(args.out, (const bf16*)(args.ws + WS_XB), (const unsigned char*)(args.ws + WS_XLO), (const rs_t*)(args.ws + WS_ROWSS) + (size_t)12 * M, args.in[I_FINN], vcu, G, tid0); }
#undef IN
#undef SEAM
}

extern "C" void kernel_launch(void* const* d_in, const int* in_sizes, int n_in, void* d_out, int out_size, void* d_ws, size_t ws_size, hipStream_t stream) {
    static int grid = 0;
    if (grid == 0) {
        if (n_in != 30 || in_sizes[0] != M * DM || out_size != M * DM || ws_size < WS_END) { fprintf(stderr, "kernel_launch: unexpected problem shape / workspace (n_in %d, ws %zu, need %zu); nothing launched\n", n_in, ws_size, (size_t)WS_END); grid = -1; return; }
        int dev = 0, cus = 0;
        if (hipGetDevice(&dev) != hipSuccess || hipDeviceGetAttribute(&cus, hipDeviceAttributeMultiprocessorCount, dev) != hipSuccess) { grid = -1; return; }
        if (hipFuncSetAttribute((const void*)fwd_kernel, hipFuncAttributeMaxDynamicSharedMemorySize, LDS_BYTES) != hipSuccess) { fprintf(stderr, "kernel_launch: hipFuncSetAttribute failed\n"); grid = -1; return; }
        int per_cu = 0;
        if (hipOccupancyMaxActiveBlocksPerMultiprocessor(&per_cu, (const void*)fwd_kernel, NTHR, LDS_BYTES) != hipSuccess || per_cu < 1) { fprintf(stderr, "kernel_launch: occupancy query says %d; nothing launched\n", per_cu); (void)hipGetLastError(); grid = -1; return; }
        grid = cus;
    }
    if (grid < 0) return;
    if (hipMemsetAsync((char*)d_ws + WS_CTL, 0, CTL_ZERO_BYTES, stream) != hipSuccess) return;
    Args a{};
    for (int i = 0; i < 30; ++i) a.in[i] = (const float*)d_in[i];
    a.out = (float*)d_out; a.ws = (unsigned char*)d_ws;
#if MK_ONE_LAUNCH
    a.ph_lo = 0; a.ph_hi = NPH;
    hipLaunchKernelGGL(fwd_kernel, dim3(grid), dim3(NTHR), LDS_BYTES, stream, a);
#else
    for (int p = 0; p < NPH; ++p) { if (!phase_active(p)) continue; a.ph_lo = p; a.ph_hi = p + 1; hipLaunchKernelGGL(fwd_kernel, dim3(grid), dim3(NTHR), LDS_BYTES, stream, a); }
#endif
}
```
